# Optimizing an MI355X kernel written in HIP

```python
import jax, jax.numpy as jnp
from jax import lax
import numpy as np

D_MODEL = 1024
BATCH = 16
SEQ = 2048
DEPTH = 2

N_EVEN = (DEPTH + 1) // 2
N_ODD = DEPTH // 2
D_FF = 2816
NORM_EPS = 1e-6
BLOCK = 128

A_HEADS = 8
A_HEAD_DIM = 64
A_BRANCHES = ((128, 1), (512, 4), (2048, 16))
B_HEADS = 8
B_NOPE_DIM = 64
B_ROPE_DIM = 32
B_V_DIM = 64
B_Q_RANK = 256
B_KV_RANK = 128
ROPE_THETA = 10000.0
A_QKV = 3 * A_HEADS * A_HEAD_DIM
AB_IN = A_QKV + B_Q_RANK + B_KV_RANK + B_ROPE_DIM
AB_OUT = A_HEADS * A_HEAD_DIM + B_HEADS * B_V_DIM
C_HEADS = 16
C_HEAD_DIM = 64
C_IN = 3 * C_HEADS * C_HEAD_DIM
C_OUT = C_HEADS * C_HEAD_DIM

kernel_name = 'hybrid_dilated_mla_stickbreak_macaron'


def rmsnorm(x, g):
    xf = x.astype(jnp.float32)
    y = xf * lax.rsqrt(jnp.mean(xf * xf, axis=-1, keepdims=True) + NORM_EPS)
    return (y * g.astype(jnp.float32)).astype(x.dtype)


def swiglu(x, w_gate, w_up, w_down):
    return (jax.nn.silu(x @ w_gate) * (x @ w_up)) @ w_down


def rope(x):
    s, dr = x.shape[1], x.shape[-1]
    inv = ROPE_THETA ** (-jnp.arange(0, dr, 2, dtype=jnp.float32) / dr)
    ang = jnp.arange(s, dtype=jnp.float32)[:, None] * inv[None, :]
    cos = jnp.cos(ang)[None, :, None, :]
    sin = jnp.sin(ang)[None, :, None, :]
    xf = x.astype(jnp.float32)
    x1, x2 = xf[..., : dr // 2], xf[..., dr // 2:]
    return jnp.concatenate([x1 * cos - x2 * sin, x1 * sin + x2 * cos], axis=-1).astype(x.dtype)


def dilated_branch(q, k, v, window, dilation, slopes):
    b, s, h, dh = q.shape
    n_back = window // dilation
    L = s // dilation
    nb = -(-L // BLOCK)
    Lp = nb * BLOCK

    def to_sub(t):
        t = t.reshape(b, L, dilation, h, dh)
        t = jnp.pad(t, ((0, 0), (0, Lp - L), (0, 0), (0, 0), (0, 0)))
        return t.reshape(b, nb, BLOCK, dilation, h, dh)

    def band(t):
        prev = jnp.pad(t, ((0, 0), (1, 0), (0, 0), (0, 0), (0, 0), (0, 0)))[:, :-1]
        return jnp.concatenate([prev, t], axis=2)

    qs = to_sub(q)
    kb = band(to_sub(k))
    vb = band(to_sub(v)).astype(jnp.float32)
    sc = jnp.einsum('bnqrhd,bnkrhd->bnrhqk', qs, kb, preferred_element_type=jnp.float32) * dh ** -0.5
    qi = jnp.arange(BLOCK)[:, None]
    kk = jnp.arange(2 * BLOCK)[None, :]
    rel = qi + BLOCK - kk
    j_abs = jnp.arange(nb)[:, None, None] * BLOCK - BLOCK + kk[None]
    valid = (rel >= 0)[None] & (rel <= n_back)[None] & (j_abs >= 0)
    bias = -slopes[:, None, None] * (rel * dilation).astype(jnp.float32)[None]
    sc = jnp.where(valid[None, :, None, None], sc + bias[None, None, None], -jnp.inf)
    m = jnp.max(sc, axis=-1)
    p = jnp.exp(sc - m[..., None])
    l = jnp.sum(p, axis=-1)
    o = jnp.einsum('bnrhqk,bnkrhd->bnqrhd', p, vb)
    m = jnp.moveaxis(m, -1, 2)
    l = jnp.moveaxis(l, -1, 2)
    o = o / l[..., None]
    o = o.reshape(b, Lp, dilation, h, dh)[:, :L].reshape(b, s, h, dh)
    m = m.reshape(b, Lp, dilation, h)[:, :L].reshape(b, s, h)
    l = l.reshape(b, Lp, dilation, h)[:, :L].reshape(b, s, h)
    return o, m, l


def dilated_attention(q, k, v):
    slopes = 2.0 ** (-8.0 * jnp.arange(1, A_HEADS + 1, dtype=jnp.float32) / A_HEADS)
    outs = [dilated_branch(q, k, v, w, d, slopes) for (w, d) in A_BRANCHES]
    o_all = jnp.stack([o for o, _, _ in outs])
    m_all = jnp.stack([m for _, m, _ in outs])
    l_all = jnp.stack([l for _, _, l in outs])
    den = l_all * jnp.exp(m_all - jnp.max(m_all, axis=0, keepdims=True))
    alpha = den / jnp.sum(den, axis=0, keepdims=True)
    return jnp.sum(alpha[..., None] * o_all, axis=0)


def to_blocks(t):
    b, s = t.shape[0], t.shape[1]
    return jnp.moveaxis(t.reshape((b, s // BLOCK, BLOCK) + t.shape[2:]), 1, 0)


def from_blocks(t):
    t = jnp.moveaxis(t, 0, 1)
    return t.reshape((t.shape[0], t.shape[1] * t.shape[2]) + t.shape[3:])


def mla_attention(qn, qr, kn, kr, v):
    s = qn.shape[1]
    scale = (B_NOPE_DIM + B_ROPE_DIM) ** -0.5
    kpos = jnp.arange(s)
    vf = v.astype(jnp.float32)

    def one(args):
        qn_b, qr_b, idx = args
        sc = (jnp.einsum('bqhd,bkhd->bhqk', qn_b, kn, preferred_element_type=jnp.float32)
              + jnp.einsum('bqhd,bkd->bhqk', qr_b, kr, preferred_element_type=jnp.float32)) * scale
        qpos = idx * BLOCK + jnp.arange(BLOCK)
        sc = jnp.where(kpos[None, :] <= qpos[:, None], sc, -jnp.inf)
        p = jax.nn.softmax(sc, axis=-1)
        return jnp.einsum('bhqk,bkhd->bqhd', p, vf)

    out = lax.map(one, (to_blocks(qn), to_blocks(qr), jnp.arange(s // BLOCK)))
    return from_blocks(out)


def stick_breaking_attention(q, k, v):
    s, dh = q.shape[1], q.shape[-1]
    kpos = jnp.arange(s)
    vf = v.astype(jnp.float32)

    def one(args):
        q_b, idx = args
        z = jnp.einsum('bqhd,bkhd->bhqk', q_b, k, preferred_element_type=jnp.float32) * dh ** -0.5
        qpos = idx * BLOCK + jnp.arange(BLOCK)
        strict = kpos[None, :] < qpos[:, None]
        log1m = jnp.where(strict, -jax.nn.softplus(z), 0.0)
        later = lax.cumsum(log1m, axis=3, reverse=True) - log1m
        a = jnp.where(strict, jnp.exp(jax.nn.log_sigmoid(z) + later), 0.0)
        return jnp.einsum('bhqk,bkhd->bqhd', a, vf)

    out = lax.map(one, (to_blocks(q), jnp.arange(s // BLOCK)))
    return from_blocks(out)


def mixer_ab(h, w_in, q_norm_g, w_uq, kv_norm_g, w_ukv, w_out):
    b, s, _ = h.shape
    proj = h @ w_in
    a_qkv = proj[..., :A_QKV].reshape(b, s, 3, A_HEADS, A_HEAD_DIM)
    c_q = proj[..., A_QKV:A_QKV + B_Q_RANK]
    c_kv = proj[..., A_QKV + B_Q_RANK:A_QKV + B_Q_RANK + B_KV_RANK]
    k_rope = proj[..., A_QKV + B_Q_RANK + B_KV_RANK:]
    o_a = dilated_attention(a_qkv[:, :, 0], a_qkv[:, :, 1], a_qkv[:, :, 2])
    q = (rmsnorm(c_q, q_norm_g) @ w_uq).reshape(b, s, B_HEADS, B_NOPE_DIM + B_ROPE_DIM)
    kv = (rmsnorm(c_kv, kv_norm_g) @ w_ukv).reshape(b, s, B_HEADS, B_NOPE_DIM + B_V_DIM)
    qn, qr = q[..., :B_NOPE_DIM], rope(q[..., B_NOPE_DIM:])
    kn, vb = kv[..., :B_NOPE_DIM], kv[..., B_NOPE_DIM:]
    kr = rope(k_rope[:, :, None, :])[:, :, 0]
    o_b = mla_attention(qn, qr, kn, kr, vb)
    o = jnp.concatenate([o_a.reshape(b, s, A_HEADS * A_HEAD_DIM),
                         o_b.reshape(b, s, B_HEADS * B_V_DIM)], axis=-1).astype(h.dtype)
    return o @ w_out


def mixer_c(h, w_in, w_out):
    b, s, _ = h.shape
    qkv = (h @ w_in).reshape(b, s, 3, C_HEADS, C_HEAD_DIM)
    o = stick_breaking_attention(qkv[:, :, 0], qkv[:, :, 1], qkv[:, :, 2])
    return o.reshape(b, s, C_OUT).astype(h.dtype) @ w_out


def setup_inputs(seed: int = 0) -> dict:
    key = jax.random.key(seed)
    ks = jax.random.split(key, 16)
    f32 = jnp.float32

    def nrm(k, shape, fan_in):
        return jax.random.normal(k, shape, f32) * fan_in ** -0.5

    def gain(k, shape):
        return 1.0 + 0.02 * jax.random.normal(k, shape, f32)

    return {
        'x': jax.random.normal(ks[0], (BATCH, SEQ, D_MODEL), f32),
        'ffn_norm_g': gain(ks[1], (DEPTH, 2, D_MODEL)),
        'mix_norm_g': gain(ks[2], (DEPTH, D_MODEL)),
        'ffn_w_gate': nrm(ks[3], (DEPTH, 2, D_MODEL, D_FF), D_MODEL),
        'ffn_w_up': nrm(ks[4], (DEPTH, 2, D_MODEL, D_FF), D_MODEL),
        'ffn_w_down': nrm(ks[5], (DEPTH, 2, D_FF, D_MODEL), D_FF),
        'ab_w_in': nrm(ks[6], (N_EVEN, D_MODEL, AB_IN), D_MODEL),
        'mla_q_norm_g': gain(ks[7], (N_EVEN, B_Q_RANK)),
        'mla_w_uq': nrm(ks[8], (N_EVEN, B_Q_RANK, B_HEADS * (B_NOPE_DIM + B_ROPE_DIM)), B_Q_RANK),
        'mla_kv_norm_g': gain(ks[9], (N_EVEN, B_KV_RANK)),
        'mla_w_ukv': nrm(ks[10], (N_EVEN, B_KV_RANK, B_HEADS * (B_NOPE_DIM + B_V_DIM)), B_KV_RANK),
        'ab_w_out': nrm(ks[11], (N_EVEN, AB_OUT, D_MODEL), AB_OUT),
        'sb_w_in': nrm(ks[12], (N_ODD, D_MODEL, C_IN), D_MODEL),
        'sb_w_out': nrm(ks[13], (N_ODD, C_OUT, D_MODEL), C_OUT),
        'final_norm_g': gain(ks[14], (D_MODEL,)),
    }


def reference(x, ffn_norm_g, mix_norm_g, ffn_w_gate, ffn_w_up, ffn_w_down, ab_w_in, mla_q_norm_g,
              mla_w_uq, mla_kv_norm_g, mla_w_ukv, ab_w_out, sb_w_in, sb_w_out, final_norm_g):
    for i in range(DEPTH):
        x = x + 0.5 * swiglu(rmsnorm(x, ffn_norm_g[i, 0]), ffn_w_gate[i, 0], ffn_w_up[i, 0], ffn_w_down[i, 0])
        h = rmsnorm(x, mix_norm_g[i])
        if i % 2 == 0:
            e = i // 2
            x = x + mixer_ab(h, ab_w_in[e], mla_q_norm_g[e], mla_w_uq[e], mla_kv_norm_g[e], mla_w_ukv[e], ab_w_out[e])
        else:
            o = i // 2
            x = x + mixer_c(h, sb_w_in[o], sb_w_out[o])
        x = x + 0.5 * swiglu(rmsnorm(x, ffn_norm_g[i, 1]), ffn_w_gate[i, 1], ffn_w_up[i, 1], ffn_w_down[i, 1])
    return rmsnorm(x, final_norm_g)
```

```cpp
#include <hip/hip_runtime.h>
#include <hip/hip_cooperative_groups.h>
#include <cstdio>
#include <cstdint>
namespace cg = cooperative_groups;

__device__ __forceinline__ int opaque_tid() { int t = threadIdx.x; asm volatile("" : "+v"(t)); return t; }
namespace pg8 {
#define PG8_LAS __attribute__((address_space(3)))
typedef unsigned short bf16_t;
typedef short bf16x8 __attribute__((ext_vector_type(8)));
typedef float f32x4 __attribute__((ext_vector_type(4)));
typedef unsigned u32x4 __attribute__((ext_vector_type(4)));
constexpr int BM = 256, BK = 64, HALF = 128, HTB = HALF * BK * 2  , STAGE_BYTES = 8 * HTB, NXCD = 8, WGM = 8;

__host__ __device__ __forceinline__ int lds_byte(int r, int c) { const int st = (r >> 4) * 2 + (c >> 5), rr = r & 15, cc = c & 31, ob = rr * 64 + cc * 2; return st * 1024 + (ob ^ (((ob >> 9) & 1) << 5)); }
__host__ __device__ __forceinline__ void stage_rc(int b, int& R, int& C) { const int st = b / 1024, sb = b % 1024, swz = sb ^ (((sb >> 9) & 1) << 5); R = (st >> 1) * 16 + swz / 64; C = (st & 1) * 32 + (swz % 64) / 2; }
__host__ __device__ __forceinline__ int perm32(int rho) { const int n = rho >> 4, i = rho & 15; return 8 * (i >> 2) + 4 * n + (i & 3); }

struct Unit { int pm, pn; };
struct Gemm { const bf16_t* A; const bf16_t* Bt; int M, N, K; };

struct StaticOrder {
    int nM, nN, nwg, G, c;
    __host__ __device__ void init(int M, int N, int G_, int c_) { nM = M / BM; nN = N / BM; nwg = nM * nN; G = G_; c = c_; }
    __host__ __device__ bool next(int i, Unit& u) const {
        const long L = (long)i * G + c; if (L >= nwg) return false;
        int wgid = (int)L; { const int q = nwg / NXCD, r = nwg % NXCD, xcd = wgid % NXCD, off = wgid / NXCD; wgid = (xcd < r ? xcd * (q + 1) : r * (q + 1) + (xcd - r) * q) + off; }
        const int nig = WGM * nN, gid = wgid / nig, fm = gid * WGM, gsz = (nM - fm) < WGM ? (nM - fm) : WGM;
        u.pm = fm + ((wgid % nig) % gsz); u.pn = (wgid % nig) / gsz; return true;
    }
    __device__ __forceinline__ void a_ready(const Unit&) const {}
    __device__ __forceinline__ void done(const Unit&) const {}
};

__device__ __forceinline__ unsigned cvt_pk_bf16(float lo, float hi) { unsigned r; asm volatile("v_cvt_pk_bf16_f32 %0, %1, %2" : "=v"(r) : "v"(lo), "v"(hi)); return r; }
typedef unsigned u32x2 __attribute__((ext_vector_type(2)));
constexpr float kEps = 1e-6f;
typedef _Float16 f16x8 __attribute__((ext_vector_type(8)));
typedef _Float16 f16x2 __attribute__((ext_vector_type(2)));
template <bool F16> __device__ __forceinline__ f32x4 mma16(bf16x8 a, bf16x8 b, f32x4 c) {
    if (F16) return __builtin_amdgcn_mfma_f32_16x16x32_f16(__builtin_bit_cast(f16x8, a), __builtin_bit_cast(f16x8, b), c, 0, 0, 0);
    return __builtin_amdgcn_mfma_f32_16x16x32_bf16(a, b, c, 0, 0, 0);
}
#ifndef RES_FP16
#define RES_FP16 0
#endif
__device__ __forceinline__ unsigned pkh(float lo, float hi) { if (!RES_FP16) return cvt_pk_bf16(lo, hi); f16x2 v = {(_Float16)lo, (_Float16)hi}; return __builtin_bit_cast(unsigned, v); }
__device__ __forceinline__ f32x4 unpk4h(u32x2 w) { if (!RES_FP16) return (f32x4){__builtin_bit_cast(float, w.x << 16), __builtin_bit_cast(float, w.x & 0xffff0000u), __builtin_bit_cast(float, w.y << 16), __builtin_bit_cast(float, w.y & 0xffff0000u)}; const f16x2 a = __builtin_bit_cast(f16x2, w.x), b = __builtin_bit_cast(f16x2, w.y); return (f32x4){(float)a[0], (float)a[1], (float)b[0], (float)b[1]}; }

constexpr float kLog2e = 1.4426950408889634f;
__device__ __forceinline__ u32x2 pack4(const f32x4 v) { u32x2 w; w.x = cvt_pk_bf16(v[0], v[1]); w.y = cvt_pk_bf16(v[2], v[3]); return w; }
template <int NP> __device__ __forceinline__ float row_rstd(const float* ss, int row, float inv_n) {
    float s = 0.f;
#pragma unroll
    for (int i = 0; i < NP / 4; ++i) { const f32x4 v = *(const f32x4*)(ss + (size_t)row * NP + 4 * i); s += (v[0] + v[1]) + (v[2] + v[3]); }
    return __builtin_amdgcn_rsqf(s * inv_n + kEps);
}
__device__ __forceinline__ float quad_sum(float s) { s += __shfl_xor(s, 16); s += __shfl_xor(s, 32); return s; }


template <int NP> __device__ __forceinline__ void load_rstd8(const float* ss, const Unit& u, int wr, int fr, int fq, float inv_n, float (&rs)[2][4]) {
    f32x4 v[2][4];
#pragma unroll
    for (int ai = 0; ai < 2; ++ai)
#pragma unroll
        for (int m = 0; m < 4; ++m) { const int row = u.pm * BM + ai * HALF + wr * 64 + m * 16 + fr; v[ai][m] = *(const f32x4*)(ss + (size_t)row * NP + (NP == 16 ? 4 * fq : 0)); }
#pragma unroll
    for (int ai = 0; ai < 2; ++ai)
#pragma unroll
        for (int m = 0; m < 4; ++m) { float t = (v[ai][m][0] + v[ai][m][1]) + (v[ai][m][2] + v[ai][m][3]); if (NP == 16) t = quad_sum(t); rs[ai][m] = __builtin_amdgcn_rsqf(t * inv_n + kEps); }
}

struct EpiGU {
    static constexpr bool PERM = true, AFTER_DRAIN = false, F16 = (RES_FP16 != 0);
    const float* ss; bf16_t* H;
    __device__ __forceinline__ void operator()(const f32x4 (&acc)[2][2][4][2], const Unit& u, int wr, int wc, int fr, int fq) const {
        float rsv[2][4]; load_rstd8<16>(ss, u, wr, fr, fq, 1.0f / 1024.0f, rsv);
        typedef unsigned u32x4_ __attribute__((ext_vector_type(4)));
#pragma unroll
        for (int ai = 0; ai < 2; ++ai)
#pragma unroll
            for (int m = 0; m < 4; ++m) {
                const int row = u.pm * BM + ai * HALF + wr * 64 + m * 16 + fr;
                const float rs = rsv[ai][m];
                u32x2 w[2];
#pragma unroll
                for (int n = 0; n < 2; ++n) {
                    const f32x4 g = acc[ai][0][m][n] * rs, up = acc[ai][1][m][n] * rs; f32x4 o;
#pragma unroll
                    for (int j = 0; j < 4; ++j) { const float e = __builtin_amdgcn_exp2f(-g[j] * kLog2e); o[j] = g[j] * up[j] * __builtin_amdgcn_rcpf(1.0f + e); }
                    w[n] = pack4(o);
                }
                *(u32x4_*)(H + (size_t)row * 2816 + u.pn * 128 + wc * 32 + fq * 8) = (u32x4_){w[0].x, w[0].y, w[1].x, w[1].y};
            }
    }
};
template <bool SRC32> struct EpiResidT {
    static constexpr bool PERM = false, AFTER_DRAIN = false, F16 = false;
    const float* x32; bf16_t* X16; float* ss; float alpha; float* wlds;
    __device__ __forceinline__ void operator()(const f32x4 (&acc)[2][2][4][2], const Unit& u, int wr, int wc, int fr, int fq) const {
        float* wl = wlds + (wr * 4 + wc) * 576;
        const int lane = fq * 16 + fr, rl = lane >> 3, ch = lane & 7;
        f32x4 rb[2][2][2][2];
        const size_t cbase = (size_t)u.pn * BM + wc * 32 + ch * 4;
#define RES_LOAD(buf, b) do { _Pragma("unroll") for (int gg = 0; gg < 2; ++gg) { const int g_ = 2 * (b) + gg; const int row0_ = u.pm * BM + (g_ >> 2) * HALF + wr * 64 + (g_ & 3) * 16 + rl; \
            _Pragma("unroll") for (int bj = 0; bj < 2; ++bj) _Pragma("unroll") for (int i = 0; i < 2; ++i) { const size_t o_ = (size_t)(row0_ + 8 * i) * 1024 + cbase + bj * HALF; \
                if (SRC32) rb[buf][gg][bj][i] = *(const f32x4*)(x32 + o_); else rb[buf][gg][bj][i] = unpk4h(*(const u32x2*)(X16 + o_)); } } } while (0)
        RES_LOAD(0, 0);
#pragma unroll
        for (int b = 0; b < 4; ++b) {
            if (b + 1 < 4) RES_LOAD((b + 1) & 1, b + 1);
#pragma unroll
            for (int gg = 0; gg < 2; ++gg) {
                const int g = 2 * b + gg, ai = g >> 2, m = g & 3;
                const int row0 = u.pm * BM + ai * HALF + wr * 64 + m * 16 + rl;
                float sq[2] = {0.f, 0.f};
#pragma unroll
                for (int bj = 0; bj < 2; ++bj) {
                    *(f32x4*)(wl + fr * 36 + fq * 4) = acc[ai][bj][m][0] * alpha; *(f32x4*)(wl + fr * 36 + 16 + fq * 4) = acc[ai][bj][m][1] * alpha;
                    asm volatile("s_waitcnt lgkmcnt(0)" ::: "memory");
#pragma unroll
                    for (int i = 0; i < 2; ++i) {
                        const f32x4 x = rb[b & 1][gg][bj][i] + *(const f32x4*)(wl + (rl + 8 * i) * 36 + ch * 4);
                        const size_t off = (size_t)(row0 + 8 * i) * 1024 + cbase + bj * HALF;
                        u32x2 w; w.x = pkh(x[0], x[1]); w.y = pkh(x[2], x[3]); *(u32x2*)(X16 + off) = w;
                        sq[i] += (x[0] * x[0] + x[1] * x[1]) + (x[2] * x[2] + x[3] * x[3]);
                    }
                    asm volatile("s_waitcnt lgkmcnt(0)" ::: "memory");
                }
#pragma unroll
                for (int i = 0; i < 2; ++i) { float t = sq[i]; t += __shfl_xor(t, 1); t += __shfl_xor(t, 2); t += __shfl_xor(t, 4);
                    if (ch == 0) ss[(size_t)(row0 + 8 * i) * 16 + u.pn * 4 + wc] = t; }
            }
        }
#undef RES_LOAD
    }
};
struct EpiScale {
    static constexpr bool PERM = true, AFTER_DRAIN = false, F16 = (RES_FP16 != 0);
    const float* ss; bf16_t* O; int ldc;
    __device__ __forceinline__ void operator()(const f32x4 (&acc)[2][2][4][2], const Unit& u, int wr, int wc, int fr, int fq) const {
        float rsv[2][4]; load_rstd8<16>(ss, u, wr, fr, fq, 1.0f / 1024.0f, rsv);
        typedef unsigned u32x4_ __attribute__((ext_vector_type(4)));
#pragma unroll
        for (int ai = 0; ai < 2; ++ai)
#pragma unroll
            for (int m = 0; m < 4; ++m) {
                const int row = u.pm * BM + ai * HALF + wr * 64 + m * 16 + fr;
                const float rs = rsv[ai][m];
#pragma unroll
                for (int bj = 0; bj < 2; ++bj) {
                    const u32x2 lo = pack4(acc[ai][bj][m][0] * rs), hi = pack4(acc[ai][bj][m][1] * rs);
                    *(u32x4_*)(O + (size_t)row * ldc + u.pn * BM + bj * HALF + wc * 32 + fq * 8) = (u32x4_){lo.x, lo.y, hi.x, hi.y};
                }
            }
    }
};
struct EpiInAB {
    static constexpr bool PERM = false, AFTER_DRAIN = false, F16 = (RES_FP16 != 0);
    const float* ss; bf16_t* AQKV; bf16_t* CQ; bf16_t* CKV; bf16_t* KM; float* ssq; float* sskv; const float* rope;
    __device__ __forceinline__ void operator()(const f32x4 (&acc)[2][2][4][2], const Unit& u, int wr, int wc, int fr, int fq) const {
        float rsv[2][4]; load_rstd8<16>(ss, u, wr, fr, fq, 1.0f / 1024.0f, rsv);
#pragma unroll
        for (int ai = 0; ai < 2; ++ai)
#pragma unroll
            for (int m = 0; m < 4; ++m) {
                asm volatile("" ::: "memory"); const int row = u.pm * BM + ai * HALF + wr * 64 + m * 16 + fr;
                const float rs = rsv[ai][m];
                if (u.pn < 6) {
#pragma unroll
                    for (int bj = 0; bj < 2; ++bj)
#pragma unroll
                        for (int n = 0; n < 2; ++n)
                            *(u32x2*)(AQKV + (size_t)row * 1536 + u.pn * BM + bj * HALF + wc * 32 + n * 16 + fq * 4) = pack4(acc[ai][bj][m][n] * rs);
                } else if (u.pn == 6) {
                    float s = 0.f;
#pragma unroll
                    for (int bj = 0; bj < 2; ++bj)
#pragma unroll
                        for (int n = 0; n < 2; ++n) { const f32x4 x = acc[ai][bj][m][n] * rs;
                            *(u32x2*)(CQ + (size_t)row * 256 + bj * HALF + wc * 32 + n * 16 + fq * 4) = pack4(x);
                            s += (x[0] * x[0] + x[1] * x[1]) + (x[2] * x[2] + x[3] * x[3]); }
                    s = quad_sum(s);
                    if (fq == 0) ssq[(size_t)row * 4 + wc] = s;
                } else {
                    float s = 0.f;
#pragma unroll
                    for (int n = 0; n < 2; ++n) { const f32x4 x = acc[ai][0][m][n] * rs;
                        *(u32x2*)(CKV + (size_t)row * 128 + wc * 32 + n * 16 + fq * 4) = pack4(x);
                        s += (x[0] * x[0] + x[1] * x[1]) + (x[2] * x[2] + x[3] * x[3]); }
                    s = quad_sum(s);
                    if (fq == 0) sskv[(size_t)row * 4 + wc] = s;
                    if (wc == 0) {
                        const f32x4 x1 = acc[ai][1][m][0] * rs, x2 = acc[ai][1][m][1] * rs;
                        const int pos = row & 2047;
                        const f32x4 c = *(const f32x4*)(rope + pos * 32 + fq * 4), sn = *(const f32x4*)(rope + pos * 32 + 16 + fq * 4);
                        const u32x2 o1 = pack4(x1 * c - x2 * sn), o2 = pack4(x1 * sn + x2 * c);
#pragma unroll
                        for (int h = 0; h < 8; ++h) { bf16_t* kp = KM + (size_t)row * 768 + h * 96 + 64 + fq * 4; *(u32x2*)kp = o1; *(u32x2*)(kp + 16) = o2; }
                    }
                }
            }
    }
};
struct EpiUQ {
    static constexpr bool PERM = false, AFTER_DRAIN = false, F16 = false;
    const float* ssq; bf16_t* Q; const float* rope;
    __device__ __forceinline__ void operator()(const f32x4 (&acc)[2][2][4][2], const Unit& u, int wr, int wc, int fr, int fq) const {
        float rsv[2][4]; load_rstd8<4>(ssq, u, wr, fr, fq, 1.0f / 256.0f, rsv);
        f32x4 rc[2][4], rsn[2][4];
#pragma unroll
        for (int ai = 0; ai < 2; ++ai)
#pragma unroll
            for (int m = 0; m < 4; ++m) { const int pos = (u.pm * BM + ai * HALF + wr * 64 + m * 16 + fr) & 2047;
                rc[ai][m] = *(const f32x4*)(rope + pos * 32 + fq * 4); rsn[ai][m] = *(const f32x4*)(rope + pos * 32 + 16 + fq * 4); }
#pragma unroll
        for (int ai = 0; ai < 2; ++ai)
#pragma unroll
            for (int m = 0; m < 4; ++m) {
                const int row = u.pm * BM + ai * HALF + wr * 64 + m * 16 + fr;
                const float rs = rsv[ai][m];
#pragma unroll
                for (int bj = 0; bj < 2; ++bj) {
                    const int cb = u.pn * BM + bj * HALF + wc * 32;
                    f32x4 x1 = acc[ai][bj][m][0] * rs, x2 = acc[ai][bj][m][1] * rs;
                    if ((cb % 96) == 64) { const f32x4 c = rc[ai][m], sn = rsn[ai][m]; const f32x4 y1 = x1 * c - x2 * sn, y2 = x1 * sn + x2 * c; x1 = y1; x2 = y2; }
                    bf16_t* qp = Q + (size_t)row * 768 + cb + fq * 4; *(u32x2*)qp = pack4(x1); *(u32x2*)(qp + 16) = pack4(x2);
                }
            }
    }
};
struct EpiUKV {
    static constexpr bool PERM = false, AFTER_DRAIN = false, F16 = false;
    const float* sskv; bf16_t* KM; bf16_t* VM;
    __device__ __forceinline__ void operator()(const f32x4 (&acc)[2][2][4][2], const Unit& u, int wr, int wc, int fr, int fq) const {
        float rsv[2][4]; load_rstd8<4>(sskv, u, wr, fr, fq, 1.0f / 128.0f, rsv);
#pragma unroll
        for (int ai = 0; ai < 2; ++ai)
#pragma unroll
            for (int m = 0; m < 4; ++m) {
                asm volatile("" ::: "memory"); const int row = u.pm * BM + ai * HALF + wr * 64 + m * 16 + fr;
                const float rs = rsv[ai][m];
#pragma unroll
                for (int bj = 0; bj < 2; ++bj) {
                    const int cb = u.pn * BM + bj * HALF + wc * 32, h = cb >> 7, w = cb & 127;
                    bf16_t* p = (w < 64) ? (KM + (size_t)row * 768 + h * 96 + w + fq * 4) : (VM + (size_t)row * 512 + h * 64 + (w - 64) + fq * 4);
                    *(u32x2*)p = pack4(acc[ai][bj][m][0] * rs); *(u32x2*)(p + 16) = pack4(acc[ai][bj][m][1] * rs);
                }
            }
    }
};

struct EpiNull {
    static constexpr bool PERM = false, AFTER_DRAIN = false, F16 = false;
    __device__ __forceinline__ void operator()(const f32x4 (&acc)[2][2][4][2], const Unit& u, int wr, int wc, int fr, int fq) const {
#pragma unroll
        for (int ai = 0; ai < 2; ++ai)
#pragma unroll
            for (int bj = 0; bj < 2; ++bj)
#pragma unroll
                for (int m = 0; m < 4; ++m)
#pragma unroll
                    for (int n = 0; n < 2; ++n) asm volatile("" :: "v"(acc[ai][bj][m][n]));
    }
};
template <class Epi, class Sched, bool ALIGN_EPI = false, bool SP2 = false>
__device__ __forceinline__ void gemm_phase(PG8_LAS unsigned char* lds, const Gemm g, const Sched& S, const Epi& E) {
    const int tid = opaque_tid(), wid = __builtin_amdgcn_readfirstlane(tid >> 6), lane = tid & 63, wr = wid >> 2, wc = wid & 3, fr = lane & 15, fq = lane >> 4;
    const int K = g.K, nt = K / BK;
    unsigned voffA[2], voffB[2];
#pragma unroll
    for (int i = 0; i < 2; ++i) { int R, C; stage_rc(tid * 16 + i * 8192, R, C); const int Rb = Epi::PERM ? ((R & ~31) + perm32(R & 31)) : R;
        voffA[i] = (unsigned)(R * K + C) * 2u; voffB[i] = (unsigned)(Rb * K + C) * 2u; }
    const size_t kstep = (size_t)(BK * 2);
    const size_t hstep = (size_t)HALF * K * 2;
    const size_t tstep = 2 * hstep;
    const unsigned ldsw = (unsigned)wid * 1024u;
    const int aoff = lds_byte(wr * 64 + fr, fq * 8), boff = lds_byte(wc * 32 + fr, fq * 8);
#define PG8_SA(b, h) (((b) * 2 + (h)) * HTB)
#define PG8_SB(b, h) ((4 + (b) * 2 + (h)) * HTB)
#define PG8_STAGE(bufoff, gbase, voff) do { _Pragma("unroll") for (int _i = 0; _i < 2; ++_i) \
        __builtin_amdgcn_global_load_lds((const unsigned*)((const char*)(gbase) + (voff)[_i]), (PG8_LAS unsigned*)(lds + (bufoff) + ldsw + _i * 8192), 16, 0, 0); } while (0)
#define PG8_LDA(dst, b, h) do { _Pragma("unroll") for (int m = 0; m < 4; ++m) _Pragma("unroll") for (int k = 0; k < 2; ++k) dst[m][k] = *(const PG8_LAS bf16x8*)(lds + PG8_SA(b, h) + aoff + m * 2048 + k * 1024); } while (0)
#define PG8_LDB(dst, b, h) do { _Pragma("unroll") for (int n = 0; n < 2; ++n) _Pragma("unroll") for (int k = 0; k < 2; ++k) dst[n][k] = *(const PG8_LAS bf16x8*)(lds + PG8_SB(b, h) + boff + n * 2048 + k * 1024); } while (0)
#define PG8_MMA(ai, bj, At, Bt) do { __builtin_amdgcn_s_setprio(1); _Pragma("unroll") for (int m = 0; m < 4; ++m) _Pragma("unroll") for (int n = 0; n < 2; ++n) _Pragma("unroll") for (int k = 0; k < 2; ++k) \
        acc[ai][bj][m][n] = mma16<Epi::F16>(Bt[n][k], At[m][k], acc[ai][bj][m][n]); __builtin_amdgcn_s_setprio(0); } while (0)
#define PG8_WAIT_V(n) asm volatile("s_waitcnt vmcnt(" #n ")" ::: "memory")
#define PG8_WAIT_L(n) asm volatile("s_waitcnt lgkmcnt(" #n ")" ::: "memory")
#define PG8_BAR __builtin_amdgcn_s_barrier()
#define PG8_SCHED __builtin_amdgcn_sched_barrier(0)
    Unit cur, nxt; int ui = 0;
    if (!S.next(0, cur)) return;
    f32x4 acc[2][2][4][2];
#pragma unroll
    for (int a = 0; a < 2; ++a)
#pragma unroll
        for (int b = 0; b < 2; ++b)
#pragma unroll
            for (int m = 0; m < 4; ++m)
#pragma unroll
                for (int n = 0; n < 2; ++n) acc[a][b][m][n] = (f32x4){0.f, 0.f, 0.f, 0.f};
    bf16x8 At[4][2], B0[2][2], B1[2][2];
    const char* cA = (const char*)g.A + (size_t)cur.pm * tstep; const char* cB = (const char*)g.Bt + (size_t)cur.pn * tstep;
    S.a_ready(cur);
    if constexpr (SP2) {
        PG8_STAGE(PG8_SB(0, 0), cB, voffB); PG8_STAGE(PG8_SB(0, 1), cB + hstep, voffB); PG8_STAGE(PG8_SA(0, 0), cA, voffA); PG8_STAGE(PG8_SA(0, 1), cA + hstep, voffA);
        if (wr == 1) PG8_BAR;
        PG8_WAIT_V(2); PG8_BAR;
        PG8_STAGE(PG8_SB(1, 0), cB + kstep, voffB); PG8_STAGE(PG8_SA(1, 0), cA + kstep, voffA); PG8_STAGE(PG8_SB(1, 1), cB + hstep + kstep, voffB);
        PG8_WAIT_V(6); PG8_BAR;
    } else {
        PG8_STAGE(PG8_SB(0, 0), cB, voffB); PG8_STAGE(PG8_SA(0, 0), cA, voffA); PG8_STAGE(PG8_SB(0, 1), cB + hstep, voffB); PG8_STAGE(PG8_SA(0, 1), cA + hstep, voffA);
        if (wr == 1) PG8_BAR;
        PG8_WAIT_V(4); PG8_BAR;
        PG8_STAGE(PG8_SB(1, 0), cB + kstep, voffB); PG8_STAGE(PG8_SA(1, 0), cA + kstep, voffA); PG8_STAGE(PG8_SB(1, 1), cB + hstep + kstep, voffB);
        PG8_WAIT_V(6); PG8_BAR;
    }
    for (;;) {
        const bool has_next = S.next(ui + 1, nxt);
        const char* nA = has_next ? (const char*)g.A + (size_t)nxt.pm * tstep : cA; const char* nB = has_next ? (const char*)g.Bt + (size_t)nxt.pn * tstep : cB;
        for (int t = 0; t < nt; t += 2) {
            const bool last = (t == nt - 2);
            const char* a1 = cA + (size_t)(t + 1) * kstep;
            const char* a2 = last ? nA : cA + (size_t)(t + 2) * kstep; const char* b2 = last ? nB : cB + (size_t)(t + 2) * kstep;
            const char* a3 = a2 + kstep; const char* b3 = b2 + kstep;
            if (last && has_next) S.a_ready(nxt);
            if constexpr (SP2) {
            PG8_LDB(B0, 0, 0); PG8_LDB(B1, 0, 1); PG8_SCHED; PG8_LDA(At, 0, 0); PG8_STAGE(PG8_SA(1, 1), a1 + hstep, voffA);
            PG8_WAIT_V(8); PG8_WAIT_L(0); PG8_BAR; PG8_MMA(0, 0, At, B0); PG8_MMA(0, 1, At, B1); PG8_BAR; PG8_SCHED;
            PG8_LDA(At, 0, 1); PG8_STAGE(PG8_SB(0, 0), b2, voffB); PG8_STAGE(PG8_SB(0, 1), b2 + hstep, voffB); PG8_STAGE(PG8_SA(0, 0), a2, voffA);
            PG8_WAIT_V(8); PG8_WAIT_L(0); PG8_BAR; PG8_MMA(1, 0, At, B0); PG8_MMA(1, 1, At, B1); PG8_BAR; PG8_SCHED;
            PG8_LDB(B0, 1, 0); PG8_LDB(B1, 1, 1); PG8_SCHED; PG8_LDA(At, 1, 0); PG8_STAGE(PG8_SA(0, 1), a2 + hstep, voffA);
            PG8_WAIT_V(8); PG8_WAIT_L(0); PG8_BAR; PG8_MMA(0, 0, At, B0); PG8_MMA(0, 1, At, B1); PG8_BAR; PG8_SCHED;
            PG8_LDA(At, 1, 1); PG8_STAGE(PG8_SB(1, 0), b3, voffB); PG8_STAGE(PG8_SB(1, 1), b3 + hstep, voffB); PG8_STAGE(PG8_SA(1, 0), a3, voffA);
            PG8_WAIT_V(8); PG8_WAIT_L(0); PG8_BAR; PG8_MMA(1, 0, At, B0); PG8_MMA(1, 1, At, B1); PG8_BAR; PG8_SCHED;
            } else {
            PG8_LDB(B0, 0, 0); PG8_SCHED; PG8_LDA(At, 0, 0); PG8_STAGE(PG8_SA(1, 1), a1 + hstep, voffA);
            PG8_WAIT_L(8); PG8_BAR; PG8_WAIT_L(0); PG8_MMA(0, 0, At, B0); PG8_BAR; PG8_SCHED;
            PG8_LDB(B1, 0, 1); PG8_STAGE(PG8_SB(0, 0), b2, voffB);
            PG8_BAR; PG8_WAIT_L(0); PG8_MMA(0, 1, At, B1); PG8_BAR;
            PG8_LDA(At, 0, 1); PG8_STAGE(PG8_SA(0, 0), a2, voffA);
            PG8_BAR; PG8_WAIT_L(0); PG8_MMA(1, 0, At, B0); PG8_BAR; PG8_SCHED;
            PG8_STAGE(PG8_SB(0, 1), b2 + hstep, voffB);
            PG8_WAIT_V(6); PG8_BAR; PG8_MMA(1, 1, At, B1); PG8_BAR;
            PG8_LDB(B0, 1, 0); PG8_SCHED; PG8_LDA(At, 1, 0); PG8_STAGE(PG8_SA(0, 1), a2 + hstep, voffA);
            PG8_WAIT_L(8); PG8_BAR; PG8_WAIT_L(0); PG8_MMA(0, 0, At, B0); PG8_BAR; PG8_SCHED;
            PG8_LDB(B1, 1, 1); PG8_STAGE(PG8_SB(1, 0), b3, voffB);
            PG8_BAR; PG8_WAIT_L(0); PG8_MMA(0, 1, At, B1); PG8_BAR;
            PG8_LDA(At, 1, 1); PG8_STAGE(PG8_SA(1, 0), a3, voffA);
            PG8_BAR; PG8_WAIT_L(0); PG8_MMA(1, 0, At, B0); PG8_BAR; PG8_SCHED;
            PG8_STAGE(PG8_SB(1, 1), b3 + hstep, voffB);
            PG8_WAIT_V(6); PG8_BAR; PG8_MMA(1, 1, At, B1); PG8_BAR;
            }
        }
        if constexpr (ALIGN_EPI) { if (wr == 0) PG8_BAR; }
        if constexpr (!Epi::AFTER_DRAIN) { E(acc, cur, wr, wc, fr, fq); S.done(cur); }
        if (!has_next) break;
#pragma unroll
        for (int a = 0; a < 2; ++a)
#pragma unroll
            for (int b = 0; b < 2; ++b)
#pragma unroll
                for (int m = 0; m < 4; ++m)
#pragma unroll
                    for (int n = 0; n < 2; ++n) acc[a][b][m][n] = (f32x4){0.f, 0.f, 0.f, 0.f};
        cur = nxt; cA = nA; cB = nB; ++ui;
        if constexpr (ALIGN_EPI) { if (wr == 1) PG8_BAR; }
    }
    PG8_WAIT_V(0);
    if constexpr (!ALIGN_EPI) { if (wr == 0) PG8_BAR; }
    PG8_BAR;
    if constexpr (Epi::AFTER_DRAIN) { E.fused(acc, cur, wr, wc, fr, fq, lds, wid, lane); S.done(cur); }
#undef PG8_SA
#undef PG8_SB
#undef PG8_STAGE
#undef PG8_LDA
#undef PG8_LDB
#undef PG8_MMA
#undef PG8_WAIT_V
#undef PG8_WAIT_L
#undef PG8_BAR
#undef PG8_SCHED
}
}
namespace att {
typedef unsigned short bf16_t;
typedef short bf16x8 __attribute__((ext_vector_type(8)));
typedef short s16x4 __attribute__((ext_vector_type(4)));
typedef float f32x16 __attribute__((ext_vector_type(16)));
typedef float f32x4 __attribute__((ext_vector_type(4)));
typedef unsigned u32x4 __attribute__((ext_vector_type(4)));
typedef unsigned u32x2 __attribute__((ext_vector_type(2)));
#define ATT_LAS __attribute__((address_space(3)))
typedef ATT_LAS const char* lds_cptr;
typedef ATT_LAS char* lds_ptr;
constexpr float kLog2e = 1.4426950408889634f;
__device__ __forceinline__ int crow(int r, int hi) { return (r & 3) + 8 * (r >> 2) + 4 * hi; }
__device__ __forceinline__ unsigned cvtpk(float lo, float hi) { unsigned r; asm volatile("v_cvt_pk_bf16_f32 %0, %1, %2" : "=v"(r) : "v"(lo), "v"(hi)); return r; }
__device__ __forceinline__ s16x4 vtr(lds_cptr p) { return __builtin_bit_cast(s16x4, __builtin_amdgcn_ds_read_tr16_b64_v4i16((ATT_LAS s16x4*)p)); }
__device__ __forceinline__ bf16x8 cat8(s16x4 lo, s16x4 hi) { return (bf16x8){lo[0], lo[1], lo[2], lo[3], hi[0], hi[1], hi[2], hi[3]}; }
__device__ __forceinline__ bf16x8 packp(const f32x16& p, int b) {
    u32x4 w; w.x = cvtpk(p[b], p[b + 1]); w.y = cvtpk(p[b + 2], p[b + 3]); w.z = cvtpk(p[b + 4], p[b + 5]); w.w = cvtpk(p[b + 6], p[b + 7]);
    return __builtin_bit_cast(bf16x8, w);
}
__device__ __forceinline__ float max16(const f32x16& p) {
    float a = fmaxf(fmaxf(p[0], p[1]), fmaxf(p[2], p[3])), b = fmaxf(fmaxf(p[4], p[5]), fmaxf(p[6], p[7]));
    float c = fmaxf(fmaxf(p[8], p[9]), fmaxf(p[10], p[11])), d = fmaxf(fmaxf(p[12], p[13]), fmaxf(p[14], p[15]));
    return fmaxf(fmaxf(a, b), fmaxf(c, d));
}
__device__ __forceinline__ float sum16(const f32x16& p) {
    return ((p[0] + p[1]) + (p[2] + p[3])) + ((p[4] + p[5]) + (p[6] + p[7])) + (((p[8] + p[9]) + (p[10] + p[11])) + ((p[12] + p[13]) + (p[14] + p[15])));
}
template <int KEYS> __device__ __forceinline__ void pv_tile(f32x16 (&o)[2], lds_cptr vbase, const bf16x8 (&pf)[KEYS / 16], int lane) {
    const int hi = lane >> 5, li = lane & 15;
    lds_cptr vp = vbase + (4 * hi + (li >> 2)) * 64 + ((lane >> 4) & 1) * 32 + (lane & 3) * 8;
#pragma unroll
    for (int d0 = 0; d0 < 2; ++d0)
#pragma unroll
        for (int ks = 0; ks < KEYS / 16; ++ks) {
            const s16x4 lo = vtr(vp + d0 * (KEYS * 64) + ks * 1024), hh = vtr(vp + d0 * (KEYS * 64) + ks * 1024 + 512);
            o[d0] = __builtin_amdgcn_mfma_f32_32x32x16_bf16(cat8(lo, hh), pf[ks], o[d0], 0, 0, 0);
        }
}
__device__ __forceinline__ void store_o(const f32x16 (&o)[2], float sc, bf16_t* orow, int hi) {
#pragma unroll
    for (int d0 = 0; d0 < 2; ++d0)
#pragma unroll
        for (int g = 0; g < 4; ++g) {
            u32x2 w; w.x = cvtpk(o[d0][4 * g] * sc, o[d0][4 * g + 1] * sc); w.y = cvtpk(o[d0][4 * g + 2] * sc, o[d0][4 * g + 3] * sc);
            *(u32x2*)(orow + d0 * 32 + g * 8 + hi * 4) = w;
        }
}

template <int DK> struct AttL { static constexpr int KS = DK * 2 + 16, KB = 64 * KS, VB = 8192, BUF = KB + VB, TOTAL = 2 * BUF; };
template <int DK, int MODE>
__device__ __forceinline__ void attn_unit(const bf16_t* Q, int ldq, const bf16_t* K, int ldk, const bf16_t* V, int ldv, bf16_t* O, int ldo, int qb, char* shm, float sc) {
    typedef AttL<DK> L;
    constexpr int NS = DK / 16, CPR = DK / 8;
    const int tid = opaque_tid(), lane = tid & 63, r32 = lane & 31, hi = lane >> 5; const int wid = __builtin_amdgcn_readfirstlane(tid >> 6);
    const int qpos = qb * 256 + wid * 32 + r32;
    bf16x8 qf[NS];
#pragma unroll
    for (int s = 0; s < NS; ++s) qf[s] = *(const bf16x8*)(Q + (size_t)qpos * ldq + s * 16 + hi * 8);
    const int kc0 = tid, kkey0 = kc0 / CPR, kch0 = kc0 % CPR;
    const int kc1 = 512 + tid, kkey1 = kc1 / CPR, kch1 = kc1 % CPR; const bool k2 = (DK == 96) && (tid < 256);
    const int vkey = tid >> 3, vch = tid & 7;
    const int voff = (vch >> 2) * 4096 + vkey * 64 + (vch & 3) * 16;
    const int nt = 4 * (qb + 1);
    f32x16 o[2]; o[0] = f32x16{}; o[1] = f32x16{};
    constexpr float SB_SAT = 160.0f; float wminR = 0.f;
    float mrun = -1e30f, lrun = (MODE == 1) ? 1.f : 0.f;
    u32x4 kr0A, kr1A = u32x4{}, vrA, kr0B, kr1B = u32x4{}, vrB;
#define ATT_FETCH(KR0, KR1, VR, tt) do { const size_t kb_ = (size_t)(tt) * 64; \
        KR0 = *(const u32x4*)(K + (kb_ + kkey0) * ldk + kch0 * 8); \
        if (k2) KR1 = *(const u32x4*)(K + (kb_ + kkey1) * ldk + kch1 * 8); \
        VR = *(const u32x4*)(V + (kb_ + vkey) * ldv + vch * 8); } while (0)
#define ATT_TILE(i_) ((MODE == 0) ? (i_) : nt - 1 - (i_))
    ATT_FETCH(kr0A, kr1A, vrA, ATT_TILE(0)); ATT_FETCH(kr0B, kr1B, vrB, ATT_TILE(1));
    bool done = false;
#define ATT_STEP(it, KR0, KR1, VR) { \
        const int tt = ATT_TILE(it); \
        char* buf = shm + ((it) & 1) * L::BUF; \
        *(u32x4*)(buf + kkey0 * L::KS + kch0 * 16) = KR0; \
        if (k2) *(u32x4*)(buf + kkey1 * L::KS + kch1 * 16) = KR1; \
        *(u32x4*)(buf + L::KB + voff) = VR; \
        __syncthreads(); \
        if (MODE == 1 && (it) > 0) { \
            const float* fl = (const float*)(shm + L::TOTAL) + (((it) - 1) & 1) * 8; \
            const float mnr = fminf(fminf(fminf(fl[0], fl[1]), fminf(fl[2], fl[3])), fminf(fminf(fl[4], fl[5]), fminf(fl[6], fl[7]))); \
            if (mnr >= SB_SAT) done = true; \
        } \
        if (!done) { \
        ATT_FETCH(KR0, KR1, VR, ATT_TILE(((it) + 2 < nt) ? (it) + 2 : nt - 1)); \
        att_compute(it, tt, buf); } }
    auto att_compute = [&](int it, int tt, char* buf) __attribute__((always_inline)) {
        const int kbase = tt * 64;
        bool active = !(kbase > qb * 256 + wid * 32 + 31);
        if (MODE == 1) active = active && (wminR < SB_SAT);
        if (active) {
        f32x16 p0 = f32x16{}, p1 = f32x16{};
        const char* kp = buf + r32 * L::KS + hi * 16;
#pragma unroll
        for (int s = 0; s < NS; ++s) {
            const bf16x8 a0 = *(const bf16x8*)(kp + s * 32), a1 = *(const bf16x8*)(kp + 32 * L::KS + s * 32);
            p0 = __builtin_amdgcn_mfma_f32_32x32x16_bf16(a0, qf[s], p0, 0, 0, 0);
            p1 = __builtin_amdgcn_mfma_f32_32x32x16_bf16(a1, qf[s], p1, 0, 0, 0);
        }
        const bool diag = (kbase + 63 >= qb * 256 + wid * 32);
        bf16x8 pf[4];
        if (MODE == 0) {
#pragma unroll
            for (int r = 0; r < 16; ++r) { p0[r] *= sc; p1[r] *= sc; }
            if (diag) {
#pragma unroll
                for (int r = 0; r < 16; ++r) { const int key = kbase + crow(r, hi); if (key > qpos) p0[r] = -INFINITY; if (key + 32 > qpos) p1[r] = -INFINITY; }
            }
            float rm = fmaxf(max16(p0), max16(p1)); rm = fmaxf(rm, __shfl_xor(rm, 32));
            const float mn = fmaxf(mrun, rm), f = __builtin_amdgcn_exp2f(mrun - mn); mrun = mn;
#pragma unroll
            for (int r = 0; r < 16; ++r) { p0[r] = __builtin_amdgcn_exp2f(p0[r] - mn); p1[r] = __builtin_amdgcn_exp2f(p1[r] - mn); }
            lrun = lrun * f + (sum16(p0) + sum16(p1));
#pragma unroll
            for (int r = 0; r < 16; ++r) { o[0][r] *= f; o[1][r] *= f; }
        } else {
            f32x16 om0, om1;
#pragma unroll
            for (int r = 0; r < 16; ++r) {
                const float e0 = __builtin_amdgcn_exp2f(-fmaxf(p0[r] * sc, -100.f)), e1 = __builtin_amdgcn_exp2f(-fmaxf(p1[r] * sc, -100.f));
                const float s0 = __builtin_amdgcn_rcpf(1.0f + e0), s1 = __builtin_amdgcn_rcpf(1.0f + e1);
                om0[r] = e0 * s0; om1[r] = e1 * s1; p0[r] = s0; p1[r] = s1;
            }
            if (diag) {
#pragma unroll
                for (int r = 0; r < 16; ++r) { const int key = kbase + crow(r, hi);
                    if (key >= qpos) { om0[r] = 1.f; p0[r] = 0.f; } if (key + 32 >= qpos) { om1[r] = 1.f; p1[r] = 0.f; } }
            }
            float gs[8], og[8];
#pragma unroll
            for (int g = 0; g < 4; ++g) { gs[g] = (om0[4 * g] * om0[4 * g + 1]) * (om0[4 * g + 2] * om0[4 * g + 3]); gs[4 + g] = (om1[4 * g] * om1[4 * g + 1]) * (om1[4 * g + 2] * om1[4 * g + 3]); }
#pragma unroll
            for (int g = 0; g < 8; ++g) og[g] = __shfl_xor(gs[g], 32);
            float suf = lrun;
#pragma unroll
            for (int g = 7; g >= 0; --g) {
                const float T = suf * (hi == 0 ? og[g] : 1.f);
                f32x16& om = (g < 4) ? om0 : om1; f32x16& pp = (g < 4) ? p0 : p1; const int b = 4 * (g & 3);
                const float l3 = T, l2 = l3 * om[b + 3], l1 = l2 * om[b + 2], l0 = l1 * om[b + 1];
                pp[b + 3] *= l3; pp[b + 2] *= l2; pp[b + 1] *= l1; pp[b] *= l0;
                suf *= gs[g] * og[g];
            }
            lrun = suf;
        }
        pf[0] = packp(p0, 0); pf[1] = packp(p0, 8); pf[2] = packp(p1, 0); pf[3] = packp(p1, 8);
        pv_tile<64>(o, (lds_cptr)(buf + L::KB), pf, lane);
        }
        if (MODE == 1) {
            float w = lrun;
#pragma unroll
            for (int sh = 1; sh < 32; sh <<= 1) w = fmaxf(w, __shfl_xor(w, sh));
            w = (w > 0.f) ? 0.f : 1000.f;
            wminR = __builtin_bit_cast(float, __builtin_amdgcn_readfirstlane(__builtin_bit_cast(int, w)));
            if (lane == 0) ((float*)(shm + L::TOTAL))[(it & 1) * 8 + wid] = wminR;
        }
    };
    for (int it = 0; it < nt && !done; it += 2) {
        ATT_STEP(it, kr0A, kr1A, vrA)
        if (done) break;
        ATT_STEP(it + 1, kr0B, kr1B, vrB)
    }
#undef ATT_STEP
#undef ATT_TILE
#undef ATT_FETCH
    float scl = 1.0f;
    if (MODE == 0) { const float lt = lrun + __shfl_xor(lrun, 32); scl = 1.0f / lt; }
    store_o(o, scl, O + (size_t)qpos * ldo, hi);
}

__device__ __forceinline__ void sb_unit_big(const bf16_t* Q, const bf16_t* K, const bf16_t* V, int ld, bf16_t* O, int ldo, int qb, char* shm, int maxch) {
    constexpr int KS = 144, KSUB = 64 * KS, KB = 4 * KSUB, VSUB = 8192, BUF = KB + 4 * VSUB, TOTAL = 2 * BUF;
    const int tid = opaque_tid(), lane = tid & 63, r32 = lane & 31, hi = lane >> 5; const int wid = __builtin_amdgcn_readfirstlane(tid >> 6);
    const float sc = 0.125f * kLog2e;
    const int qpos = qb * 256 + wid * 32 + r32;
    bf16x8 qf[4];
#pragma unroll
    for (int s = 0; s < 4; ++s) qf[s] = *(const bf16x8*)(Q + (size_t)qpos * ld + s * 16 + hi * 8);
    const int lkey = tid >> 3, lch = tid & 7;
    const int koff = lkey * KS + lch * 16, voff = KB + (lch >> 2) * 4096 + lkey * 64 + (lch & 3) * 16;
    f32x16 o[2]; o[0] = f32x16{}; o[1] = f32x16{};
    float carry = 1.f; bool wsat = false;
    u32x4 kr[4], vr[4];
#define SBB_FETCH(c) do { const size_t cb_ = (size_t)(c) * 256 + lkey; \
        _Pragma("unroll") for (int i = 0; i < 4; ++i) { kr[i] = *(const u32x4*)(K + (cb_ + 64 * i) * ld + lch * 8); vr[i] = *(const u32x4*)(V + (cb_ + 64 * i) * ld + lch * 8); } } while (0)
    auto sub_compute = [&](int kbase, const char* kt, const char* vt) __attribute__((always_inline)) {
        f32x16 p0 = f32x16{}, p1 = f32x16{};
        const char* kp = kt + r32 * KS + hi * 16;
#pragma unroll
        for (int s = 0; s < 4; ++s) {
            const bf16x8 a0 = *(const bf16x8*)(kp + s * 32), a1 = *(const bf16x8*)(kp + 32 * KS + s * 32);
            p0 = __builtin_amdgcn_mfma_f32_32x32x16_bf16(a0, qf[s], p0, 0, 0, 0);
            p1 = __builtin_amdgcn_mfma_f32_32x32x16_bf16(a1, qf[s], p1, 0, 0, 0);
        }
        f32x16 om0, om1;
#pragma unroll
        for (int r = 0; r < 16; ++r) {
            const float e0 = __builtin_amdgcn_exp2f(-fmaxf(p0[r] * sc, -100.f)), e1 = __builtin_amdgcn_exp2f(-fmaxf(p1[r] * sc, -100.f));
            const float s0 = __builtin_amdgcn_rcpf(1.0f + e0), s1 = __builtin_amdgcn_rcpf(1.0f + e1);
            om0[r] = e0 * s0; om1[r] = e1 * s1; p0[r] = s0; p1[r] = s1;
        }
        if (kbase + 63 >= qb * 256 + wid * 32) {
#pragma unroll
            for (int r = 0; r < 16; ++r) { const int key = kbase + crow(r, hi);
                if (key >= qpos) { om0[r] = 1.f; p0[r] = 0.f; } if (key + 32 >= qpos) { om1[r] = 1.f; p1[r] = 0.f; } }
        }
        float gs[8], og[8];
#pragma unroll
        for (int g = 0; g < 4; ++g) { gs[g] = (om0[4 * g] * om0[4 * g + 1]) * (om0[4 * g + 2] * om0[4 * g + 3]); gs[4 + g] = (om1[4 * g] * om1[4 * g + 1]) * (om1[4 * g + 2] * om1[4 * g + 3]); }
#pragma unroll
        for (int g = 0; g < 8; ++g) og[g] = __shfl_xor(gs[g], 32);
        float suf = carry;
#pragma unroll
        for (int g = 7; g >= 0; --g) {
            const float T = suf * (hi == 0 ? og[g] : 1.f);
            f32x16& om = (g < 4) ? om0 : om1; f32x16& pp = (g < 4) ? p0 : p1; const int b = 4 * (g & 3);
            const float l3 = T, l2 = l3 * om[b + 3], l1 = l2 * om[b + 2], l0 = l1 * om[b + 1];
            pp[b + 3] *= l3; pp[b + 2] *= l2; pp[b + 1] *= l1; pp[b] *= l0;
            suf *= gs[g] * og[g];
        }
        carry = suf;
        bf16x8 pf[4]; pf[0] = packp(p0, 0); pf[1] = packp(p0, 8); pf[2] = packp(p1, 0); pf[3] = packp(p1, 8);
        pv_tile<64>(o, (lds_cptr)vt, pf, lane);
        wsat = !__any(carry > 0.f);
    };
    const int nch = (qb + 1 < maxch) ? qb + 1 : maxch;
    SBB_FETCH(qb);
    for (int it = 0; it < nch; ++it) {
        char* buf = shm + (it & 1) * BUF;
#pragma unroll
        for (int i = 0; i < 4; ++i) { *(u32x4*)(buf + i * KSUB + koff) = kr[i]; *(u32x4*)(buf + i * VSUB + voff) = vr[i]; }
        __syncthreads();
        if (it > 0) {
            const float* fl = (const float*)(shm + TOTAL) + ((it - 1) & 1) * 8;
            const float mnr = fminf(fminf(fminf(fl[0], fl[1]), fminf(fl[2], fl[3])), fminf(fminf(fl[4], fl[5]), fminf(fl[6], fl[7])));
            if (mnr > 0.5f) break;
        }
        if (it + 1 < nch) SBB_FETCH(qb - it - 1);
        const int cbase = (qb - it) * 256;
#pragma unroll 1
        for (int sub = 3; sub >= 0; --sub) {
            const int kbase = cbase + 64 * sub;
            if (!(kbase > qb * 256 + wid * 32 + 31) && !wsat) sub_compute(kbase, buf + sub * KSUB, buf + KB + sub * VSUB);
        }
        if (lane == 0) ((float*)(shm + TOTAL))[(it & 1) * 8 + wid] = wsat ? 1.f : 0.f;
    }
#undef SBB_FETCH
    store_o(o, 1.0f, O + (size_t)qpos * ldo, hi);
    __syncthreads();
}

__device__ __forceinline__ void sb_wave_unit(const bf16_t* Q, const bf16_t* K, const bf16_t* V, int ld, bf16_t* O, int ldo, int q0, char* wl, int lane) {
    const int r32 = lane & 31, hi = lane >> 5;
    const float sc = 0.125f * kLog2e;
    const int qpos = q0 + r32;
    bf16x8 qf[4];
#pragma unroll
    for (int s = 0; s < 4; ++s) qf[s] = *(const bf16x8*)(Q + (size_t)qpos * ld + s * 16 + hi * 8);
    f32x16 o[2]; o[0] = f32x16{}; o[1] = f32x16{};
    float carry = 1.f;
#define SBW_LOAD(j, KF, VR) do { const size_t kb_ = (size_t)(j) * 32; \
        _Pragma("unroll") for (int s = 0; s < 4; ++s) KF[s] = *(const bf16x8*)(K + (kb_ + r32) * ld + s * 16 + hi * 8); \
        _Pragma("unroll") for (int c4 = 0; c4 < 4; ++c4) VR[c4] = *(const u32x4*)(V + (kb_ + (lane >> 3) + 8 * c4) * ld + (lane & 7) * 8); } while (0)
#define SBW_TILE(j, KF, VR) do { const int kbase = (j) * 32; \
        asm volatile("s_waitcnt lgkmcnt(0)" ::: "memory"); \
        _Pragma("unroll") for (int c4 = 0; c4 < 4; ++c4) { const int key = (lane >> 3) + 8 * c4, ch = lane & 7; \
            *(u32x4*)(wl + (ch >> 2) * 2048 + key * 64 + (ch & 3) * 16) = VR[c4]; } \
        f32x16 p = f32x16{}; \
        _Pragma("unroll") for (int s = 0; s < 4; ++s) p = __builtin_amdgcn_mfma_f32_32x32x16_bf16(KF[s], qf[s], p, 0, 0, 0); \
        f32x16 om; \
        _Pragma("unroll") for (int r = 0; r < 16; ++r) { \
            const float e = __builtin_amdgcn_exp2f(-fmaxf(p[r] * sc, -100.f)); const float sg = __builtin_amdgcn_rcpf(1.0f + e); \
            om[r] = e * sg; p[r] = sg; } \
        if (kbase + 31 >= q0) { \
            _Pragma("unroll") for (int r = 0; r < 16; ++r) { if (kbase + crow(r, hi) >= qpos) { om[r] = 1.f; p[r] = 0.f; } } } \
        float gs[4], og[4]; \
        _Pragma("unroll") for (int g = 0; g < 4; ++g) gs[g] = (om[4 * g] * om[4 * g + 1]) * (om[4 * g + 2] * om[4 * g + 3]); \
        _Pragma("unroll") for (int g = 0; g < 4; ++g) og[g] = __shfl_xor(gs[g], 32); \
        float suf = carry; \
        _Pragma("unroll") for (int g = 3; g >= 0; --g) { \
            const float T = suf * (hi == 0 ? og[g] : 1.f); const int b = 4 * g; \
            const float l3 = T, l2 = l3 * om[b + 3], l1 = l2 * om[b + 2], l0 = l1 * om[b + 1]; \
            p[b + 3] *= l3; p[b + 2] *= l2; p[b + 1] *= l1; p[b] *= l0; \
            suf *= gs[g] * og[g]; } \
        carry = suf; \
        bf16x8 pf[2]; pf[0] = packp(p, 0); pf[1] = packp(p, 8); \
        asm volatile("s_waitcnt lgkmcnt(0)" ::: "memory"); \
        pv_tile<32>(o, (lds_cptr)wl, pf, lane); } while (0)
    bf16x8 kfA[4], kfB[4], kfC[4]; u32x4 vrA[4], vrB[4], vrC[4];
    int j = (q0 + 30) >> 5;
#define SBW_CL(x) ((x) < 0 ? 0 : (x))
    SBW_LOAD(j, kfA, vrA);
    SBW_LOAD(SBW_CL(j - 1), kfB, vrB);
    for (;;) {
        SBW_LOAD(SBW_CL(j - 2), kfC, vrC);
        SBW_TILE(j, kfA, vrA);
        if (j < 1 || !__any(carry > 0.f)) break;
        SBW_LOAD(SBW_CL(j - 3), kfA, vrA);
        SBW_TILE(j - 1, kfB, vrB);
        if (j < 2 || !__any(carry > 0.f)) break;
        SBW_LOAD(SBW_CL(j - 4), kfB, vrB);
        SBW_TILE(j - 2, kfC, vrC);
        if (j < 3 || !__any(carry > 0.f)) break;
        j -= 3;
    }
#undef SBW_CL
#undef SBW_LOAD
#undef SBW_TILE
    asm volatile("s_waitcnt lgkmcnt(0)" ::: "memory");
    store_o(o, 1.0f, O + (size_t)qpos * ldo, hi);
}

__device__ __forceinline__ void dil_unit(const bf16_t* QKV, float* scr, bf16_t* O, int b, int h, int blk, char* shm) {
    const int tid = opaque_tid(), lane = tid & 63, r32 = lane & 31, hi = lane >> 5; const int wid = __builtin_amdgcn_readfirstlane(tid >> 6);
    const int T0 = blk * 512; const size_t rb = (size_t)b * 2048;
    const bf16_t* Qh = QKV + h * 64; const bf16_t* Kh = QKV + 512 + h * 64; const bf16_t* Vh = QKV + 1024 + h * 64;
    const float sc = 0.125f * kLog2e, slope2 = __builtin_amdgcn_exp2f(-(float)(h + 1)) * kLog2e;
    char* wl = shm + wid * 4096;
    float* sO = scr; float* sM = scr + 512 * 64; float* sL = sM + 512;
#pragma unroll 1
    for (int br = 0; br < 3; ++br) {
        const int lg = 2 * br, d = 1 << lg;
        const float sl = slope2 * (float)d;
#pragma unroll 1
        for (int rep = 0; rep < 2; ++rep) {
            const int k = wid + 8 * rep, res = k & (d - 1), c = k >> lg, tq0 = T0 + res + d * 32 * c;
            const int tq = tq0 + d * r32;
            bf16x8 qf[4];
#pragma unroll
            for (int s = 0; s < 4; ++s) qf[s] = *(const bf16x8*)(Qh + (rb + tq) * 1536 + s * 16 + hi * 8);
            f32x16 o[2]; o[0] = f32x16{}; o[1] = f32x16{};
            float mrun = -1e30f, lrun = 0.f;
#define DIL_LOAD(kt, KF, VR) do { int ktv_ = (kt); asm volatile("" : "+s"(ktv_)); const int ik0_ = -128 + 32 * ktv_; \
                int tk_ = tq0 + d * (ik0_ + r32); tk_ = tk_ < 0 ? 0 : tk_; \
                _Pragma("unroll") for (int s = 0; s < 4; ++s) KF[s] = *(const bf16x8*)(Kh + (rb + tk_) * 1536 + s * 16 + hi * 8); \
                _Pragma("unroll") for (int c4 = 0; c4 < 4; ++c4) { const int key_ = (lane >> 3) + 8 * c4; int tv_ = tq0 + d * (ik0_ + key_); tv_ = tv_ < 0 ? 0 : tv_; \
                    VR[c4] = *(const u32x4*)(Vh + (rb + tv_) * 1536 + (lane & 7) * 8); } } while (0)
#define DIL_TILE(kt, KF, VR) do { int ktw_ = (kt); asm volatile("" : "+s"(ktw_)); const int ik0 = -128 + 32 * ktw_; \
                asm volatile("s_waitcnt lgkmcnt(0)" ::: "memory"); \
                _Pragma("unroll") for (int c4 = 0; c4 < 4; ++c4) { const int key = (lane >> 3) + 8 * c4, ch = lane & 7; \
                    *(u32x4*)(wl + (ch >> 2) * 2048 + key * 64 + (ch & 3) * 16) = VR[c4]; } \
                f32x16 p = f32x16{}; \
                _Pragma("unroll") for (int s = 0; s < 4; ++s) p = __builtin_amdgcn_mfma_f32_32x32x16_bf16(KF[s], qf[s], p, 0, 0, 0); \
                _Pragma("unroll") for (int r = 0; r < 16; ++r) { \
                    const int key = crow(r, hi), rel = r32 - (ik0 + key); \
                    const bool valid = (rel >= 0) && (rel <= 128) && (tq0 + d * (ik0 + key) >= 0); \
                    const float s2 = p[r] * sc - sl * (float)rel; \
                    p[r] = valid ? s2 : -INFINITY; } \
                float rm = max16(p); rm = fmaxf(rm, __shfl_xor(rm, 32)); \
                const float mn = fmaxf(mrun, rm), f = __builtin_amdgcn_exp2f(mrun - mn); mrun = mn; \
                _Pragma("unroll") for (int r = 0; r < 16; ++r) p[r] = __builtin_amdgcn_exp2f(p[r] - mn); \
                lrun = lrun * f + sum16(p); \
                _Pragma("unroll") for (int r = 0; r < 16; ++r) { o[0][r] *= f; o[1][r] *= f; } \
                bf16x8 pf[2]; pf[0] = packp(p, 0); pf[1] = packp(p, 8); \
                asm volatile("s_waitcnt lgkmcnt(0)" ::: "memory"); \
                pv_tile<32>(o, (lds_cptr)wl, pf, lane); } while (0)
#define DIL_LIVE(kt) (tq0 + d * (-128 + 32 * (kt) + 31) >= 0)
            bf16x8 kfA[4], kfB[4], kfC[4]; u32x4 vrA[4], vrB[4], vrC[4];
            DIL_LOAD(4, kfA, vrA);
            DIL_LOAD(3, kfB, vrB);
            DIL_LOAD(2, kfC, vrC);
            DIL_TILE(4, kfA, vrA);
            if (DIL_LIVE(3)) {
                DIL_LOAD(1, kfA, vrA);
                DIL_TILE(3, kfB, vrB);
                if (DIL_LIVE(2)) {
                    DIL_LOAD(0, kfB, vrB);
                    DIL_TILE(2, kfC, vrC);
                    if (DIL_LIVE(1)) {
                        DIL_TILE(1, kfA, vrA);
                        if (DIL_LIVE(0)) DIL_TILE(0, kfB, vrB);
                    }
                }
            }
#undef DIL_LIVE
#undef DIL_LOAD
#undef DIL_TILE
            float lt = lrun + __shfl_xor(lrun, 32);
            const int ti = tq - T0;
            float* so = sO + (size_t)ti * 64;
            if (br > 0) {
                const float ms = sM[ti], ls = sL[ti];
                const float mn = fmaxf(ms, mrun), fs = __builtin_amdgcn_exp2f(ms - mn), fb = __builtin_amdgcn_exp2f(mrun - mn);
                lt = lt * fb + ls * fs; mrun = mn;
#pragma unroll
                for (int d0 = 0; d0 < 2; ++d0)
#pragma unroll
                    for (int g = 0; g < 4; ++g) { const f32x4 st = *(const f32x4*)(so + d0 * 32 + g * 8 + hi * 4);
#pragma unroll
                        for (int j = 0; j < 4; ++j) o[d0][4 * g + j] = o[d0][4 * g + j] * fb + st[j] * fs; }
            }
            if (br < 2) {
#pragma unroll
                for (int d0 = 0; d0 < 2; ++d0)
#pragma unroll
                    for (int g = 0; g < 4; ++g) *(f32x4*)(so + d0 * 32 + g * 8 + hi * 4) = (f32x4){o[d0][4 * g], o[d0][4 * g + 1], o[d0][4 * g + 2], o[d0][4 * g + 3]};
                if (hi == 0) { sM[ti] = mrun; sL[ti] = lt; }
            } else {
                store_o(o, 1.0f / lt, O + (rb + tq) * 1024 + h * 64, hi);
            }
        }
        __threadfence_block();
        __syncthreads();
    }
}
#undef ATT_LAS
}

typedef unsigned short bf16_t;
typedef float f32x4 __attribute__((ext_vector_type(4)));
typedef unsigned u32x4 __attribute__((ext_vector_type(4)));
typedef unsigned u32x2 __attribute__((ext_vector_type(2)));
constexpr int M_TOK = 32768, DM = 1024, DFF = 2816, SEQ = 2048;
constexpr int NTHR = 512;
constexpr size_t MiB = 1u << 20;
constexpr size_t WS_ROPE = 0;
constexpr size_t WS_SS   = 1 * MiB;
constexpr size_t WS_SSQ  = 3 * MiB;
constexpr size_t WS_SSKV = 4 * MiB;
constexpr size_t WS_BAR  = 5 * MiB;
constexpr size_t WS_W    = 8 * MiB;
constexpr size_t SZ_WGU = (size_t)5632 * 1024 * 2, SZ_WD = (size_t)1024 * 2816 * 2;
constexpr size_t WS_WGU0 = WS_W;
constexpr size_t WS_WIN0 = WS_W + 4 * (SZ_WGU + SZ_WD);
constexpr size_t WS_WUQ  = WS_WIN0 + (size_t)2048 * 1024 * 2;
constexpr size_t WS_WUKV = WS_WUQ + (size_t)768 * 256 * 2;
constexpr size_t WS_WOUT0 = WS_WUKV + (size_t)1024 * 128 * 2;
constexpr size_t WS_WIN1 = WS_WOUT0 + (size_t)1024 * 1024 * 2;
constexpr size_t WS_WOUT1 = WS_WIN1 + (size_t)3072 * 1024 * 2;
constexpr size_t WS_WEND = WS_WOUT1 + (size_t)1024 * 1024 * 2;
constexpr size_t WS_XB   = 96 * MiB;
constexpr size_t WS_DIL  = 472 * MiB;
constexpr size_t WS_BIG  = 160 * MiB;
constexpr size_t WS_H    = WS_BIG;
constexpr size_t WS_AQKV = WS_BIG;
constexpr size_t WS_CQ   = WS_AQKV + 96 * MiB;
constexpr size_t WS_CKV  = WS_CQ + 16 * MiB;
constexpr size_t WS_QM   = WS_CKV + 8 * MiB;
constexpr size_t WS_KM   = WS_QM + 48 * MiB;
constexpr size_t WS_VM   = WS_KM + 48 * MiB;
constexpr size_t WS_O0   = WS_VM + 32 * MiB;
constexpr size_t WS_END0 = WS_O0 + 64 * MiB;
constexpr size_t WS_QKV1 = WS_BIG;
constexpr size_t WS_O1   = WS_QKV1 + 192 * MiB;
constexpr size_t WS_END1 = WS_O1 + 64 * MiB;
constexpr size_t WS_NEED = 512 * MiB;
static_assert(WS_WEND <= WS_XB && WS_END0 <= WS_NEED && WS_END1 <= WS_NEED && WS_H + (size_t)M_TOK * DFF * 2 <= WS_NEED, "d_ws map");
constexpr size_t DIL_SCR_BYTES = (512 * 64 + 1024) * 4;
static_assert(WS_DIL >= WS_END0 && WS_DIL + 256 * DIL_SCR_BYTES <= WS_NEED, "dilated state after the layer-0 mixer buffers");
constexpr int LDS_BYTES = 131072 + 18432;

struct Args {
    const float* x; const float* ffn_norm_g; const float* mix_norm_g; const float* w_gate; const float* w_up; const float* w_down;
    const float* ab_w_in; const float* q_norm_g; const float* w_uq; const float* kv_norm_g; const float* w_ukv; const float* ab_w_out;
    const float* sb_w_in; const float* sb_w_out; const float* final_g; float* out; unsigned char* ws; int ph_lo, ph_hi;
};

__device__ __forceinline__ unsigned f2bf(float f) { unsigned u = __builtin_bit_cast(unsigned, f); return (u + 0x7fffu + ((u >> 16) & 1u)) >> 16; }
__device__ __forceinline__ unsigned pk2(float lo, float hi) { return f2bf(lo) | (f2bf(hi) << 16); }
__device__ __forceinline__ float wave_sum(float v) {
#pragma unroll
    for (int o = 1; o < 64; o <<= 1) v += __shfl_xor(v, o);
    return v;
}
template <int MAP> __device__ __forceinline__ int wrow(int n) {
    if (MAP == 0) return n;
    return (n >> 7) * 256 + (n & 127) + (MAP == 2 ? 128 : 0);
}
__device__ __forceinline__ unsigned pkh2(float lo, float hi) { typedef _Float16 h2_ __attribute__((ext_vector_type(2))); if (!RES_FP16) return pk2(lo, hi); h2_ v = {(_Float16)lo, (_Float16)hi}; return __builtin_bit_cast(unsigned, v); }
template <int MAP, bool F16> __device__ __forceinline__ void tr_item(const float* W, int K, int N, bf16_t* WT, const float* gain, float* scr, int item, int lane) {
    const int nblk = N / 32, kb = item / nblk, nb = item % nblk, k0 = 64 * kb, n0 = 32 * nb;
    float wv[32];
    const float gl = gain ? gain[k0 + lane] : 1.0f;
#pragma unroll
    for (int i = 0; i < 32; ++i) { const int kk = 2 * i + (lane >> 5); wv[i] = W[(size_t)(k0 + kk) * N + n0 + (lane & 31)]; }
#pragma unroll
    for (int i = 0; i < 32; ++i) { const int kk = 2 * i + (lane >> 5);
        const float g0 = __builtin_bit_cast(float, __builtin_amdgcn_readlane(__builtin_bit_cast(int, gl), 2 * i)), g1 = __builtin_bit_cast(float, __builtin_amdgcn_readlane(__builtin_bit_cast(int, gl), 2 * i + 1));
        scr[kk * 33 + (lane & 31)] = wv[i] * ((lane >> 5) ? g1 : g0); }
    asm volatile("s_waitcnt lgkmcnt(0)" ::: "memory");
    const int c = lane & 7;
#pragma unroll
    for (int j = 0; j < 4; ++j) { const int n = (lane >> 3) + 8 * j; const float* s = scr + (8 * c) * 33 + n;
        u32x4 o; if (F16) { o.x = pkh2(s[0 * 33], s[1 * 33]); o.y = pkh2(s[2 * 33], s[3 * 33]); o.z = pkh2(s[4 * 33], s[5 * 33]); o.w = pkh2(s[6 * 33], s[7 * 33]); }
        else { o.x = pk2(s[0 * 33], s[1 * 33]); o.y = pk2(s[2 * 33], s[3 * 33]); o.z = pk2(s[4 * 33], s[5 * 33]); o.w = pk2(s[6 * 33], s[7 * 33]); }
        *(u32x4*)(WT + (size_t)wrow<MAP>(n0 + n) * K + k0 + 8 * c) = o; }
    asm volatile("s_waitcnt lgkmcnt(0)" ::: "memory");
}

struct TrP { const float* W; const float* gain; bf16_t* WT; int K, N, map, item; };
__device__ __forceinline__ void tr_load(const TrP& p, int lane, float (&wv)[32], float& gl) {
    const int nblk = p.N / 32, kb = p.item / nblk, nb = p.item % nblk, k0 = 64 * kb, n0 = 32 * nb;
    gl = p.gain ? p.gain[k0 + lane] : 1.0f;
#pragma unroll
    for (int i = 0; i < 32; ++i) { const int kk = 2 * i + (lane >> 5); wv[i] = p.W[(size_t)(k0 + kk) * p.N + n0 + (lane & 31)]; }
}
__device__ __forceinline__ void tr_store(const TrP& p, int lane, const float (&wv)[32], float gl, float* scr) {
    const int nblk = p.N / 32, kb = p.item / nblk, nb = p.item % nblk, k0 = 64 * kb, n0 = 32 * nb;
#pragma unroll
    for (int i = 0; i < 32; ++i) { const int kk = 2 * i + (lane >> 5);
        const float g0 = __builtin_bit_cast(float, __builtin_amdgcn_readlane(__builtin_bit_cast(int, gl), 2 * i)), g1 = __builtin_bit_cast(float, __builtin_amdgcn_readlane(__builtin_bit_cast(int, gl), 2 * i + 1));
        scr[kk * 33 + (lane & 31)] = wv[i] * ((lane >> 5) ? g1 : g0); }
    asm volatile("s_waitcnt lgkmcnt(0)" ::: "memory");
    const int c = lane & 7;
#pragma unroll
    for (int j = 0; j < 4; ++j) { const int n = (lane >> 3) + 8 * j; const float* s = scr + (8 * c) * 33 + n;
        u32x4 o; o.x = pkh2(s[0 * 33], s[1 * 33]); o.y = pkh2(s[2 * 33], s[3 * 33]); o.z = pkh2(s[4 * 33], s[5 * 33]); o.w = pkh2(s[6 * 33], s[7 * 33]);
        const int nn = n0 + n; const int rowd = (p.map == 0) ? nn : (nn >> 7) * 256 + (nn & 127) + (p.map == 2 ? 128 : 0);
        *(u32x4*)(p.WT + (size_t)rowd * p.K + k0 + 8 * c) = o; }
    asm volatile("s_waitcnt lgkmcnt(0)" ::: "memory");
}

__device__ __forceinline__ void grid_bar(unsigned* bar, unsigned nblk, unsigned& gen) {
    asm volatile("s_waitcnt vmcnt(0)" ::: "memory");
    __syncthreads();
    gen += 1u;
    if (threadIdx.x == 0) {
        __builtin_amdgcn_fence(__ATOMIC_RELEASE, "agent");
        asm volatile("s_waitcnt vmcnt(0)" ::: "memory");
        const unsigned target = gen * nblk;
        const unsigned old = __hip_atomic_fetch_add(bar, 1u, __ATOMIC_RELAXED, __HIP_MEMORY_SCOPE_AGENT);
        unsigned* flag = bar + 64;
        if (old + 1u == target) __hip_atomic_store(flag, gen, __ATOMIC_RELAXED, __HIP_MEMORY_SCOPE_AGENT);
        else { unsigned spins = 0; while (__hip_atomic_load(flag, __ATOMIC_RELAXED, __HIP_MEMORY_SCOPE_AGENT) < gen) { __builtin_amdgcn_s_sleep(2); if (++spins > (1u << 24)) break; } }
        __builtin_amdgcn_fence(__ATOMIC_ACQUIRE, "agent");
        asm volatile("s_waitcnt vmcnt(0)" ::: "memory");
    }
    __syncthreads();
}

__global__ void __launch_bounds__(NTHR, 2) mk_fwd(Args a) {
    extern __shared__ __attribute__((aligned(16))) unsigned char lds[];
    cg::grid_group grid = cg::this_grid();
    const int G = gridDim.x, bid = blockIdx.x;
    unsigned char* ws = a.ws;
    float* rope = (float*)(ws + WS_ROPE); float* ss = (float*)(ws + WS_SS); float* ssq = (float*)(ws + WS_SSQ); float* sskv = (float*)(ws + WS_SSKV);
    bf16_t* XB = (bf16_t*)(ws + WS_XB); bf16_t* H = (bf16_t*)(ws + WS_H);
    PG8_LAS unsigned char* glds = (PG8_LAS unsigned char*)lds;
    int ph = 0;
    unsigned* gbar = (unsigned*)(ws + WS_BAR); unsigned gen = 0u;
#ifndef PROBE_REPEAT
#define PROBE_REPEAT -1
#endif
#define PHASE_BEGIN if (ph >= a.ph_lo && ph < a.ph_hi) { for (int rep_ = (ph == PROBE_REPEAT ? 2 : 1); rep_ > 0; --rep_) {
#define PHASE_END(dosync_) } if ((dosync_) && ph + 1 < a.ph_hi) { if (a.ph_lo > 1000000) grid.sync(); grid_bar(gbar, (unsigned)G, gen); } } ++ph;

    PHASE_BEGIN
    {
        const int tid = opaque_tid(), lane = tid & 63, wave = __builtin_amdgcn_readfirstlane(tid >> 6);
        float* scr = (float*)(lds + wave * 16384);
        const int gw = bid * 8 + wave, NGW = G * 8;
        constexpr int I_GU = 16 * 88, I_D = 44 * 32, I_IN0 = 16 * 61, I_UQ = 4 * 24, I_UKV = 2 * 32, I_O = 16 * 32, I_IN1 = 16 * 96;
        constexpr int NITEMS = 4 * (2 * I_GU + I_D) + I_IN0 + I_UQ + I_UKV + I_O + I_IN1 + I_O;
        auto get_item = [&](int it) __attribute__((always_inline)) -> TrP {
            TrP p; int r = it;
            if (r < 4 * (2 * I_GU + I_D)) {
                const int f = r / (2 * I_GU + I_D); r -= f * (2 * I_GU + I_D);
                bf16_t* wgu = (bf16_t*)(ws + WS_WGU0 + f * (SZ_WGU + SZ_WD)); bf16_t* wd = (bf16_t*)(ws + WS_WGU0 + f * (SZ_WGU + SZ_WD) + SZ_WGU);
                const float* g = a.ffn_norm_g + f * 1024;
                if (r < I_GU) p = TrP{a.w_gate + (size_t)f * 1024 * 2816, g, wgu, 1024, 2816, 1, r};
                else if (r < 2 * I_GU) p = TrP{a.w_up + (size_t)f * 1024 * 2816, g, wgu, 1024, 2816, 2, r - I_GU};
                else p = TrP{a.w_down + (size_t)f * 2816 * 1024, nullptr, wd, 2816, 1024, 0, r - 2 * I_GU};
                return p;
            }
            r -= 4 * (2 * I_GU + I_D);
            if (r < I_IN0) return TrP{a.ab_w_in, a.mix_norm_g, (bf16_t*)(ws + WS_WIN0), 1024, 1952, 0, r}; r -= I_IN0;
            if (r < I_UQ) return TrP{a.w_uq, a.q_norm_g, (bf16_t*)(ws + WS_WUQ), 256, 768, 0, r}; r -= I_UQ;
            if (r < I_UKV) return TrP{a.w_ukv, a.kv_norm_g, (bf16_t*)(ws + WS_WUKV), 128, 1024, 0, r}; r -= I_UKV;
            if (r < I_O) return TrP{a.ab_w_out, nullptr, (bf16_t*)(ws + WS_WOUT0), 1024, 1024, 0, r}; r -= I_O;
            if (r < I_IN1) return TrP{a.sb_w_in, a.mix_norm_g + 1024, (bf16_t*)(ws + WS_WIN1), 1024, 3072, 0, r}; r -= I_IN1;
            return TrP{a.sb_w_out, nullptr, (bf16_t*)(ws + WS_WOUT1), 1024, 1024, 0, r};
        };
        if (gw < NITEMS) {
            TrP cur = get_item(gw); float wv[32], gl; tr_load(cur, lane, wv, gl);
            for (int it = gw; it < NITEMS; it += NGW) {
                const int itn = (it + NGW < NITEMS) ? it + NGW : it;
                const TrP nxt = get_item(itn); float wn[32], gn; tr_load(nxt, lane, wn, gn);
                tr_store(cur, lane, wv, gl, scr);
                cur = nxt; gl = gn;
#pragma unroll
                for (int i = 0; i < 32; ++i) wv[i] = wn[i];
            }
        }
        { u32x4* z = (u32x4*)(ws + WS_WIN0 + (size_t)1952 * 1024 * 2); const int nz = 96 * 1024 * 2 / 16;
          for (int i = bid * NTHR + tid; i < nz; i += G * NTHR) z[i] = u32x4{0u, 0u, 0u, 0u}; }
        for (int i = bid * NTHR + tid; i < 2048 * 16; i += G * NTHR) {
            const int pos = i >> 4, fi = i & 15; double inv = 1.0;
            for (int q = 0; q < fi; ++q) inv *= 0.5623413251903491;
            const double rev = (double)pos * inv * 0.15915494309189535; const double fr = rev - (double)(long long)rev;
            const float ang = (float)(fr * 6.283185307179586);
            float sv, cv; sincosf(ang, &sv, &cv);
            rope[pos * 32 + fi] = cv; rope[pos * 32 + 16 + fi] = sv;
        }
        for (int m0 = gw; m0 < M_TOK; m0 += 4 * NGW) {
            f32x4 v[4][4];
#pragma unroll
            for (int q = 0; q < 4; ++q)
#pragma unroll
                for (int j = 0; j < 4; ++j) v[q][j] = ((const f32x4*)(a.x + (size_t)(m0 + q * NGW) * 1024) + lane)[64 * j];
#pragma unroll
            for (int q = 0; q < 4; ++q) { const int m = m0 + q * NGW; float s = 0.f;
                unsigned long long* o8 = (unsigned long long*)(XB + (size_t)m * 1024) + lane;
#pragma unroll
                for (int j = 0; j < 4; ++j) { const f32x4 w = v[q][j]; s += (w[0] * w[0] + w[1] * w[1]) + (w[2] * w[2] + w[3] * w[3]);
                    o8[64 * j] = (unsigned long long)pkh2(w[0], w[1]) | ((unsigned long long)pkh2(w[2], w[3]) << 32); }
                s = wave_sum(s);
                if (lane < 16) ss[(size_t)m * 16 + lane] = (lane == 0) ? s : 0.f; }
        }
        __syncthreads();
    }
    PHASE_END(true)

#define GEMM_PHASE(EPI, E, Aptr, Bptr, Nn, Kk) do { int kk_ = (Kk), nn_ = (Nn); asm volatile("" : "+s"(kk_), "+s"(nn_)); pg8::Gemm g_{(const bf16_t*)(Aptr), (const bf16_t*)(Bptr), M_TOK, nn_, kk_}; pg8::StaticOrder S_; S_.init(M_TOK, nn_, G, bid); \
        pg8::gemm_phase<EPI, pg8::StaticOrder, true, true>(glds, g_, S_, E); } while (0)

#pragma unroll 1
    for (int layer = 0; layer < 2; ++layer) {
#pragma unroll 1
        for (int half = 0; half < 2; ++half) {
            const int f = layer * 2 + half;
            const bf16_t* wgu = (const bf16_t*)(ws + WS_WGU0 + f * (SZ_WGU + SZ_WD)); const bf16_t* wd = (const bf16_t*)(ws + WS_WGU0 + f * (SZ_WGU + SZ_WD) + SZ_WGU);
            PHASE_BEGIN
            { pg8::EpiGU E{ss, H}; GEMM_PHASE(pg8::EpiGU, E, XB, wgu, 5632, 1024); }
            PHASE_END(true)
            PHASE_BEGIN
                        { if (f == 0) { pg8::EpiResidT<true> E{a.x, XB, ss, (rep_ == 2) ? 0.f : 0.5f, (float*)(lds + 131072)}; GEMM_PHASE(pg8::EpiResidT<true>, E, H, wd, 1024, 2816); }
              else { pg8::EpiResidT<false> E{a.x, XB, ss, (rep_ == 2) ? 0.f : 0.5f, (float*)(lds + 131072)}; GEMM_PHASE(pg8::EpiResidT<false>, E, H, wd, 1024, 2816); } }
            PHASE_END(true)
            if (half == 1) continue;
            if (layer == 0) {
                bf16_t* AQKV = (bf16_t*)(ws + WS_AQKV); bf16_t* CQ = (bf16_t*)(ws + WS_CQ); bf16_t* CKV = (bf16_t*)(ws + WS_CKV);
                bf16_t* QM = (bf16_t*)(ws + WS_QM); bf16_t* KM = (bf16_t*)(ws + WS_KM); bf16_t* VM = (bf16_t*)(ws + WS_VM); bf16_t* O0 = (bf16_t*)(ws + WS_O0);
                PHASE_BEGIN
                { pg8::EpiInAB E{ss, AQKV, CQ, CKV, KM, ssq, sskv, rope}; GEMM_PHASE(pg8::EpiInAB, E, XB, ws + WS_WIN0, 2048, 1024); }
                PHASE_END(true)
                PHASE_BEGIN
                { pg8::EpiUQ E{ssq, QM, rope}; GEMM_PHASE(pg8::EpiUQ, E, CQ, ws + WS_WUQ, 768, 256); }
                { pg8::EpiUKV E{sskv, KM, VM}; GEMM_PHASE(pg8::EpiUKV, E, CKV, ws + WS_WUKV, 1024, 128); }
                __syncthreads();
                for (int u = bid; u < 512; u += G) {
                    const int blk = u & 3, h = (u >> 2) & 7, b = u >> 5;
                    att::dil_unit(AQKV, (float*)(ws + WS_DIL + (size_t)bid * DIL_SCR_BYTES), O0, b, h, blk, (char*)lds);
                }
                PHASE_END(true)
                PHASE_BEGIN
                for (int i = 0; i < 4; ++i) {
                    const int v = bid + i * G; if (v >= 1024) break;
                    const int c = v & 255, rnd = v >> 8, bh = c >> 1, s = c & 1;
                    const int qb = (rnd == 0) ? s : (rnd == 1) ? 7 - s : (rnd == 2) ? 2 + s : 5 - s;
                    const int b = bh >> 3, h = bh & 7; const size_t rb = (size_t)b * 2048;
                    att::attn_unit<96, 0>(QM + rb * 768 + h * 96, 768, KM + rb * 768 + h * 96, 768, VM + rb * 512 + h * 64, 512, O0 + rb * 1024 + 512 + h * 64, 1024, qb, (char*)lds,
                                          0.10206207261596575f * att::kLog2e);
                }
                __syncthreads();
                PHASE_END(true)
                PHASE_BEGIN
                { pg8::EpiResidT<false> E{a.x, XB, ss, (rep_ == 2) ? 0.f : 1.0f, (float*)(lds + 131072)}; GEMM_PHASE(pg8::EpiResidT<false>, E, O0, ws + WS_WOUT0, 1024, 1024); }
                PHASE_END(true)
            } else {
                bf16_t* QKV = (bf16_t*)(ws + WS_QKV1); bf16_t* O1 = (bf16_t*)(ws + WS_O1);
                PHASE_BEGIN
                { pg8::EpiScale E{ss, QKV, 3072}; GEMM_PHASE(pg8::EpiScale, E, XB, ws + WS_WIN1, 3072, 1024); }
                PHASE_END(true)
                PHASE_BEGIN
                {
                    const int tid = opaque_tid(), lane = tid & 63, wave = __builtin_amdgcn_readfirstlane(tid >> 6);
                    for (int bh = bid; bh < 256; bh += G) {
                        const int b = bh >> 4, h = bh & 15; const size_t rb = (size_t)b * 2048;
                        for (int rnd = 7; rnd >= 0; --rnd)
                            att::sb_wave_unit(QKV + rb * 3072 + h * 64, QKV + rb * 3072 + 1024 + h * 64, QKV + rb * 3072 + 2048 + h * 64, 3072, O1 + rb * 1024 + h * 64, 1024, (rnd * 8 + wave) * 32, (char*)lds + wave * 4096, lane);
                    }
                }
                __syncthreads();
                PHASE_END(true)
                PHASE_BEGIN
                { pg8::EpiResidT<false> E{a.x, XB, ss, (rep_ == 2) ? 0.f : 1.0f, (float*)(lds + 131072)}; GEMM_PHASE(pg8::EpiResidT<false>, E, O1, ws + WS_WOUT1, 1024, 1024); }
                PHASE_END(true)
            }
        }
    }
    PHASE_BEGIN
    {
        const int tid = opaque_tid(), lane = tid & 63, wave = __builtin_amdgcn_readfirstlane(tid >> 6);
        const int gw = bid * 8 + wave, NGW = G * 8;
        f32x4 gv[4];
#pragma unroll
        for (int j = 0; j < 4; ++j) gv[j] = ((const f32x4*)a.final_g + lane)[64 * j];
        for (int m0 = gw; m0 < M_TOK; m0 += 4 * NGW) {
            u32x2 v[4][4]; float sq[4];
#pragma unroll
            for (int q = 0; q < 4; ++q) { const int m = m0 + q * NGW; sq[q] = (lane < 16) ? ss[(size_t)m * 16 + lane] : 0.f;
#pragma unroll
                for (int j = 0; j < 4; ++j) v[q][j] = ((const u32x2*)(XB + (size_t)m * 1024) + lane)[64 * j]; }
#pragma unroll
            for (int q = 0; q < 4; ++q) { const int m = m0 + q * NGW; const float rs = __builtin_amdgcn_rsqf(wave_sum(sq[q]) * (1.0f / 1024.0f) + 1e-6f);
                f32x4* xr = (f32x4*)(a.out + (size_t)m * 1024) + lane;
#pragma unroll
                for (int j = 0; j < 4; ++j) xr[64 * j] = pg8::unpk4h(v[q][j]) * rs * gv[j]; }
        }
    }
    PHASE_END(false)
#undef PHASE_BEGIN
#undef PHASE_END
#undef GEMM_PHASE
}

extern "C" void kernel_launch(void* const* d_in, const int* in_sizes, int n_in, void* d_out, int out_size, void* d_ws, size_t ws_size, hipStream_t stream) {
    static int grid = 0;
    if (grid == 0) {
        if (n_in != 15 || in_sizes[0] != M_TOK * DM || out_size != M_TOK * DM || ws_size < WS_NEED) {
            fprintf(stderr, "kernel_launch: unexpected shapes (n_in %d in0 %d out %d ws %zu)\n", n_in, n_in > 0 ? in_sizes[0] : -1, out_size, ws_size); grid = -1; return; }
        int dev = 0, cus = 0, per_cu = 0;
        (void)hipGetDevice(&dev); (void)hipDeviceGetAttribute(&cus, hipDeviceAttributeMultiprocessorCount, dev);
        if (hipFuncSetAttribute((const void*)mk_fwd, hipFuncAttributeMaxDynamicSharedMemorySize, LDS_BYTES) != hipSuccess) { fprintf(stderr, "kernel_launch: hipFuncSetAttribute failed\n"); grid = -1; return; }
        if (hipOccupancyMaxActiveBlocksPerMultiprocessor(&per_cu, (const void*)mk_fwd, NTHR, LDS_BYTES) != hipSuccess || per_cu < 1) { fprintf(stderr, "kernel_launch: occupancy query failed (%d)\n", per_cu); per_cu = 1; }
        (void)hipGetLastError();
        grid = cus * 1;
        if (grid <= 0) grid = 256;
    }
    if (grid < 0) return;
    Args a{};
    a.x = (const float*)d_in[0]; a.ffn_norm_g = (const float*)d_in[1]; a.mix_norm_g = (const float*)d_in[2]; a.w_gate = (const float*)d_in[3]; a.w_up = (const float*)d_in[4]; a.w_down = (const float*)d_in[5];
    a.ab_w_in = (const float*)d_in[6]; a.q_norm_g = (const float*)d_in[7]; a.w_uq = (const float*)d_in[8]; a.kv_norm_g = (const float*)d_in[9]; a.w_ukv = (const float*)d_in[10]; a.ab_w_out = (const float*)d_in[11];
    a.sb_w_in = (const float*)d_in[12]; a.sb_w_out = (const float*)d_in[13]; a.final_g = (const float*)d_in[14]; a.out = (float*)d_out; a.ws = (unsigned char*)d_ws;
    a.ph_lo = 0; a.ph_hi = 1000;
    if (hipMemsetAsync((char*)d_ws + WS_BAR, 0, 512, stream) != hipSuccess) { fprintf(stderr, "kernel_launch: memset of the barrier words failed\n"); return; }
    void* args[] = {&a};
    hipError_t e = hipLaunchCooperativeKernel((const void*)mk_fwd, dim3(grid), dim3(NTHR), args, LDS_BYTES, stream);
    if (e != hipSuccess) fprintf(stderr, "kernel_launch: cooperative launch failed: %s (grid %d)\n", hipGetErrorString(e), grid);
}
```

```cpp
#include <hip/hip_runtime.h>
#include <hip/hip_cooperative_groups.h>
#include <cstdio>
#include <cstdint>
namespace cg = cooperative_groups;

__device__ __forceinline__ int opaque_tid() { int t = threadIdx.x; asm volatile("" : "+v"(t)); return t; }
namespace pg8 {
#define PG8_LAS __attribute__((address_space(3)))
typedef unsigned short bf16_t;
typedef short bf16x8 __attribute__((ext_vector_type(8)));
typedef float f32x4 __attribute__((ext_vector_type(4)));
typedef unsigned u32x4 __attribute__((ext_vector_type(4)));
constexpr int BM = 256, BK = 64, HALF = 128, HTB = HALF * BK * 2  , STAGE_BYTES = 8 * HTB, NXCD = 8, WGM = 8;

__host__ __device__ __forceinline__ int lds_byte(int r, int c) { const int st = (r >> 4) * 2 + (c >> 5), rr = r & 15, cc = c & 31, ob = rr * 64 + cc * 2; return st * 1024 + (ob ^ (((ob >> 9) & 1) << 5)); }
__host__ __device__ __forceinline__ void stage_rc(int b, int& R, int& C) { const int st = b / 1024, sb = b % 1024, swz = sb ^ (((sb >> 9) & 1) << 5); R = (st >> 1) * 16 + swz / 64; C = (st & 1) * 32 + (swz % 64) / 2; }
__host__ __device__ __forceinline__ int perm32(int rho) { const int n = rho >> 4, i = rho & 15; return 8 * (i >> 2) + 4 * n + (i & 3); }

struct Unit { int pm, pn; };
struct Gemm { const bf16_t* A; const bf16_t* Bt; int M, N, K; };

struct StaticOrder {
    int nM, nN, nwg, G, c;
    __host__ __device__ void init(int M, int N, int G_, int c_) { nM = M / BM; nN = N / BM; nwg = nM * nN; G = G_; c = c_; }
    __host__ __device__ bool next(int i, Unit& u) const {
        const long L = (long)i * G + c; if (L >= nwg) return false;
        int wgid = (int)L; { const int q = nwg / NXCD, r = nwg % NXCD, xcd = wgid % NXCD, off = wgid / NXCD; wgid = (xcd < r ? xcd * (q + 1) : r * (q + 1) + (xcd - r) * q) + off; }
        const int nig = WGM * nN, gid = wgid / nig, fm = gid * WGM, gsz = (nM - fm) < WGM ? (nM - fm) : WGM;
        u.pm = fm + ((wgid % nig) % gsz); u.pn = (wgid % nig) / gsz; return true;
    }
    __device__ __forceinline__ void a_ready(const Unit&) const {}
    __device__ __forceinline__ void done(const Unit&) const {}
};

__device__ __forceinline__ unsigned cvt_pk_bf16(float lo, float hi) { unsigned r; asm volatile("v_cvt_pk_bf16_f32 %0, %1, %2" : "=v"(r) : "v"(lo), "v"(hi)); return r; }
typedef unsigned u32x2 __attribute__((ext_vector_type(2)));
constexpr float kEps = 1e-6f;
typedef _Float16 f16x8 __attribute__((ext_vector_type(8)));
typedef _Float16 f16x2 __attribute__((ext_vector_type(2)));
template <bool F16> __device__ __forceinline__ f32x4 mma16(bf16x8 a, bf16x8 b, f32x4 c) {
    if (F16) return __builtin_amdgcn_mfma_f32_16x16x32_f16(__builtin_bit_cast(f16x8, a), __builtin_bit_cast(f16x8, b), c, 0, 0, 0);
    return __builtin_amdgcn_mfma_f32_16x16x32_bf16(a, b, c, 0, 0, 0);
}
#ifndef RES_FP16
#define RES_FP16 0
#endif
__device__ __forceinline__ unsigned pkh(float lo, float hi) { if (!RES_FP16) return cvt_pk_bf16(lo, hi); f16x2 v = {(_Float16)lo, (_Float16)hi}; return __builtin_bit_cast(unsigned, v); }
__device__ __forceinline__ f32x4 unpk4h(u32x2 w) { if (!RES_FP16) return (f32x4){__builtin_bit_cast(float, w.x << 16), __builtin_bit_cast(float, w.x & 0xffff0000u), __builtin_bit_cast(float, w.y << 16), __builtin_bit_cast(float, w.y & 0xffff0000u)}; const f16x2 a = __builtin_bit_cast(f16x2, w.x), b = __builtin_bit_cast(f16x2, w.y); return (f32x4){(float)a[0], (float)a[1], (float)b[0], (float)b[1]}; }

constexpr float kLog2e = 1.4426950408889634f;
__device__ __forceinline__ u32x2 pack4(const f32x4 v) { u32x2 w; w.x = cvt_pk_bf16(v[0], v[1]); w.y = cvt_pk_bf16(v[2], v[3]); return w; }
template <int NP> __device__ __forceinline__ float row_rstd(const float* ss, int row, float inv_n) {
    float s = 0.f;
#pragma unroll
    for (int i = 0; i < NP / 4; ++i) { const f32x4 v = *(const f32x4*)(ss + (size_t)row * NP + 4 * i); s += (v[0] + v[1]) + (v[2] + v[3]); }
    return __builtin_amdgcn_rsqf(s * inv_n + kEps);
}
__device__ __forceinline__ float quad_sum(float s) { s += __shfl_xor(s, 16); s += __shfl_xor(s, 32); return s; }


template <int NP> __device__ __forceinline__ void load_rstd8(const float* ss, const Unit& u, int wr, int fr, int fq, float inv_n, float (&rs)[2][4]) {
    f32x4 v[2][4];
#pragma unroll
    for (int ai = 0; ai < 2; ++ai)
#pragma unroll
        for (int m = 0; m < 4; ++m) { const int row = u.pm * BM + ai * HALF + wr * 64 + m * 16 + fr; v[ai][m] = *(const f32x4*)(ss + (size_t)row * NP + (NP == 16 ? 4 * fq : 0)); }
#pragma unroll
    for (int ai = 0; ai < 2; ++ai)
#pragma unroll
        for (int m = 0; m < 4; ++m) { float t = (v[ai][m][0] + v[ai][m][1]) + (v[ai][m][2] + v[ai][m][3]); if (NP == 16) t = quad_sum(t); rs[ai][m] = __builtin_amdgcn_rsqf(t * inv_n + kEps); }
}

struct EpiGU {
    static constexpr bool PERM = true, AFTER_DRAIN = false, F16 = (RES_FP16 != 0);
    const float* ss; bf16_t* H;
    __device__ __forceinline__ void operator()(const f32x4 (&acc)[2][2][4][2], const Unit& u, int wr, int wc, int fr, int fq) const {
        float rsv[2][4]; load_rstd8<16>(ss, u, wr, fr, fq, 1.0f / 1024.0f, rsv);
        typedef unsigned u32x4_ __attribute__((ext_vector_type(4)));
#pragma unroll
        for (int ai = 0; ai < 2; ++ai)
#pragma unroll
            for (int m = 0; m < 4; ++m) {
                const int row = u.pm * BM + ai * HALF + wr * 64 + m * 16 + fr;
                const float rs = rsv[ai][m];
                u32x2 w[2];
#pragma unroll
                for (int n = 0; n < 2; ++n) {
                    const f32x4 g = acc[ai][0][m][n] * rs, up = acc[ai][1][m][n] * rs; f32x4 o;
#pragma unroll
                    for (int j = 0; j < 4; ++j) { const float e = __builtin_amdgcn_exp2f(-g[j] * kLog2e); o[j] = g[j] * up[j] * __builtin_amdgcn_rcpf(1.0f + e); }
                    w[n] = pack4(o);
                }
                *(u32x4_*)(H + (size_t)row * 2816 + u.pn * 128 + wc * 32 + fq * 8) = (u32x4_){w[0].x, w[0].y, w[1].x, w[1].y};
            }
    }
};
template <bool SRC32> struct EpiResidT {
    static constexpr bool PERM = false, AFTER_DRAIN = false, F16 = false;
    const float* x32; bf16_t* X16; float* ss; float alpha; float* wlds;
    __device__ __forceinline__ void operator()(const f32x4 (&acc)[2][2][4][2], const Unit& u, int wr, int wc, int fr, int fq) const {
        float* wl = wlds + (wr * 4 + wc) * 576;
        const int lane = fq * 16 + fr, rl = lane >> 3, ch = lane & 7;
        f32x4 rb[2][2][2][2];
        const size_t cbase = (size_t)u.pn * BM + wc * 32 + ch * 4;
#define RES_LOAD(buf, b) do { _Pragma("unroll") for (int gg = 0; gg < 2; ++gg) { const int g_ = 2 * (b) + gg; const int row0_ = u.pm * BM + (g_ >> 2) * HALF + wr * 64 + (g_ & 3) * 16 + rl; \
            _Pragma("unroll") for (int bj = 0; bj < 2; ++bj) _Pragma("unroll") for (int i = 0; i < 2; ++i) { const size_t o_ = (size_t)(row0_ + 8 * i) * 1024 + cbase + bj * HALF; \
                if (SRC32) rb[buf][gg][bj][i] = *(const f32x4*)(x32 + o_); else rb[buf][gg][bj][i] = unpk4h(*(const u32x2*)(X16 + o_)); } } } while (0)
        RES_LOAD(0, 0);
#pragma unroll
        for (int b = 0; b < 4; ++b) {
            if (b + 1 < 4) RES_LOAD((b + 1) & 1, b + 1);
#pragma unroll
            for (int gg = 0; gg < 2; ++gg) {
                const int g = 2 * b + gg, ai = g >> 2, m = g & 3;
                const int row0 = u.pm * BM + ai * HALF + wr * 64 + m * 16 + rl;
                float sq[2] = {0.f, 0.f};
#pragma unroll
                for (int bj = 0; bj < 2; ++bj) {
                    *(f32x4*)(wl + fr * 36 + fq * 4) = acc[ai][bj][m][0] * alpha; *(f32x4*)(wl + fr * 36 + 16 + fq * 4) = acc[ai][bj][m][1] * alpha;
                    asm volatile("s_waitcnt lgkmcnt(0)" ::: "memory");
#pragma unroll
                    for (int i = 0; i < 2; ++i) {
                        const f32x4 x = rb[b & 1][gg][bj][i] + *(const f32x4*)(wl + (rl + 8 * i) * 36 + ch * 4);
                        const size_t off = (size_t)(row0 + 8 * i) * 1024 + cbase + bj * HALF;
                        u32x2 w; w.x = pkh(x[0], x[1]); w.y = pkh(x[2], x[3]); *(u32x2*)(X16 + off) = w;
                        sq[i] += (x[0] * x[0] + x[1] * x[1]) + (x[2] * x[2] + x[3] * x[3]);
                    }
                    asm volatile("s_waitcnt lgkmcnt(0)" ::: "memory");
                }
#pragma unroll
                for (int i = 0; i < 2; ++i) { float t = sq[i]; t += __shfl_xor(t, 1); t += __shfl_xor(t, 2); t += __shfl_xor(t, 4);
                    if (ch == 0) ss[(size_t)(row0 + 8 * i) * 16 + u.pn * 4 + wc] = t; }
            }
        }
#undef RES_LOAD
    }
};
struct EpiScale {
    static constexpr bool PERM = true, AFTER_DRAIN = false, F16 = (RES_FP16 != 0);
    const float* ss; bf16_t* O; int ldc;
    __device__ __forceinline__ void operator()(const f32x4 (&acc)[2][2][4][2], const Unit& u, int wr, int wc, int fr, int fq) const {
        float rsv[2][4]; load_rstd8<16>(ss, u, wr, fr, fq, 1.0f / 1024.0f, rsv);
        typedef unsigned u32x4_ __attribute__((ext_vector_type(4)));
#pragma unroll
        for (int ai = 0; ai < 2; ++ai)
#pragma unroll
            for (int m = 0; m < 4; ++m) {
                const int row = u.pm * BM + ai * HALF + wr * 64 + m * 16 + fr;
                const float rs = rsv[ai][m];
#pragma unroll
                for (int bj = 0; bj < 2; ++bj) {
                    const u32x2 lo = pack4(acc[ai][bj][m][0] * rs), hi = pack4(acc[ai][bj][m][1] * rs);
                    *(u32x4_*)(O + (size_t)row * ldc + u.pn * BM + bj * HALF + wc * 32 + fq * 8) = (u32x4_){lo.x, lo.y, hi.x, hi.y};
                }
            }
    }
};
struct EpiInAB {
    static constexpr bool PERM = false, AFTER_DRAIN = false, F16 = (RES_FP16 != 0);
    const float* ss; bf16_t* AQKV; bf16_t* CQ; bf16_t* CKV; bf16_t* KM; float* ssq; float* sskv; const float* rope;
    __device__ __forceinline__ void operator()(const f32x4 (&acc)[2][2][4][2], const Unit& u, int wr, int wc, int fr, int fq) const {
        float rsv[2][4]; load_rstd8<16>(ss, u, wr, fr, fq, 1.0f / 1024.0f, rsv);
#pragma unroll
        for (int ai = 0; ai < 2; ++ai)
#pragma unroll
            for (int m = 0; m < 4; ++m) {
                asm volatile("" ::: "memory"); const int row = u.pm * BM + ai * HALF + wr * 64 + m * 16 + fr;
                const float rs = rsv[ai][m];
                if (u.pn < 6) {
#pragma unroll
                    for (int bj = 0; bj < 2; ++bj)
#pragma unroll
                        for (int n = 0; n < 2; ++n)
                            *(u32x2*)(AQKV + (size_t)row * 1536 + u.pn * BM + bj * HALF + wc * 32 + n * 16 + fq * 4) = pack4(acc[ai][bj][m][n] * rs);
                } else if (u.pn == 6) {
                    float s = 0.f;
#pragma unroll
                    for (int bj = 0; bj < 2; ++bj)
#pragma unroll
                        for (int n = 0; n < 2; ++n) { const f32x4 x = acc[ai][bj][m][n] * rs;
                            *(u32x2*)(CQ + (size_t)row * 256 + bj * HALF + wc * 32 + n * 16 + fq * 4) = pack4(x);
                            s += (x[0] * x[0] + x[1] * x[1]) + (x[2] * x[2] + x[3] * x[3]); }
                    s = quad_sum(s);
                    if (fq == 0) ssq[(size_t)row * 4 + wc] = s;
                } else {
                    float s = 0.f;
#pragma unroll
                    for (int n = 0; n < 2; ++n) { const f32x4 x = acc[ai][0][m][n] * rs;
                        *(u32x2*)(CKV + (size_t)row * 128 + wc * 32 + n * 16 + fq * 4) = pack4(x);
                        s += (x[0] * x[0] + x[1] * x[1]) + (x[2] * x[2] + x[3] * x[3]); }
                    s = quad_sum(s);
                    if (fq == 0) sskv[(size_t)row * 4 + wc] = s;
                    if (wc == 0) {
                        const f32x4 x1 = acc[ai][1][m][0] * rs, x2 = acc[ai][1][m][1] * rs;
                        const int pos = row & 2047;
                        const f32x4 c = *(const f32x4*)(rope + pos * 32 + fq * 4), sn = *(const f32x4*)(rope + pos * 32 + 16 + fq * 4);
                        const u32x2 o1 = pack4(x1 * c - x2 * sn), o2 = pack4(x1 * sn + x2 * c);
#pragma unroll
                        for (int h = 0; h < 8; ++h) { bf16_t* kp = KM + (size_t)row * 768 + h * 96 + 64 + fq * 4; *(u32x2*)kp = o1; *(u32x2*)(kp + 16) = o2; }
                    }
                }
            }
    }
};
struct EpiUQ {
    static constexpr bool PERM = false, AFTER_DRAIN = false, F16 = false;
    const float* ssq; bf16_t* Q; const float* rope;
    __device__ __forceinline__ void operator()(const f32x4 (&acc)[2][2][4][2], const Unit& u, int wr, int wc, int fr, int fq) const {
        float rsv[2][4]; load_rstd8<4>(ssq, u, wr, fr, fq, 1.0f / 256.0f, rsv);
        f32x4 rc[2][4], rsn[2][4];
#pragma unroll
        for (int ai = 0; ai < 2; ++ai)
#pragma unroll
            for (int m = 0; m < 4; ++m) { const int pos = (u.pm * BM + ai * HALF + wr * 64 + m * 16 + fr) & 2047;
                rc[ai][m] = *(const f32x4*)(rope + pos * 32 + fq * 4); rsn[ai][m] = *(const f32x4*)(rope + pos * 32 + 16 + fq * 4); }
#pragma unroll
        for (int ai = 0; ai < 2; ++ai)
#pragma unroll
            for (int m = 0; m < 4; ++m) {
                const int row = u.pm * BM + ai * HALF + wr * 64 + m * 16 + fr;
                const float rs = rsv[ai][m];
#pragma unroll
                for (int bj = 0; bj < 2; ++bj) {
                    const int cb = u.pn * BM + bj * HALF + wc * 32;
                    f32x4 x1 = acc[ai][bj][m][0] * rs, x2 = acc[ai][bj][m][1] * rs;
                    if ((cb % 96) == 64) { const f32x4 c = rc[ai][m], sn = rsn[ai][m]; const f32x4 y1 = x1 * c - x2 * sn, y2 = x1 * sn + x2 * c; x1 = y1; x2 = y2; }
                    bf16_t* qp = Q + (size_t)row * 768 + cb + fq * 4; *(u32x2*)qp = pack4(x1); *(u32x2*)(qp + 16) = pack4(x2);
                }
            }
    }
};
struct EpiUKV {
    static constexpr bool PERM = false, AFTER_DRAIN = false, F16 = false;
    const float* sskv; bf16_t* KM; bf16_t* VM;
    __device__ __forceinline__ void operator()(const f32x4 (&acc)[2][2][4][2], const Unit& u, int wr, int wc, int fr, int fq) const {
        float rsv[2][4]; load_rstd8<4>(sskv, u, wr, fr, fq, 1.0f / 128.0f, rsv);
#pragma unroll
        for (int ai = 0; ai < 2; ++ai)
#pragma unroll
            for (int m = 0; m < 4; ++m) {
                asm volatile("" ::: "memory"); const int row = u.pm * BM + ai * HALF + wr * 64 + m * 16 + fr;
                const float rs = rsv[ai][m];
#pragma unroll
                for (int bj = 0; bj < 2; ++bj) {
                    const int cb = u.pn * BM + bj * HALF + wc * 32, h = cb >> 7, w = cb & 127;
                    bf16_t* p = (w < 64) ? (KM + (size_t)row * 768 + h * 96 + w + fq * 4) : (VM + (size_t)row * 512 + h * 64 + (w - 64) + fq * 4);
                    *(u32x2*)p = pack4(acc[ai][bj][m][0] * rs); *(u32x2*)(p + 16) = pack4(acc[ai][bj][m][1] * rs);
                }
            }
    }
};

struct EpiNull {
    static constexpr bool PERM = false, AFTER_DRAIN = false, F16 = false;
    __device__ __forceinline__ void operator()(const f32x4 (&acc)[2][2][4][2], const Unit& u, int wr, int wc, int fr, int fq) const {
#pragma unroll
        for (int ai = 0; ai < 2; ++ai)
#pragma unroll
            for (int bj = 0; bj < 2; ++bj)
#pragma unroll
                for (int m = 0; m < 4; ++m)
#pragma unroll
                    for (int n = 0; n < 2; ++n) asm volatile("" :: "v"(acc[ai][bj][m][n]));
    }
};
template <class Epi, class Sched, bool ALIGN_EPI = false, bool SP2 = false>
__device__ __forceinline__ void gemm_phase(PG8_LAS unsigned char* lds, const Gemm g, const Sched& S, const Epi& E) {
    const int tid = opaque_tid(), wid = __builtin_amdgcn_readfirstlane(tid >> 6), lane = tid & 63, wr = wid >> 2, wc = wid & 3, fr = lane & 15, fq = lane >> 4;
    const int K = g.K, nt = K / BK;
    unsigned voffA[2], voffB[2];
#pragma unroll
    for (int i = 0; i < 2; ++i) { int R, C; stage_rc(tid * 16 + i * 8192, R, C); const int Rb = Epi::PERM ? ((R & ~31) + perm32(R & 31)) : R;
        voffA[i] = (unsigned)(R * K + C) * 2u; voffB[i] = (unsigned)(Rb * K + C) * 2u; }
    const size_t kstep = (size_t)(BK * 2);
    const size_t hstep = (size_t)HALF * K * 2;
    const size_t tstep = 2 * hstep;
    const unsigned ldsw = (unsigned)wid * 1024u;
    const int aoff = lds_byte(wr * 64 + fr, fq * 8), boff = lds_byte(wc * 32 + fr, fq * 8);
#define PG8_SA(b, h) (((b) * 2 + (h)) * HTB)
#define PG8_SB(b, h) ((4 + (b) * 2 + (h)) * HTB)
#define PG8_STAGE(bufoff, gbase, voff) do { _Pragma("unroll") for (int _i = 0; _i < 2; ++_i) \
        __builtin_amdgcn_global_load_lds((const unsigned*)((const char*)(gbase) + (voff)[_i]), (PG8_LAS unsigned*)(lds + (bufoff) + ldsw + _i * 8192), 16, 0, 0); } while (0)
#define PG8_LDA(dst, b, h) do { _Pragma("unroll") for (int m = 0; m < 4; ++m) _Pragma("unroll") for (int k = 0; k < 2; ++k) dst[m][k] = *(const PG8_LAS bf16x8*)(lds + PG8_SA(b, h) + aoff + m * 2048 + k * 1024); } while (0)
#define PG8_LDB(dst, b, h) do { _Pragma("unroll") for (int n = 0; n < 2; ++n) _Pragma("unroll") for (int k = 0; k < 2; ++k) dst[n][k] = *(const PG8_LAS bf16x8*)(lds + PG8_SB(b, h) + boff + n * 2048 + k * 1024); } while (0)
#define PG8_MMA(ai, bj, At, Bt) do { __builtin_amdgcn_s_setprio(1); _Pragma("unroll") for (int m = 0; m < 4; ++m) _Pragma("unroll") for (int n = 0; n < 2; ++n) _Pragma("unroll") for (int k = 0; k < 2; ++k) \
        acc[ai][bj][m][n] = mma16<Epi::F16>(Bt[n][k], At[m][k], acc[ai][bj][m][n]); __builtin_amdgcn_s_setprio(0); } while (0)
#define PG8_WAIT_V(n) asm volatile("s_waitcnt vmcnt(" #n ")" ::: "memory")
#define PG8_WAIT_L(n) asm volatile("s_waitcnt lgkmcnt(" #n ")" ::: "memory")
#define PG8_BAR __builtin_amdgcn_s_barrier()
#define PG8_SCHED __builtin_amdgcn_sched_barrier(0)
    Unit cur, nxt; int ui = 0;
    if (!S.next(0, cur)) return;
    f32x4 acc[2][2][4][2];
#pragma unroll
    for (int a = 0; a < 2; ++a)
#pragma unroll
        for (int b = 0; b < 2; ++b)
#pragma unroll
            for (int m = 0; m < 4; ++m)
#pragma unroll
                for (int n = 0; n < 2; ++n) acc[a][b][m][n] = (f32x4){0.f, 0.f, 0.f, 0.f};
    bf16x8 At[4][2], B0[2][2], B1[2][2];
    const char* cA = (const char*)g.A + (size_t)cur.pm * tstep; const char* cB = (const char*)g.Bt + (size_t)cur.pn * tstep;
    S.a_ready(cur);
    if constexpr (SP2) {
        PG8_STAGE(PG8_SB(0, 0), cB, voffB); PG8_STAGE(PG8_SB(0, 1), cB + hstep, voffB); PG8_STAGE(PG8_SA(0, 0), cA, voffA); PG8_STAGE(PG8_SA(0, 1), cA + hstep, voffA);
        if (wr == 1) PG8_BAR;
        PG8_WAIT_V(2); PG8_BAR;
        PG8_STAGE(PG8_SB(1, 0), cB + kstep, voffB); PG8_STAGE(PG8_SA(1, 0), cA + kstep, voffA); PG8_STAGE(PG8_SB(1, 1), cB + hstep + kstep, voffB);
        PG8_WAIT_V(6); PG8_BAR;
    } else {
        PG8_STAGE(PG8_SB(0, 0), cB, voffB); PG8_STAGE(PG8_SA(0, 0), cA, voffA); PG8_STAGE(PG8_SB(0, 1), cB + hstep, voffB); PG8_STAGE(PG8_SA(0, 1), cA + hstep, voffA);
        if (wr == 1) PG8_BAR;
        PG8_WAIT_V(4); PG8_BAR;
        PG8_STAGE(PG8_SB(1, 0), cB + kstep, voffB); PG8_STAGE(PG8_SA(1, 0), cA + kstep, voffA); PG8_STAGE(PG8_SB(1, 1), cB + hstep + kstep, voffB);
        PG8_WAIT_V(6); PG8_BAR;
    }
    for (;;) {
        const bool has_next = S.next(ui + 1, nxt);
        const char* nA = has_next ? (const char*)g.A + (size_t)nxt.pm * tstep : cA; const char* nB = has_next ? (const char*)g.Bt + (size_t)nxt.pn * tstep : cB;
        for (int t = 0; t < nt; t += 2) {
            const bool last = (t == nt - 2);
            const char* a1 = cA + (size_t)(t + 1) * kstep;
            const char* a2 = last ? nA : cA + (size_t)(t + 2) * kstep; const char* b2 = last ? nB : cB + (size_t)(t + 2) * kstep;
            const char* a3 = a2 + kstep; const char* b3 = b2 + kstep;
            if (last && has_next) S.a_ready(nxt);
            if constexpr (SP2) {
            PG8_LDB(B0, 0, 0); PG8_LDB(B1, 0, 1); PG8_SCHED; PG8_LDA(At, 0, 0); PG8_STAGE(PG8_SA(1, 1), a1 + hstep, voffA);
            PG8_WAIT_V(8); PG8_WAIT_L(0); PG8_BAR; PG8_MMA(0, 0, At, B0); PG8_MMA(0, 1, At, B1); PG8_BAR; PG8_SCHED;
            PG8_LDA(At, 0, 1); PG8_STAGE(PG8_SB(0, 0), b2, voffB); PG8_STAGE(PG8_SB(0, 1), b2 + hstep, voffB); PG8_STAGE(PG8_SA(0, 0), a2, voffA);
            PG8_WAIT_V(8); PG8_WAIT_L(0); PG8_BAR; PG8_MMA(1, 0, At, B0); PG8_MMA(1, 1, At, B1); PG8_BAR; PG8_SCHED;
            PG8_LDB(B0, 1, 0); PG8_LDB(B1, 1, 1); PG8_SCHED; PG8_LDA(At, 1, 0); PG8_STAGE(PG8_SA(0, 1), a2 + hstep, voffA);
            PG8_WAIT_V(8); PG8_WAIT_L(0); PG8_BAR; PG8_MMA(0, 0, At, B0); PG8_MMA(0, 1, At, B1); PG8_BAR; PG8_SCHED;
            PG8_LDA(At, 1, 1); PG8_STAGE(PG8_SB(1, 0), b3, voffB); PG8_STAGE(PG8_SB(1, 1), b3 + hstep, voffB); PG8_STAGE(PG8_SA(1, 0), a3, voffA);
            PG8_WAIT_V(8); PG8_WAIT_L(0); PG8_BAR; PG8_MMA(1, 0, At, B0); PG8_MMA(1, 1, At, B1); PG8_BAR; PG8_SCHED;
            } else {
            PG8_LDB(B0, 0, 0); PG8_SCHED; PG8_LDA(At, 0, 0); PG8_STAGE(PG8_SA(1, 1), a1 + hstep, voffA);
            PG8_WAIT_L(8); PG8_BAR; PG8_WAIT_L(0); PG8_MMA(0, 0, At, B0); PG8_BAR; PG8_SCHED;
            PG8_LDB(B1, 0, 1); PG8_STAGE(PG8_SB(0, 0), b2, voffB);
            PG8_BAR; PG8_WAIT_L(0); PG8_MMA(0, 1, At, B1); PG8_BAR;
            PG8_LDA(At, 0, 1); PG8_STAGE(PG8_SA(0, 0), a2, voffA);
            PG8_BAR; PG8_WAIT_L(0); PG8_MMA(1, 0, At, B0); PG8_BAR; PG8_SCHED;
            PG8_STAGE(PG8_SB(0, 1), b2 + hstep, voffB);
            PG8_WAIT_V(6); PG8_BAR; PG8_MMA(1, 1, At, B1); PG8_BAR;
            PG8_LDB(B0, 1, 0); PG8_SCHED; PG8_LDA(At, 1, 0); PG8_STAGE(PG8_SA(0, 1), a2 + hstep, voffA);
            PG8_WAIT_L(8); PG8_BAR; PG8_WAIT_L(0); PG8_MMA(0, 0, At, B0); PG8_BAR; PG8_SCHED;
            PG8_LDB(B1, 1, 1); PG8_STAGE(PG8_SB(1, 0), b3, voffB);
            PG8_BAR; PG8_WAIT_L(0); PG8_MMA(0, 1, At, B1); PG8_BAR;
            PG8_LDA(At, 1, 1); PG8_STAGE(PG8_SA(1, 0), a3, voffA);
            PG8_BAR; PG8_WAIT_L(0); PG8_MMA(1, 0, At, B0); PG8_BAR; PG8_SCHED;
            PG8_STAGE(PG8_SB(1, 1), b3 + hstep, voffB);
            PG8_WAIT_V(6); PG8_BAR; PG8_MMA(1, 1, At, B1); PG8_BAR;
            }
        }
        if constexpr (ALIGN_EPI) { if (wr == 0) PG8_BAR; }
        if constexpr (!Epi::AFTER_DRAIN) { E(acc, cur, wr, wc, fr, fq); S.done(cur); }
        if (!has_next) break;
#pragma unroll
        for (int a = 0; a < 2; ++a)
#pragma unroll
            for (int b = 0; b < 2; ++b)
#pragma unroll
                for (int m = 0; m < 4; ++m)
#pragma unroll
                    for (int n = 0; n < 2; ++n) acc[a][b][m][n] = (f32x4){0.f, 0.f, 0.f, 0.f};
        cur = nxt; cA = nA; cB = nB; ++ui;
        if constexpr (ALIGN_EPI) { if (wr == 1) PG8_BAR; }
    }
    PG8_WAIT_V(0);
    if constexpr (!ALIGN_EPI) { if (wr == 0) PG8_BAR; }
    PG8_BAR;
    if constexpr (Epi::AFTER_DRAIN) { E.fused(acc, cur, wr, wc, fr, fq, lds, wid, lane); S.done(cur); }
#undef PG8_SA
#undef PG8_SB
#undef PG8_STAGE
#undef PG8_LDA
#undef PG8_LDB
#undef PG8_MMA
#undef PG8_WAIT_V
#undef PG8_WAIT_L
#undef PG8_BAR
#undef PG8_SCHED
}
}
namespace att {
typedef unsigned short bf16_t;
typedef short bf16x8 __attribute__((ext_vector_type(8)));
typedef short s16x4 __attribute__((ext_vector_type(4)));
typedef float f32x16 __attribute__((ext_vector_type(16)));
typedef float f32x4 __attribute__((ext_vector_type(4)));
typedef unsigned u32x4 __attribute__((ext_vector_type(4)));
typedef unsigned u32x2 __attribute__((ext_vector_type(2)));
#define ATT_LAS __attribute__((address_space(3)))
typedef ATT_LAS const char* lds_cptr;
typedef ATT_LAS char* lds_ptr;
constexpr float kLog2e = 1.4426950408889634f;
__device__ __forceinline__ int crow(int r, int hi) { return (r & 3) + 8 * (r >> 2) + 4 * hi; }
__device__ __forceinline__ unsigned cvtpk(float lo, float hi) { unsigned r; asm volatile("v_cvt_pk_bf16_f32 %0, %1, %2" : "=v"(r) : "v"(lo), "v"(hi)); return r; }
__device__ __forceinline__ s16x4 vtr(lds_cptr p) { return __builtin_bit_cast(s16x4, __builtin_amdgcn_ds_read_tr16_b64_v4i16((ATT_LAS s16x4*)p)); }
__device__ __forceinline__ bf16x8 cat8(s16x4 lo, s16x4 hi) { return (bf16x8){lo[0], lo[1], lo[2], lo[3], hi[0], hi[1], hi[2], hi[3]}; }
__device__ __forceinline__ bf16x8 packp(const f32x16& p, int b) {
    u32x4 w; w.x = cvtpk(p[b], p[b + 1]); w.y = cvtpk(p[b + 2], p[b + 3]); w.z = cvtpk(p[b + 4], p[b + 5]); w.w = cvtpk(p[b + 6], p[b + 7]);
    return __builtin_bit_cast(bf16x8, w);
}
__device__ __forceinline__ float max16(const f32x16& p) {
    float a = fmaxf(fmaxf(p[0], p[1]), fmaxf(p[2], p[3])), b = fmaxf(fmaxf(p[4], p[5]), fmaxf(p[6], p[7]));
    float c = fmaxf(fmaxf(p[8], p[9]), fmaxf(p[10], p[11])), d = fmaxf(fmaxf(p[12], p[13]), fmaxf(p[14], p[15]));
    return fmaxf(fmaxf(a, b), fmaxf(c, d));
}
__device__ __forceinline__ float sum16(const f32x16& p) {
    return ((p[0] + p[1]) + (p[2] + p[3])) + ((p[4] + p[5]) + (p[6] + p[7])) + (((p[8] + p[9]) + (p[10] + p[11])) + ((p[12] + p[13]) + (p[14] + p[15])));
}
template <int KEYS> __device__ __forceinline__ void pv_tile(f32x16 (&o)[2], lds_cptr vbase, const bf16x8 (&pf)[KEYS / 16], int lane) {
    const int hi = lane >> 5, li = lane & 15;
    lds_cptr vp = vbase + (4 * hi + (li >> 2)) * 64 + ((lane >> 4) & 1) * 32 + (lane & 3) * 8;
#pragma unroll
    for (int d0 = 0; d0 < 2; ++d0)
#pragma unroll
        for (int ks = 0; ks < KEYS / 16; ++ks) {
            const s16x4 lo = vtr(vp + d0 * (KEYS * 64) + ks * 1024), hh = vtr(vp + d0 * (KEYS * 64) + ks * 1024 + 512);
            o[d0] = __builtin_amdgcn_mfma_f32_32x32x16_bf16(cat8(lo, hh), pf[ks], o[d0], 0, 0, 0);
        }
}
__device__ __forceinline__ void store_o(const f32x16 (&o)[2], float sc, bf16_t* orow, int hi) {
#pragma unroll
    for (int d0 = 0; d0 < 2; ++d0)
#pragma unroll
        for (int g = 0; g < 4; ++g) {
            u32x2 w; w.x = cvtpk(o[d0][4 * g] * sc, o[d0][4 * g + 1] * sc); w.y = cvtpk(o[d0][4 * g + 2] * sc, o[d0][4 * g + 3] * sc);
            *(u32x2*)(orow + d0 * 32 + g * 8 + hi * 4) = w;
        }
}

template <int DK> struct AttL { static constexpr int KS = DK * 2 + 16, KB = 64 * KS, VB = 8192, BUF = KB + VB, TOTAL = 2 * BUF; };
template <int DK, int MODE>
__device__ __forceinline__ void attn_unit(const bf16_t* Q, int ldq, const bf16_t* K, int ldk, const bf16_t* V, int ldv, bf16_t* O, int ldo, int qb, char* shm, float sc) {
    typedef AttL<DK> L;
    constexpr int NS = DK / 16, CPR = DK / 8;
    const int tid = opaque_tid(), lane = tid & 63, r32 = lane & 31, hi = lane >> 5; const int wid = __builtin_amdgcn_readfirstlane(tid >> 6);
    const int qpos = qb * 256 + wid * 32 + r32;
    bf16x8 qf[NS];
#pragma unroll
    for (int s = 0; s < NS; ++s) qf[s] = *(const bf16x8*)(Q + (size_t)qpos * ldq + s * 16 + hi * 8);
    const int kc0 = tid, kkey0 = kc0 / CPR, kch0 = kc0 % CPR;
    const int kc1 = 512 + tid, kkey1 = kc1 / CPR, kch1 = kc1 % CPR; const bool k2 = (DK == 96) && (tid < 256);
    const int vkey = tid >> 3, vch = tid & 7;
    const int voff = (vch >> 2) * 4096 + vkey * 64 + (vch & 3) * 16;
    const int nt = 4 * (qb + 1);
    f32x16 o[2]; o[0] = f32x16{}; o[1] = f32x16{};
    constexpr float SB_SAT = 160.0f; float wminR = 0.f;
    float mrun = -1e30f, lrun = (MODE == 1) ? 1.f : 0.f;
    u32x4 kr0A, kr1A = u32x4{}, vrA, kr0B, kr1B = u32x4{}, vrB;
#define ATT_FETCH(KR0, KR1, VR, tt) do { const size_t kb_ = (size_t)(tt) * 64; \
        KR0 = *(const u32x4*)(K + (kb_ + kkey0) * ldk + kch0 * 8); \
        if (k2) KR1 = *(const u32x4*)(K + (kb_ + kkey1) * ldk + kch1 * 8); \
        VR = *(const u32x4*)(V + (kb_ + vkey) * ldv + vch * 8); } while (0)
#define ATT_TILE(i_) ((MODE == 0) ? (i_) : nt - 1 - (i_))
    ATT_FETCH(kr0A, kr1A, vrA, ATT_TILE(0)); ATT_FETCH(kr0B, kr1B, vrB, ATT_TILE(1));
    bool done = false;
#define ATT_STEP(it, KR0, KR1, VR) { \
        const int tt = ATT_TILE(it); \
        char* buf = shm + ((it) & 1) * L::BUF; \
        *(u32x4*)(buf + kkey0 * L::KS + kch0 * 16) = KR0; \
        if (k2) *(u32x4*)(buf + kkey1 * L::KS + kch1 * 16) = KR1; \
        *(u32x4*)(buf + L::KB + voff) = VR; \
        __syncthreads(); \
        if (MODE == 1 && (it) > 0) { \
            const float* fl = (const float*)(shm + L::TOTAL) + (((it) - 1) & 1) * 8; \
            const float mnr = fminf(fminf(fminf(fl[0], fl[1]), fminf(fl[2], fl[3])), fminf(fminf(fl[4], fl[5]), fminf(fl[6], fl[7]))); \
            if (mnr >= SB_SAT) done = true; \
        } \
        if (!done) { \
        ATT_FETCH(KR0, KR1, VR, ATT_TILE(((it) + 2 < nt) ? (it) + 2 : nt - 1)); \
        att_compute(it, tt, buf); } }
    auto att_compute = [&](int it, int tt, char* buf) __attribute__((always_inline)) {
        const int kbase = tt * 64;
        bool active = !(kbase > qb * 256 + wid * 32 + 31);
        if (MODE == 1) active = active && (wminR < SB_SAT);
        if (active) {
        f32x16 p0 = f32x16{}, p1 = f32x16{};
        const char* kp = buf + r32 * L::KS + hi * 16;
#pragma unroll
        for (int s = 0; s < NS; ++s) {
            const bf16x8 a0 = *(const bf16x8*)(kp + s * 32), a1 = *(const bf16x8*)(kp + 32 * L::KS + s * 32);
            p0 = __builtin_amdgcn_mfma_f32_32x32x16_bf16(a0, qf[s], p0, 0, 0, 0);
            p1 = __builtin_amdgcn_mfma_f32_32x32x16_bf16(a1, qf[s], p1, 0, 0, 0);
        }
        const bool diag = (kbase + 63 >= qb * 256 + wid * 32);
        bf16x8 pf[4];
        if (MODE == 0) {
#pragma unroll
            for (int r = 0; r < 16; ++r) { p0[r] *= sc; p1[r] *= sc; }
            if (diag) {
#pragma unroll
                for (int r = 0; r < 16; ++r) { const int key = kbase + crow(r, hi); if (key > qpos) p0[r] = -INFINITY; if (key + 32 > qpos) p1[r] = -INFINITY; }
            }
            float rm = fmaxf(max16(p0), max16(p1)); rm = fmaxf(rm, __shfl_xor(rm, 32));
            const float mn = fmaxf(mrun, rm), f = __builtin_amdgcn_exp2f(mrun - mn); mrun = mn;
#pragma unroll
            for (int r = 0; r < 16; ++r) { p0[r] = __builtin_amdgcn_exp2f(p0[r] - mn); p1[r] = __builtin_amdgcn_exp2f(p1[r] - mn); }
            lrun = lrun * f + (sum16(p0) + sum16(p1));
#pragma unroll
            for (int r = 0; r < 16; ++r) { o[0][r] *= f; o[1][r] *= f; }
        } else {
            f32x16 om0, om1;
#pragma unroll
            for (int r = 0; r < 16; ++r) {
                const float e0 = __builtin_amdgcn_exp2f(-fmaxf(p0[r] * sc, -100.f)), e1 = __builtin_amdgcn_exp2f(-fmaxf(p1[r] * sc, -100.f));
                const float s0 = __builtin_amdgcn_rcpf(1.0f + e0), s1 = __builtin_amdgcn_rcpf(1.0f + e1);
                om0[r] = e0 * s0; om1[r] = e1 * s1; p0[r] = s0; p1[r] = s1;
            }
            if (diag) {
#pragma unroll
                for (int r = 0; r < 16; ++r) { const int key = kbase + crow(r, hi);
                    if (key >= qpos) { om0[r] = 1.f; p0[r] = 0.f; } if (key + 32 >= qpos) { om1[r] = 1.f; p1[r] = 0.f; } }
            }
            float gs[8], og[8];
#pragma unroll
            for (int g = 0; g < 4; ++g) { gs[g] = (om0[4 * g] * om0[4 * g + 1]) * (om0[4 * g + 2] * om0[4 * g + 3]); gs[4 + g] = (om1[4 * g] * om1[4 * g + 1]) * (om1[4 * g + 2] * om1[4 * g + 3]); }
#pragma unroll
            for (int g = 0; g < 8; ++g) og[g] = __shfl_xor(gs[g], 32);
            float suf = lrun;
#pragma unroll
            for (int g = 7; g >= 0; --g) {
                const float T = suf * (hi == 0 ? og[g] : 1.f);
                f32x16& om = (g < 4) ? om0 : om1; f32x16& pp = (g < 4) ? p0 : p1; const int b = 4 * (g & 3);
                const float l3 = T, l2 = l3 * om[b + 3], l1 = l2 * om[b + 2], l0 = l1 * om[b + 1];
                pp[b + 3] *= l3; pp[b + 2] *= l2; pp[b + 1] *= l1; pp[b] *= l0;
                suf *= gs[g] * og[g];
            }
            lrun = suf;
        }
        pf[0] = packp(p0, 0); pf[1] = packp(p0, 8); pf[2] = packp(p1, 0); pf[3] = packp(p1, 8);
        pv_tile<64>(o, (lds_cptr)(buf + L::KB), pf, lane);
        }
        if (MODE == 1) {
            float w = lrun;
#pragma unroll
            for (int sh = 1; sh < 32; sh <<= 1) w = fmaxf(w, __shfl_xor(w, sh));
            w = (w > 0.f) ? 0.f : 1000.f;
            wminR = __builtin_bit_cast(float, __builtin_amdgcn_readfirstlane(__builtin_bit_cast(int, w)));
            if (lane == 0) ((float*)(shm + L::TOTAL))[(it & 1) * 8 + wid] = wminR;
        }
    };
    for (int it = 0; it < nt && !done; it += 2) {
        ATT_STEP(it, kr0A, kr1A, vrA)
        if (done) break;
        ATT_STEP(it + 1, kr0B, kr1B, vrB)
    }
#undef ATT_STEP
#undef ATT_TILE
#undef ATT_FETCH
    float scl = 1.0f;
    if (MODE == 0) { const float lt = lrun + __shfl_xor(lrun, 32); scl = 1.0f / lt; }
    store_o(o, scl, O + (size_t)qpos * ldo, hi);
}

__device__ __forceinline__ void sb_unit_big(const bf16_t* Q, const bf16_t* K, const bf16_t* V, int ld, bf16_t* O, int ldo, int qb, char* shm, int maxch) {
    constexpr int KS = 144, KSUB = 64 * KS, KB = 4 * KSUB, VSUB = 8192, BUF = KB + 4 * VSUB, TOTAL = 2 * BUF;
    const int tid = opaque_tid(), lane = tid & 63, r32 = lane & 31, hi = lane >> 5; const int wid = __builtin_amdgcn_readfirstlane(tid >> 6);
    const float sc = 0.125f * kLog2e;
    const int qpos = qb * 256 + wid * 32 + r32;
    bf16x8 qf[4];
#pragma unroll
    for (int s = 0; s < 4; ++s) qf[s] = *(const bf16x8*)(Q + (size_t)qpos * ld + s * 16 + hi * 8);
    const int lkey = tid >> 3, lch = tid & 7;
    const int koff = lkey * KS + lch * 16, voff = KB + (lch >> 2) * 4096 + lkey * 64 + (lch & 3) * 16;
    f32x16 o[2]; o[0] = f32x16{}; o[1] = f32x16{};
    float carry = 1.f; bool wsat = false;
    u32x4 kr[4], vr[4];
#define SBB_FETCH(c) do { const size_t cb_ = (size_t)(c) * 256 + lkey; \
        _Pragma("unroll") for (int i = 0; i < 4; ++i) { kr[i] = *(const u32x4*)(K + (cb_ + 64 * i) * ld + lch * 8); vr[i] = *(const u32x4*)(V + (cb_ + 64 * i) * ld + lch * 8); } } while (0)
    auto sub_compute = [&](int kbase, const char* kt, const char* vt) __attribute__((always_inline)) {
        f32x16 p0 = f32x16{}, p1 = f32x16{};
        const char* kp = kt + r32 * KS + hi * 16;
#pragma unroll
        for (int s = 0; s < 4; ++s) {
            const bf16x8 a0 = *(const bf16x8*)(kp + s * 32), a1 = *(const bf16x8*)(kp + 32 * KS + s * 32);
            p0 = __builtin_amdgcn_mfma_f32_32x32x16_bf16(a0, qf[s], p0, 0, 0, 0);
            p1 = __builtin_amdgcn_mfma_f32_32x32x16_bf16(a1, qf[s], p1, 0, 0, 0);
        }
        f32x16 om0, om1;
#pragma unroll
        for (int r = 0; r < 16; ++r) {
            const float e0 = __builtin_amdgcn_exp2f(-fmaxf(p0[r] * sc, -100.f)), e1 = __builtin_amdgcn_exp2f(-fmaxf(p1[r] * sc, -100.f));
            const float s0 = __builtin_amdgcn_rcpf(1.0f + e0), s1 = __builtin_amdgcn_rcpf(1.0f + e1);
            om0[r] = e0 * s0; om1[r] = e1 * s1; p0[r] = s0; p1[r] = s1;
        }
        if (kbase + 63 >= qb * 256 + wid * 32) {
#pragma unroll
            for (int r = 0; r < 16; ++r) { const int key = kbase + crow(r, hi);
                if (key >= qpos) { om0[r] = 1.f; p0[r] = 0.f; } if (key + 32 >= qpos) { om1[r] = 1.f; p1[r] = 0.f; } }
        }
        float gs[8], og[8];
#pragma unroll
        for (int g = 0; g < 4; ++g) { gs[g] = (om0[4 * g] * om0[4 * g + 1]) * (om0[4 * g + 2] * om0[4 * g + 3]); gs[4 + g] = (om1[4 * g] * om1[4 * g + 1]) * (om1[4 * g + 2] * om1[4 * g + 3]); }
#pragma unroll
        for (int g = 0; g < 8; ++g) og[g] = __shfl_xor(gs[g], 32);
        float suf = carry;
#pragma unroll
        for (int g = 7; g >= 0; --g) {
            const float T = suf * (hi == 0 ? og[g] : 1.f);
            f32x16& om = (g < 4) ? om0 : om1; f32x16& pp = (g < 4) ? p0 : p1; const int b = 4 * (g & 3);
            const float l3 = T, l2 = l3 * om[b + 3], l1 = l2 * om[b + 2], l0 = l1 * om[b + 1];
            pp[b + 3] *= l3; pp[b + 2] *= l2; pp[b + 1] *= l1; pp[b] *= l0;
            suf *= gs[g] * og[g];
        }
        carry = suf;
        bf16x8 pf[4]; pf[0] = packp(p0, 0); pf[1] = packp(p0, 8); pf[2] = packp(p1, 0); pf[3] = packp(p1, 8);
        pv_tile<64>(o, (lds_cptr)vt, pf, lane);
        wsat = !__any(carry > 0.f);
    };
    const int nch = (qb + 1 < maxch) ? qb + 1 : maxch;
    SBB_FETCH(qb);
    for (int it = 0; it < nch; ++it) {
        char* buf = shm + (it & 1) * BUF;
#pragma unroll
        for (int i = 0; i < 4; ++i) { *(u32x4*)(buf + i * KSUB + koff) = kr[i]; *(u32x4*)(buf + i * VSUB + voff) = vr[i]; }
        __syncthreads();
        if (it > 0) {
            const float* fl = (const float*)(shm + TOTAL) + ((it - 1) & 1) * 8;
            const float mnr = fminf(fminf(fminf(fl[0], fl[1]), fminf(fl[2], fl[3])), fminf(fminf(fl[4], fl[5]), fminf(fl[6], fl[7])));
            if (mnr > 0.5f) break;
        }
        if (it + 1 < nch) SBB_FETCH(qb - it - 1);
        const int cbase = (qb - it) * 256;
#pragma unroll 1
        for (int sub = 3; sub >= 0; --sub) {
            const int kbase = cbase + 64 * sub;
            if (!(kbase > qb * 256 + wid * 32 + 31) && !wsat) sub_compute(kbase, buf + sub * KSUB, buf + KB + sub * VSUB);
        }
        if (lane == 0) ((float*)(shm + TOTAL))[(it & 1) * 8 + wid] = wsat ? 1.f : 0.f;
    }
#undef SBB_FETCH
    store_o(o, 1.0f, O + (size_t)qpos * ldo, hi);
    __syncthreads();
}

__device__ __forceinline__ void sb_wave_unit(const bf16_t* Q, const bf16_t* K, const bf16_t* V, int ld, bf16_t* O, int ldo, int q0, char* wl, int lane) {
    const int r32 = lane & 31, hi = lane >> 5;
    const float sc = 0.125f * kLog2e;
    const int qpos = q0 + r32;
    bf16x8 qf[4];
#pragma unroll
    for (int s = 0; s < 4; ++s) qf[s] = *(const bf16x8*)(Q + (size_t)qpos * ld + s * 16 + hi * 8);
    f32x16 o[2]; o[0] = f32x16{}; o[1] = f32x16{};
    float carry = 1.f;
#define SBW_LOAD(j, KF, VR) do { const size_t kb_ = (size_t)(j) * 32; \
        _Pragma("unroll") for (int s = 0; s < 4; ++s) KF[s] = *(const bf16x8*)(K + (kb_ + r32) * ld + s * 16 + hi * 8); \
        _Pragma("unroll") for (int c4 = 0; c4 < 4; ++c4) VR[c4] = *(const u32x4*)(V + (kb_ + (lane >> 3) + 8 * c4) * ld + (lane & 7) * 8); } while (0)
#define SBW_TILE(j, KF, VR) do { const int kbase = (j) * 32; \
        asm volatile("s_waitcnt lgkmcnt(0)" ::: "memory"); \
        _Pragma("unroll") for (int c4 = 0; c4 < 4; ++c4) { const int key = (lane >> 3) + 8 * c4, ch = lane & 7; \
            *(u32x4*)(wl + (ch >> 2) * 2048 + key * 64 + (ch & 3) * 16) = VR[c4]; } \
        f32x16 p = f32x16{}; \
        _Pragma("unroll") for (int s = 0; s < 4; ++s) p = __builtin_amdgcn_mfma_f32_32x32x16_bf16(KF[s], qf[s], p, 0, 0, 0); \
        f32x16 om; \
        _Pragma("unroll") for (int r = 0; r < 16; ++r) { \
            const float e = __builtin_amdgcn_exp2f(-fmaxf(p[r] * sc, -100.f)); const float sg = __builtin_amdgcn_rcpf(1.0f + e); \
            om[r] = e * sg; p[r] = sg; } \
        if (kbase + 31 >= q0) { \
            _Pragma("unroll") for (int r = 0; r < 16; ++r) { if (kbase + crow(r, hi) >= qpos) { om[r] = 1.f; p[r] = 0.f; } } } \
        float gs[4], og[4]; \
        _Pragma("unroll") for (int g = 0; g < 4; ++g) gs[g] = (om[4 * g] * om[4 * g + 1]) * (om[4 * g + 2] * om[4 * g + 3]); \
        _Pragma("unroll") for (int g = 0; g < 4; ++g) og[g] = __shfl_xor(gs[g], 32); \
        float suf = carry; \
        _Pragma("unroll") for (int g = 3; g >= 0; --g) { \
            const float T = suf * (hi == 0 ? og[g] : 1.f); const int b = 4 * g; \
            const float l3 = T, l2 = l3 * om[b + 3], l1 = l2 * om[b + 2], l0 = l1 * om[b + 1]; \
            p[b + 3] *= l3; p[b + 2] *= l2; p[b + 1] *= l1; p[b] *= l0; \
            suf *= gs[g] * og[g]; } \
        carry = suf; \
        bf16x8 pf[2]; pf[0] = packp(p, 0); pf[1] = packp(p, 8); \
        asm volatile("s_waitcnt lgkmcnt(0)" ::: "memory"); \
        pv_tile<32>(o, (lds_cptr)wl, pf, lane); } while (0)
    bf16x8 kfA[4], kfB[4], kfC[4]; u32x4 vrA[4], vrB[4], vrC[4];
    int j = (q0 + 30) >> 5;
#define SBW_CL(x) ((x) < 0 ? 0 : (x))
    SBW_LOAD(j, kfA, vrA);
    SBW_LOAD(SBW_CL(j - 1), kfB, vrB);
    for (;;) {
        SBW_LOAD(SBW_CL(j - 2), kfC, vrC);
        SBW_TILE(j, kfA, vrA);
        if (j < 1 || !__any(carry > 0.f)) break;
        SBW_LOAD(SBW_CL(j - 3), kfA, vrA);
        SBW_TILE(j - 1, kfB, vrB);
        if (j < 2 || !__any(carry > 0.f)) break;
        SBW_LOAD(SBW_CL(j - 4), kfB, vrB);
        SBW_TILE(j - 2, kfC, vrC);
        if (j < 3 || !__any(carry > 0.f)) break;
        j -= 3;
    }
#undef SBW_CL
#undef SBW_LOAD
#undef SBW_TILE
    asm volatile("s_waitcnt lgkmcnt(0)" ::: "memory");
    store_o(o, 1.0f, O + (size_t)qpos * ldo, hi);
}

__device__ __forceinline__ void dil_unit(const bf16_t* QKV, float* scr, bf16_t* O, int b, int h, int blk, char* shm) {
    const int tid = opaque_tid(), lane = tid & 63, r32 = lane & 31, hi = lane >> 5; const int wid = __builtin_amdgcn_readfirstlane(tid >> 6);
    const int T0 = blk * 512; const size_t rb = (size_t)b * 2048;
    const bf16_t* Qh = QKV + h * 64; const bf16_t* Kh = QKV + 512 + h * 64; const bf16_t* Vh = QKV + 1024 + h * 64;
    const float sc = 0.125f * kLog2e, slope2 = __builtin_amdgcn_exp2f(-(float)(h + 1)) * kLog2e;
    char* wl = shm + wid * 4096;
    float* sO = scr; float* sM = scr + 512 * 64; float* sL = sM + 512;
#pragma unroll 1
    for (int br = 0; br < 3; ++br) {
        const int lg = 2 * br, d = 1 << lg;
        const float sl = slope2 * (float)d;
#pragma unroll 1
        for (int rep = 0; rep < 2; ++rep) {
            const int k = wid + 8 * rep, res = k & (d - 1), c = k >> lg, tq0 = T0 + res + d * 32 * c;
            const int tq = tq0 + d * r32;
            bf16x8 qf[4];
#pragma unroll
            for (int s = 0; s < 4; ++s) qf[s] = *(const bf16x8*)(Qh + (rb + tq) * 1536 + s * 16 + hi * 8);
            f32x16 o[2]; o[0] = f32x16{}; o[1] = f32x16{};
            float mrun = -1e30f, lrun = 0.f;
#define DIL_LOAD(kt, KF, VR) do { int ktv_ = (kt); asm volatile("" : "+s"(ktv_)); const int ik0_ = -128 + 32 * ktv_; \
                int tk_ = tq0 + d * (ik0_ + r32); tk_ = tk_ < 0 ? 0 : tk_; \
                _Pragma("unroll") for (int s = 0; s < 4; ++s) KF[s] = *(const bf16x8*)(Kh + (rb + tk_) * 1536 + s * 16 + hi * 8); \
                _Pragma("unroll") for (int c4 = 0; c4 < 4; ++c4) { const int key_ = (lane >> 3) + 8 * c4; int tv_ = tq0 + d * (ik0_ + key_); tv_ = tv_ < 0 ? 0 : tv_; \
                    VR[c4] = *(const u32x4*)(Vh + (rb + tv_) * 1536 + (lane & 7) * 8); } } while (0)
#define DIL_TILE(kt, KF, VR) do { int ktw_ = (kt); asm volatile("" : "+s"(ktw_)); const int ik0 = -128 + 32 * ktw_; \
                asm volatile("s_waitcnt lgkmcnt(0)" ::: "memory"); \
                _Pragma("unroll") for (int c4 = 0; c4 < 4; ++c4) { const int key = (lane >> 3) + 8 * c4, ch = lane & 7; \
                    *(u32x4*)(wl + (ch >> 2) * 2048 + key * 64 + (ch & 3) * 16) = VR[c4]; } \
                f32x16 p = f32x16{}; \
                _Pragma("unroll") for (int s = 0; s < 4; ++s) p = __builtin_amdgcn_mfma_f32_32x32x16_bf16(KF[s], qf[s], p, 0, 0, 0); \
                _Pragma("unroll") for (int r = 0; r < 16; ++r) { \
                    const int key = crow(r, hi), rel = r32 - (ik0 + key); \
                    const bool valid = (rel >= 0) && (rel <= 128) && (tq0 + d * (ik0 + key) >= 0); \
                    const float s2 = p[r] * sc - sl * (float)rel; \
                    p[r] = valid ? s2 : -INFINITY; } \
                float rm = max16(p); rm = fmaxf(rm, __shfl_xor(rm, 32)); \
                const float mn = fmaxf(mrun, rm), f = __builtin_amdgcn_exp2f(mrun - mn); mrun = mn; \
                _Pragma("unroll") for (int r = 0; r < 16; ++r) p[r] = __builtin_amdgcn_exp2f(p[r] - mn); \
                lrun = lrun * f + sum16(p); \
                _Pragma("unroll") for (int r = 0; r < 16; ++r) { o[0][r] *= f; o[1][r] *= f; } \
                bf16x8 pf[2]; pf[0] = packp(p, 0); pf[1] = packp(p, 8); \
                asm volatile("s_waitcnt lgkmcnt(0)" ::: "memory"); \
                pv_tile<32>(o, (lds_cptr)wl, pf, lane); } while (0)
#define DIL_LIVE(kt) (tq0 + d * (-128 + 32 * (kt) + 31) >= 0)
            bf16x8 kfA[4], kfB[4], kfC[4]; u32x4 vrA[4], vrB[4], vrC[4];
            DIL_LOAD(4, kfA, vrA);
            DIL_LOAD(3, kfB, vrB);
            DIL_LOAD(2, kfC, vrC);
            DIL_TILE(4, kfA, vrA);
            if (DIL_LIVE(3)) {
                DIL_LOAD(1, kfA, vrA);
                DIL_TILE(3, kfB, vrB);
                if (DIL_LIVE(2)) {
                    DIL_LOAD(0, kfB, vrB);
                    DIL_TILE(2, kfC, vrC);
                    if (DIL_LIVE(1)) {
                        DIL_TILE(1, kfA, vrA);
                        if (DIL_LIVE(0)) DIL_TILE(0, kfB, vrB);
                    }
                }
            }
#undef DIL_LIVE
#undef DIL_LOAD
#undef DIL_TILE
            float lt = lrun + __shfl_xor(lrun, 32);
            const int ti = tq - T0;
            float* so = sO + (size_t)ti * 64;
            if (br > 0) {
                const float ms = sM[ti], ls = sL[ti];
                const float mn = fmaxf(ms, mrun), fs = __builtin_amdgcn_exp2f(ms - mn), fb = __builtin_amdgcn_exp2f(mrun - mn);
                lt = lt * fb + ls * fs; mrun = mn;
#pragma unroll
                for (int d0 = 0; d0 < 2; ++d0)
#pragma unroll
                    for (int g = 0; g < 4; ++g) { const f32x4 st = *(const f32x4*)(so + d0 * 32 + g * 8 + hi * 4);
#pragma unroll
                        for (int j = 0; j < 4; ++j) o[d0][4 * g + j] = o[d0][4 * g + j] * fb + st[j] * fs; }
            }
            if (br < 2) {
#pragma unroll
                for (int d0 = 0; d0 < 2; ++d0)
#pragma unroll
                    for (int g = 0; g < 4; ++g) *(f32x4*)(so + d0 * 32 + g * 8 + hi * 4) = (f32x4){o[d0][4 * g], o[d0][4 * g + 1], o[d0][4 * g + 2], o[d0][4 * g + 3]};
                if (hi == 0) { sM[ti] = mrun; sL[ti] = lt; }
            } else {
                store_o(o, 1.0f / lt, O + (rb + tq) * 1024 + h * 64, hi);
            }
        }
        __threadfence_block();
        __syncthreads();
    }
}
#undef ATT_LAS
}

typedef unsigned short bf16_t;
typedef float f32x4 __attribute__((ext_vector_type(4)));
typedef unsigned u32x4 __attribute__((ext_vector_type(4)));
typedef unsigned u32x2 __attribute__((ext_vector_type(2)));
constexpr int M_TOK = 32768, DM = 1024, DFF = 2816, SEQ = 2048;
constexpr int NTHR = 512;
constexpr size_t MiB = 1u << 20;
constexpr size_t WS_ROPE = 0;
constexpr size_t WS_SS   = 1 * MiB;
constexpr size_t WS_SSQ  = 3 * MiB;
constexpr size_t WS_SSKV = 4 * MiB;
constexpr size_t WS_BAR  = 5 * MiB;
constexpr size_t WS_W    = 8 * MiB;
constexpr size_t SZ_WGU = (size_t)5632 * 1024 * 2, SZ_WD = (size_t)1024 * 2816 * 2;
constexpr size_t WS_WGU0 = WS_W;
constexpr size_t WS_WIN0 = WS_W + 4 * (SZ_WGU + SZ_WD);
constexpr size_t WS_WUQ  = WS_WIN0 + (size_t)2048 * 1024 * 2;
constexpr size_t WS_WUKV = WS_WUQ + (size_t)768 * 256 * 2;
constexpr size_t WS_WOUT0 = WS_WUKV + (size_t)1024 * 128 * 2;
constexpr size_t WS_WIN1 = WS_WOUT0 + (size_t)1024 * 1024 * 2;
constexpr size_t WS_WOUT1 = WS_WIN1 + (size_t)3072 * 1024 * 2;
constexpr size_t WS_WEND = WS_WOUT1 + (size_t)1024 * 1024 * 2;
constexpr size_t WS_XB   = 96 * MiB;
constexpr size_t WS_DIL  = 472 * MiB;
constexpr size_t WS_BIG  = 160 * MiB;
constexpr size_t WS_H    = WS_BIG;
constexpr size_t WS_AQKV = WS_BIG;
constexpr size_t WS_CQ   = WS_AQKV + 96 * MiB;
constexpr size_t WS_CKV  = WS_CQ + 16 * MiB;
constexpr size_t WS_QM   = WS_CKV + 8 * MiB;
constexpr size_t WS_KM   = WS_QM + 48 * MiB;
constexpr size_t WS_VM   = WS_KM + 48 * MiB;
constexpr size_t WS_O0   = WS_VM + 32 * MiB;
constexpr size_t WS_END0 = WS_O0 + 64 * MiB;
constexpr size_t WS_QKV1 = WS_BIG;
constexpr size_t WS_O1   = WS_QKV1 + 192 * MiB;
constexpr size_t WS_END1 = WS_O1 + 64 * MiB;
constexpr size_t WS_NEED = 512 * MiB;
static_assert(WS_WEND <= WS_XB && WS_END0 <= WS_NEED && WS_END1 <= WS_NEED && WS_H + (size_t)M_TOK * DFF * 2 <= WS_NEED, "d_ws map");
constexpr size_t DIL_SCR_BYTES = (512 * 64 + 1024) * 4;
static_assert(WS_DIL >= WS_END0 && WS_DIL + 256 * DIL_SCR_BYTES <= WS_NEED, "dilated state after the layer-0 mixer buffers");
constexpr int LDS_BYTES = 131072 + 18432 + 64;

struct Args {
    const float* x; const float* ffn_norm_g; const float* mix_norm_g; const float* w_gate; const float* w_up; const float* w_down;
    const float* ab_w_in; const float* q_norm_g; const float* w_uq; const float* kv_norm_g; const float* w_ukv; const float* ab_w_out;
    const float* sb_w_in; const float* sb_w_out; const float* final_g; float* out; unsigned char* ws; int ph_lo, ph_hi;
};

__device__ __forceinline__ unsigned f2bf(float f) { unsigned u = __builtin_bit_cast(unsigned, f); return (u + 0x7fffu + ((u >> 16) & 1u)) >> 16; }
__device__ __forceinline__ unsigned pk2(float lo, float hi) { return f2bf(lo) | (f2bf(hi) << 16); }
__device__ __forceinline__ float wave_sum(float v) {
#pragma unroll
    for (int o = 1; o < 64; o <<= 1) v += __shfl_xor(v, o);
    return v;
}
template <int MAP> __device__ __forceinline__ int wrow(int n) {
    if (MAP == 0) return n;
    return (n >> 7) * 256 + (n & 127) + (MAP == 2 ? 128 : 0);
}
__device__ __forceinline__ unsigned pkh2(float lo, float hi) { typedef _Float16 h2_ __attribute__((ext_vector_type(2))); if (!RES_FP16) return pk2(lo, hi); h2_ v = {(_Float16)lo, (_Float16)hi}; return __builtin_bit_cast(unsigned, v); }
template <int MAP, bool F16> __device__ __forceinline__ void tr_item(const float* W, int K, int N, bf16_t* WT, const float* gain, float* scr, int item, int lane) {
    const int nblk = N / 32, kb = item / nblk, nb = item % nblk, k0 = 64 * kb, n0 = 32 * nb;
    float wv[32];
    const float gl = gain ? gain[k0 + lane] : 1.0f;
#pragma unroll
    for (int i = 0; i < 32; ++i) { const int kk = 2 * i + (lane >> 5); wv[i] = W[(size_t)(k0 + kk) * N + n0 + (lane & 31)]; }
#pragma unroll
    for (int i = 0; i < 32; ++i) { const int kk = 2 * i + (lane >> 5);
        const float g0 = __builtin_bit_cast(float, __builtin_amdgcn_readlane(__builtin_bit_cast(int, gl), 2 * i)), g1 = __builtin_bit_cast(float, __builtin_amdgcn_readlane(__builtin_bit_cast(int, gl), 2 * i + 1));
        scr[kk * 33 + (lane & 31)] = wv[i] * ((lane >> 5) ? g1 : g0); }
    asm volatile("s_waitcnt lgkmcnt(0)" ::: "memory");
    const int c = lane & 7;
#pragma unroll
    for (int j = 0; j < 4; ++j) { const int n = (lane >> 3) + 8 * j; const float* s = scr + (8 * c) * 33 + n;
        u32x4 o; if (F16) { o.x = pkh2(s[0 * 33], s[1 * 33]); o.y = pkh2(s[2 * 33], s[3 * 33]); o.z = pkh2(s[4 * 33], s[5 * 33]); o.w = pkh2(s[6 * 33], s[7 * 33]); }
        else { o.x = pk2(s[0 * 33], s[1 * 33]); o.y = pk2(s[2 * 33], s[3 * 33]); o.z = pk2(s[4 * 33], s[5 * 33]); o.w = pk2(s[6 * 33], s[7 * 33]); }
        *(u32x4*)(WT + (size_t)wrow<MAP>(n0 + n) * K + k0 + 8 * c) = o; }
    asm volatile("s_waitcnt lgkmcnt(0)" ::: "memory");
}

struct TrP { const float* W; const float* gain; bf16_t* WT; int K, N, map, item; };
__device__ __forceinline__ void tr_load(const TrP& p, int lane, float (&wv)[32], float& gl) {
    const int nblk = p.N / 32, kb = p.item / nblk, nb = p.item % nblk, k0 = 64 * kb, n0 = 32 * nb;
    gl = p.gain ? p.gain[k0 + lane] : 1.0f;
#pragma unroll
    for (int i = 0; i < 32; ++i) { const int kk = 2 * i + (lane >> 5); wv[i] = p.W[(size_t)(k0 + kk) * p.N + n0 + (lane & 31)]; }
}
__device__ __forceinline__ void tr_store(const TrP& p, int lane, const float (&wv)[32], float gl, float* scr) {
    const int nblk = p.N / 32, kb = p.item / nblk, nb = p.item % nblk, k0 = 64 * kb, n0 = 32 * nb;
#pragma unroll
    for (int i = 0; i < 32; ++i) { const int kk = 2 * i + (lane >> 5);
        const float g0 = __builtin_bit_cast(float, __builtin_amdgcn_readlane(__builtin_bit_cast(int, gl), 2 * i)), g1 = __builtin_bit_cast(float, __builtin_amdgcn_readlane(__builtin_bit_cast(int, gl), 2 * i + 1));
        scr[kk * 33 + (lane & 31)] = wv[i] * ((lane >> 5) ? g1 : g0); }
    asm volatile("s_waitcnt lgkmcnt(0)" ::: "memory");
    const int c = lane & 7;
#pragma unroll
    for (int j = 0; j < 4; ++j) { const int n = (lane >> 3) + 8 * j; const float* s = scr + (8 * c) * 33 + n;
        u32x4 o; o.x = pkh2(s[0 * 33], s[1 * 33]); o.y = pkh2(s[2 * 33], s[3 * 33]); o.z = pkh2(s[4 * 33], s[5 * 33]); o.w = pkh2(s[6 * 33], s[7 * 33]);
        const int nn = n0 + n; const int rowd = (p.map == 0) ? nn : (nn >> 7) * 256 + (nn & 127) + (p.map == 2 ? 128 : 0);
        *(u32x4*)(p.WT + (size_t)rowd * p.K + k0 + 8 * c) = o; }
    asm volatile("s_waitcnt lgkmcnt(0)" ::: "memory");
}

#define LAS __attribute__((address_space(3)))
#define XB_TMO      128
#define XB_XCNT(j)  (256  + 64 * (j))
#define XB_XSUB(j)  (1280 + 64 * (j))
#define XB_XGEN(j)  (2304 + 64 * (j))
#define XB_TOP      3328
#define XB_TOPGEN   3392
#define XCD_BAR_WORDS 3456
#define XB_SPIN_CAP (1u << 18)

__device__ __forceinline__ unsigned xb_ld(unsigned* p)              { return __hip_atomic_load(p, __ATOMIC_RELAXED, __HIP_MEMORY_SCOPE_AGENT); }
__device__ __forceinline__ unsigned xb_add(unsigned* p, unsigned v) { return __hip_atomic_fetch_add(p, v, __ATOMIC_RELAXED, __HIP_MEMORY_SCOPE_AGENT); }
__device__ __forceinline__ unsigned xb_xcc_id() { return (unsigned)__builtin_amdgcn_s_getreg((3 << 11) | 20) & 0xFu; }
#define XB_SPIN(cond, bar) do { unsigned _sp = 0; while (cond) { __builtin_amdgcn_s_sleep(1); \
    if ((++_sp & 255u) == 0u) { if (xb_ld(&(bar)[XB_TMO])) break; if (_sp > XB_SPIN_CAP) { atomicAdd(&(bar)[XB_TMO], 1u); break; } } } } while (0)

struct XcdBarrier {
    unsigned* bar; unsigned x;
    volatile LAS unsigned* st;
};

__device__ __forceinline__ XcdBarrier xcd_barrier_post(unsigned* bar, volatile LAS unsigned* st) {
    XcdBarrier b; b.bar = bar; b.x = xb_xcc_id(); b.st = st;
    if (threadIdx.x == 0) (void)xb_add(&bar[XB_XCNT(b.x)], 1u);
    return b;
}
__device__ __forceinline__ void xcd_barrier_complete(unsigned* bar, unsigned x, unsigned& nloc, unsigned& nx) {
    const unsigned G = gridDim.x * gridDim.y * gridDim.z;
    unsigned sum, cnt, mine, sp = 0u;
    for (;;) {
        sum = 0u; cnt = 0u; mine = 0u;
#pragma unroll
        for (unsigned j = 0; j < 16; ++j) { const unsigned c = xb_ld(&bar[XB_XCNT(j)]); sum += c; cnt += (c > 0u) ? 1u : 0u; mine = (j == x) ? c : mine; }
        if (sum == G) break;
        __builtin_amdgcn_s_sleep(1);
        if ((++sp & 255u) == 0u) { if (xb_ld(&bar[XB_TMO])) break; if (sp > XB_SPIN_CAP) { atomicAdd(&bar[XB_TMO], 1u); break; } }
    }
    nloc = mine > 0u ? mine : 1u; nx = cnt > 0u ? cnt : 1u;
}

__device__ __forceinline__ void xcd_barrier(const XcdBarrier& b) {
    asm volatile("s_waitcnt vmcnt(0)" ::: "memory");
    __syncthreads();
    if (threadIdx.x == 0) {
        unsigned* bar = b.bar;
        __builtin_amdgcn_s_waitcnt(0);
        unsigned nloc = b.st[0], nx = b.st[1];
        if (nloc == 0u) { xcd_barrier_complete(bar, b.x, nloc, nx); b.st[0] = nloc; b.st[1] = nx; }
        const unsigned old = xb_add(&bar[XB_XSUB(b.x)], 1u);
        const unsigned gen = old / nloc;
        if (old + 1u == (gen + 1u) * nloc) {
            __builtin_amdgcn_fence(__ATOMIC_RELEASE, "agent");
            asm volatile("s_waitcnt vmcnt(0)" ::: "memory");
            const unsigned og = xb_add(&bar[XB_TOP], 1u);
            const unsigned tg = og / nx;
            if (og + 1u == (tg + 1u) * nx) xb_add(&bar[XB_TOPGEN], 1u);
            else XB_SPIN(xb_ld(&bar[XB_TOPGEN]) == tg, bar);
            __builtin_amdgcn_fence(__ATOMIC_ACQUIRE, "agent");
            xb_add(&bar[XB_XGEN(b.x)], 1u);
            asm volatile("s_waitcnt vmcnt(0)" ::: "memory");
        } else {
            XB_SPIN(xb_ld(&bar[XB_XGEN(b.x)]) == gen, bar);
            __builtin_amdgcn_fence(__ATOMIC_ACQUIRE, "agent");
            asm volatile("s_waitcnt vmcnt(0)" ::: "memory");
        }
    }
    __syncthreads();
}

__device__ __forceinline__ void grid_bar(unsigned* bar, unsigned nblk, unsigned& gen) {
    asm volatile("s_waitcnt vmcnt(0)" ::: "memory");
    __syncthreads();
    gen += 1u;
    if (threadIdx.x == 0) {
        __builtin_amdgcn_fence(__ATOMIC_RELEASE, "agent");
        asm volatile("s_waitcnt vmcnt(0)" ::: "memory");
        const unsigned target = gen * nblk;
        const unsigned old = __hip_atomic_fetch_add(bar, 1u, __ATOMIC_RELAXED, __HIP_MEMORY_SCOPE_AGENT);
        unsigned* flag = bar + 64;
        if (old + 1u == target) __hip_atomic_store(flag, gen, __ATOMIC_RELAXED, __HIP_MEMORY_SCOPE_AGENT);
        else { unsigned spins = 0; while (__hip_atomic_load(flag, __ATOMIC_RELAXED, __HIP_MEMORY_SCOPE_AGENT) < gen) { __builtin_amdgcn_s_sleep(2); if (++spins > (1u << 24)) break; } }
        __builtin_amdgcn_fence(__ATOMIC_ACQUIRE, "agent");
        asm volatile("s_waitcnt vmcnt(0)" ::: "memory");
    }
    __syncthreads();
}

__global__ void __launch_bounds__(NTHR, 2) mk_fwd(Args a) {
    extern __shared__ __attribute__((aligned(16))) unsigned char lds[];
    cg::grid_group grid = cg::this_grid();
    const int G = gridDim.x, bid = blockIdx.x;
    unsigned char* ws = a.ws;
    float* rope = (float*)(ws + WS_ROPE); float* ss = (float*)(ws + WS_SS); float* ssq = (float*)(ws + WS_SSQ); float* sskv = (float*)(ws + WS_SSKV);
    bf16_t* XB = (bf16_t*)(ws + WS_XB); bf16_t* H = (bf16_t*)(ws + WS_H);
    PG8_LAS unsigned char* glds = (PG8_LAS unsigned char*)lds;
    int ph = 0;
    unsigned* gbar = (unsigned*)(ws + WS_BAR); unsigned gen = 0u; (void)gen;
    volatile LAS unsigned* xst = (volatile LAS unsigned*)((LAS unsigned char*)lds + 131072 + 18432);
    if (threadIdx.x < 2) xst[threadIdx.x] = 0u;
    __syncthreads();
    const XcdBarrier xbar = xcd_barrier_post(gbar, xst);
#ifndef PROBE_REPEAT
#define PROBE_REPEAT -1
#endif
#define PHASE_BEGIN if (ph >= a.ph_lo && ph < a.ph_hi) { for (int rep_ = (ph == PROBE_REPEAT ? 2 : 1); rep_ > 0; --rep_) {
#define PHASE_END(dosync_) } if ((dosync_) && ph + 1 < a.ph_hi) { if (a.ph_lo > 1000000) grid.sync(); xcd_barrier(xbar); } } ++ph;

    PHASE_BEGIN
    {
        const int tid = opaque_tid(), lane = tid & 63, wave = __builtin_amdgcn_readfirstlane(tid >> 6);
        float* scr = (float*)(lds + wave * 16384);
        const int gw = bid * 8 + wave, NGW = G * 8;
        constexpr int I_GU = 16 * 88, I_D = 44 * 32, I_IN0 = 16 * 61, I_UQ = 4 * 24, I_UKV = 2 * 32, I_O = 16 * 32, I_IN1 = 16 * 96;
        constexpr int NITEMS = 4 * (2 * I_GU + I_D) + I_IN0 + I_UQ + I_UKV + I_O + I_IN1 + I_O;
        auto get_item = [&](int it) __attribute__((always_inline)) -> TrP {
            TrP p; int r = it;
            if (r < 4 * (2 * I_GU + I_D)) {
                const int f = r / (2 * I_GU + I_D); r -= f * (2 * I_GU + I_D);
                bf16_t* wgu = (bf16_t*)(ws + WS_WGU0 + f * (SZ_WGU + SZ_WD)); bf16_t* wd = (bf16_t*)(ws + WS_WGU0 + f * (SZ_WGU + SZ_WD) + SZ_WGU);
                const float* g = a.ffn_norm_g + f * 1024;
                if (r < I_GU) p = TrP{a.w_gate + (size_t)f * 1024 * 2816, g, wgu, 1024, 2816, 1, r};
                else if (r < 2 * I_GU) p = TrP{a.w_up + (size_t)f * 1024 * 2816, g, wgu, 1024, 2816, 2, r - I_GU};
                else p = TrP{a.w_down + (size_t)f * 2816 * 1024, nullptr, wd, 2816, 1024, 0, r - 2 * I_GU};
                return p;
            }
            r -= 4 * (2 * I_GU + I_D);
            if (r < I_IN0) return TrP{a.ab_w_in, a.mix_norm_g, (bf16_t*)(ws + WS_WIN0), 1024, 1952, 0, r}; r -= I_IN0;
            if (r < I_UQ) return TrP{a.w_uq, a.q_norm_g, (bf16_t*)(ws + WS_WUQ), 256, 768, 0, r}; r -= I_UQ;
            if (r < I_UKV) return TrP{a.w_ukv, a.kv_norm_g, (bf16_t*)(ws + WS_WUKV), 128, 1024, 0, r}; r -= I_UKV;
            if (r < I_O) return TrP{a.ab_w_out, nullptr, (bf16_t*)(ws + WS_WOUT0), 1024, 1024, 0, r}; r -= I_O;
            if (r < I_IN1) return TrP{a.sb_w_in, a.mix_norm_g + 1024, (bf16_t*)(ws + WS_WIN1), 1024, 3072, 0, r}; r -= I_IN1;
            return TrP{a.sb_w_out, nullptr, (bf16_t*)(ws + WS_WOUT1), 1024, 1024, 0, r};
        };
        if (gw < NITEMS) {
            TrP cur = get_item(gw); float wv[32], gl; tr_load(cur, lane, wv, gl);
            for (int it = gw; it < NITEMS; it += NGW) {
                const int itn = (it + NGW < NITEMS) ? it + NGW : it;
                const TrP nxt = get_item(itn); float wn[32], gn; tr_load(nxt, lane, wn, gn);
                tr_store(cur, lane, wv, gl, scr);
                cur = nxt; gl = gn;
#pragma unroll
                for (int i = 0; i < 32; ++i) wv[i] = wn[i];
            }
        }
        { u32x4* z = (u32x4*)(ws + WS_WIN0 + (size_t)1952 * 1024 * 2); const int nz = 96 * 1024 * 2 / 16;
          for (int i = bid * NTHR + tid; i < nz; i += G * NTHR) z[i] = u32x4{0u, 0u, 0u, 0u}; }
        for (int i = bid * NTHR + tid; i < 2048 * 16; i += G * NTHR) {
            const int pos = i >> 4, fi = i & 15; double inv = 1.0;
            for (int q = 0; q < fi; ++q) inv *= 0.5623413251903491;
            const double rev = (double)pos * inv * 0.15915494309189535; const double fr = rev - (double)(long long)rev;
            const float ang = (float)(fr * 6.283185307179586);
            float sv, cv; sincosf(ang, &sv, &cv);
            rope[pos * 32 + fi] = cv; rope[pos * 32 + 16 + fi] = sv;
        }
        for (int m0 = gw; m0 < M_TOK; m0 += 4 * NGW) {
            f32x4 v[4][4];
#pragma unroll
            for (int q = 0; q < 4; ++q)
#pragma unroll
                for (int j = 0; j < 4; ++j) v[q][j] = ((const f32x4*)(a.x + (size_t)(m0 + q * NGW) * 1024) + lane)[64 * j];
#pragma unroll
            for (int q = 0; q < 4; ++q) { const int m = m0 + q * NGW; float s = 0.f;
                unsigned long long* o8 = (unsigned long long*)(XB + (size_t)m * 1024) + lane;
#pragma unroll
                for (int j = 0; j < 4; ++j) { const f32x4 w = v[q][j]; s += (w[0] * w[0] + w[1] * w[1]) + (w[2] * w[2] + w[3] * w[3]);
                    o8[64 * j] = (unsigned long long)pkh2(w[0], w[1]) | ((unsigned long long)pkh2(w[2], w[3]) << 32); }
                s = wave_sum(s);
                if (lane < 16) ss[(size_t)m * 16 + lane] = (lane == 0) ? s : 0.f; }
        }
        __syncthreads();
    }
    PHASE_END(true)

#define GEMM_PHASE(EPI, E, Aptr, Bptr, Nn, Kk) do { int kk_ = (Kk), nn_ = (Nn); asm volatile("" : "+s"(kk_), "+s"(nn_)); pg8::Gemm g_{(const bf16_t*)(Aptr), (const bf16_t*)(Bptr), M_TOK, nn_, kk_}; pg8::StaticOrder S_; S_.init(M_TOK, nn_, G, bid); \
        pg8::gemm_phase<EPI, pg8::StaticOrder, true, true>(glds, g_, S_, E); } while (0)

#pragma unroll 1
    for (int layer = 0; layer < 2; ++layer) {
#pragma unroll 1
        for (int half = 0; half < 2; ++half) {
            const int f = layer * 2 + half;
            const bf16_t* wgu = (const bf16_t*)(ws + WS_WGU0 + f * (SZ_WGU + SZ_WD)); const bf16_t* wd = (const bf16_t*)(ws + WS_WGU0 + f * (SZ_WGU + SZ_WD) + SZ_WGU);
            PHASE_BEGIN
            { pg8::EpiGU E{ss, H}; GEMM_PHASE(pg8::EpiGU, E, XB, wgu, 5632, 1024); }
            PHASE_END(true)
            PHASE_BEGIN
                        { if (f == 0) { pg8::EpiResidT<true> E{a.x, XB, ss, (rep_ == 2) ? 0.f : 0.5f, (float*)(lds + 131072)}; GEMM_PHASE(pg8::EpiResidT<true>, E, H, wd, 1024, 2816); }
              else { pg8::EpiResidT<false> E{a.x, XB, ss, (rep_ == 2) ? 0.f : 0.5f, (float*)(lds + 131072)}; GEMM_PHASE(pg8::EpiResidT<false>, E, H, wd, 1024, 2816); } }
            PHASE_END(true)
            if (half == 1) continue;
            if (layer == 0) {
                bf16_t* AQKV = (bf16_t*)(ws + WS_AQKV); bf16_t* CQ = (bf16_t*)(ws + WS_CQ); bf16_t* CKV = (bf16_t*)(ws + WS_CKV);
                bf16_t* QM = (bf16_t*)(ws + WS_QM); bf16_t* KM = (bf16_t*)(ws + WS_KM); bf16_t* VM = (bf16_t*)(ws + WS_VM); bf16_t* O0 = (bf16_t*)(ws + WS_O0);
                PHASE_BEGIN
                { pg8::EpiInAB E{ss, AQKV, CQ, CKV, KM, ssq, sskv, rope}; GEMM_PHASE(pg8::EpiInAB, E, XB, ws + WS_WIN0, 2048, 1024); }
                PHASE_END(true)
                PHASE_BEGIN
                { pg8::EpiUQ E{ssq, QM, rope}; GEMM_PHASE(pg8::EpiUQ, E, CQ, ws + WS_WUQ, 768, 256); }
                { pg8::EpiUKV E{sskv, KM, VM}; GEMM_PHASE(pg8::EpiUKV, E, CKV, ws + WS_WUKV, 1024, 128); }
                __syncthreads();
                for (int u = bid; u < 512; u += G) {
                    const int blk = u & 3, h = (u >> 2) & 7, b = u >> 5;
                    att::dil_unit(AQKV, (float*)(ws + WS_DIL + (size_t)bid * DIL_SCR_BYTES), O0, b, h, blk, (char*)lds);
                }
                PHASE_END(true)
                PHASE_BEGIN
                for (int i = 0; i < 4; ++i) {
                    const int v = bid + i * G; if (v >= 1024) break;
                    const int c = v & 255, rnd = v >> 8, bh = c >> 1, s = c & 1;
                    const int qb = (rnd == 0) ? s : (rnd == 1) ? 7 - s : (rnd == 2) ? 2 + s : 5 - s;
                    const int b = bh >> 3, h = bh & 7; const size_t rb = (size_t)b * 2048;
                    att::attn_unit<96, 0>(QM + rb * 768 + h * 96, 768, KM + rb * 768 + h * 96, 768, VM + rb * 512 + h * 64, 512, O0 + rb * 1024 + 512 + h * 64, 1024, qb, (char*)lds,
                                          0.10206207261596575f * att::kLog2e);
                }
                __syncthreads();
                PHASE_END(true)
                PHASE_BEGIN
                { pg8::EpiResidT<false> E{a.x, XB, ss, (rep_ == 2) ? 0.f : 1.0f, (float*)(lds + 131072)}; GEMM_PHASE(pg8::EpiResidT<false>, E, O0, ws + WS_WOUT0, 1024, 1024); }
                PHASE_END(true)
            } else {
                bf16_t* QKV = (bf16_t*)(ws + WS_QKV1); bf16_t* O1 = (bf16_t*)(ws + WS_O1);
                PHASE_BEGIN
                { pg8::EpiScale E{ss, QKV, 3072}; GEMM_PHASE(pg8::EpiScale, E, XB, ws + WS_WIN1, 3072, 1024); }
                PHASE_END(true)
                PHASE_BEGIN
                {
                    const int tid = opaque_tid(), lane = tid & 63, wave = __builtin_amdgcn_readfirstlane(tid >> 6);
                    for (int bh = bid; bh < 256; bh += G) {
                        const int b = bh >> 4, h = bh & 15; const size_t rb = (size_t)b * 2048;
                        for (int rnd = 7; rnd >= 0; --rnd)
                            att::sb_wave_unit(QKV + rb * 3072 + h * 64, QKV + rb * 3072 + 1024 + h * 64, QKV + rb * 3072 + 2048 + h * 64, 3072, O1 + rb * 1024 + h * 64, 1024, (rnd * 8 + wave) * 32, (char*)lds + wave * 4096, lane);
                    }
                }
                __syncthreads();
                PHASE_END(true)
                PHASE_BEGIN
                { pg8::EpiResidT<false> E{a.x, XB, ss, (rep_ == 2) ? 0.f : 1.0f, (float*)(lds + 131072)}; GEMM_PHASE(pg8::EpiResidT<false>, E, O1, ws + WS_WOUT1, 1024, 1024); }
                PHASE_END(true)
            }
        }
    }
    PHASE_BEGIN
    {
        const int tid = opaque_tid(), lane = tid & 63, wave = __builtin_amdgcn_readfirstlane(tid >> 6);
        const int gw = bid * 8 + wave, NGW = G * 8;
        f32x4 gv[4];
#pragma unroll
        for (int j = 0; j < 4; ++j) gv[j] = ((const f32x4*)a.final_g + lane)[64 * j];
        for (int m0 = gw; m0 < M_TOK; m0 += 4 * NGW) {
            u32x2 v[4][4]; float sq[4];
#pragma unroll
            for (int q = 0; q < 4; ++q) { const int m = m0 + q * NGW; sq[q] = (lane < 16) ? ss[(size_t)m * 16 + lane] : 0.f;
#pragma unroll
                for (int j = 0; j < 4; ++j) v[q][j] = ((const u32x2*)(XB + (size_t)m * 1024) + lane)[64 * j]; }
#pragma unroll
            for (int q = 0; q < 4; ++q) { const int m = m0 + q * NGW; const float rs = __builtin_amdgcn_rsqf(wave_sum(sq[q]) * (1.0f / 1024.0f) + 1e-6f);
                f32x4* xr = (f32x4*)(a.out + (size_t)m * 1024) + lane;
#pragma unroll
                for (int j = 0; j < 4; ++j) xr[64 * j] = pg8::unpk4h(v[q][j]) * rs * gv[j]; }
        }
    }
    PHASE_END(false)
#undef PHASE_BEGIN
#undef PHASE_END
#undef GEMM_PHASE
}

extern "C" void kernel_launch(void* const* d_in, const int* in_sizes, int n_in, void* d_out, int out_size, void* d_ws, size_t ws_size, hipStream_t stream) {
    static int grid = 0;
    if (grid == 0) {
        if (n_in != 15 || in_sizes[0] != M_TOK * DM || out_size != M_TOK * DM || ws_size < WS_NEED) {
            fprintf(stderr, "kernel_launch: unexpected shapes (n_in %d in0 %d out %d ws %zu)\n", n_in, n_in > 0 ? in_sizes[0] : -1, out_size, ws_size); grid = -1; return; }
        int dev = 0, cus = 0, per_cu = 0;
        (void)hipGetDevice(&dev); (void)hipDeviceGetAttribute(&cus, hipDeviceAttributeMultiprocessorCount, dev);
        if (hipFuncSetAttribute((const void*)mk_fwd, hipFuncAttributeMaxDynamicSharedMemorySize, LDS_BYTES) != hipSuccess) { fprintf(stderr, "kernel_launch: hipFuncSetAttribute failed\n"); grid = -1; return; }
        if (hipOccupancyMaxActiveBlocksPerMultiprocessor(&per_cu, (const void*)mk_fwd, NTHR, LDS_BYTES) != hipSuccess || per_cu < 1) { fprintf(stderr, "kernel_launch: occupancy query failed (%d)\n", per_cu); per_cu = 1; }
        (void)hipGetLastError();
        grid = cus * 1;
        if (grid <= 0) grid = 256;
    }
    if (grid < 0) return;
    Args a{};
    a.x = (const float*)d_in[0]; a.ffn_norm_g = (const float*)d_in[1]; a.mix_norm_g = (const float*)d_in[2]; a.w_gate = (const float*)d_in[3]; a.w_up = (const float*)d_in[4]; a.w_down = (const float*)d_in[5];
    a.ab_w_in = (const float*)d_in[6]; a.q_norm_g = (const float*)d_in[7]; a.w_uq = (const float*)d_in[8]; a.kv_norm_g = (const float*)d_in[9]; a.w_ukv = (const float*)d_in[10]; a.ab_w_out = (const float*)d_in[11];
    a.sb_w_in = (const float*)d_in[12]; a.sb_w_out = (const float*)d_in[13]; a.final_g = (const float*)d_in[14]; a.out = (float*)d_out; a.ws = (unsigned char*)d_ws;
    a.ph_lo = 0; a.ph_hi = 1000;
    if (hipMemsetAsync((char*)d_ws + WS_BAR, 0, 16384, stream) != hipSuccess) { fprintf(stderr, "kernel_launch: memset of the barrier words failed\n"); return; }
    void* args[] = {&a};
    hipError_t e = hipLaunchCooperativeKernel((const void*)mk_fwd, dim3(grid), dim3(NTHR), args, LDS_BYTES, stream);
    if (e != hipSuccess) fprintf(stderr, "kernel_launch: cooperative launch failed: %s (grid %d)\n", hipGetErrorString(e), grid);
}
```

```cpp
#include <hip/hip_runtime.h>
#include <hip/hip_cooperative_groups.h>
#include <cstdio>
#include <cstdint>
namespace cg = cooperative_groups;

__device__ __forceinline__ int opaque_tid() { int t = threadIdx.x; asm volatile("" : "+v"(t)); return t; }
namespace pg8 {
#define PG8_LAS __attribute__((address_space(3)))
typedef unsigned short bf16_t;
typedef short bf16x8 __attribute__((ext_vector_type(8)));
typedef float f32x4 __attribute__((ext_vector_type(4)));
typedef unsigned u32x4 __attribute__((ext_vector_type(4)));
constexpr int BM = 256, BK = 64, HALF = 128, HTB = HALF * BK * 2  , STAGE_BYTES = 8 * HTB, NXCD = 8, WGM = 8;

__host__ __device__ __forceinline__ int lds_byte(int r, int c) { const int st = (r >> 4) * 2 + (c >> 5), rr = r & 15, cc = c & 31, ob = rr * 64 + cc * 2; return st * 1024 + (ob ^ (((ob >> 9) & 1) << 5)); }
__host__ __device__ __forceinline__ void stage_rc(int b, int& R, int& C) { const int st = b / 1024, sb = b % 1024, swz = sb ^ (((sb >> 9) & 1) << 5); R = (st >> 1) * 16 + swz / 64; C = (st & 1) * 32 + (swz % 64) / 2; }
__host__ __device__ __forceinline__ int perm32(int rho) { const int n = rho >> 4, i = rho & 15; return 8 * (i >> 2) + 4 * n + (i & 3); }

struct Unit { int pm, pn; };
struct Gemm { const bf16_t* A; const bf16_t* Bt; int M, N, K; };

struct StaticOrder {
    int nM, nN, nwg, G, c;
    __host__ __device__ void init(int M, int N, int G_, int c_) { nM = M / BM; nN = N / BM; nwg = nM * nN; G = G_; c = c_; }
    __host__ __device__ bool next(int i, Unit& u) const {
        const long L = (long)i * G + c; if (L >= nwg) return false;
        int wgid = (int)L; { const int q = nwg / NXCD, r = nwg % NXCD, xcd = wgid % NXCD, off = wgid / NXCD; wgid = (xcd < r ? xcd * (q + 1) : r * (q + 1) + (xcd - r) * q) + off; }
        const int nig = WGM * nN, gid = wgid / nig, fm = gid * WGM, gsz = (nM - fm) < WGM ? (nM - fm) : WGM;
        u.pm = fm + ((wgid % nig) % gsz); u.pn = (wgid % nig) / gsz; return true;
    }
    __device__ __forceinline__ void a_ready(const Unit&) const {}
    __device__ __forceinline__ void done(const Unit&) const {}
};

__device__ __forceinline__ unsigned cvt_pk_bf16(float lo, float hi) { unsigned r; asm volatile("v_cvt_pk_bf16_f32 %0, %1, %2" : "=v"(r) : "v"(lo), "v"(hi)); return r; }
typedef unsigned u32x2 __attribute__((ext_vector_type(2)));
constexpr float kEps = 1e-6f;
typedef _Float16 f16x8 __attribute__((ext_vector_type(8)));
typedef _Float16 f16x2 __attribute__((ext_vector_type(2)));
template <bool F16> __device__ __forceinline__ f32x4 mma16(bf16x8 a, bf16x8 b, f32x4 c) {
    if (F16) return __builtin_amdgcn_mfma_f32_16x16x32_f16(__builtin_bit_cast(f16x8, a), __builtin_bit_cast(f16x8, b), c, 0, 0, 0);
    return __builtin_amdgcn_mfma_f32_16x16x32_bf16(a, b, c, 0, 0, 0);
}
#ifndef RES_FP16
#define RES_FP16 0
#endif
__device__ __forceinline__ unsigned pkh(float lo, float hi) { if (!RES_FP16) return cvt_pk_bf16(lo, hi); f16x2 v = {(_Float16)lo, (_Float16)hi}; return __builtin_bit_cast(unsigned, v); }
__device__ __forceinline__ f32x4 unpk4h(u32x2 w) { if (!RES_FP16) return (f32x4){__builtin_bit_cast(float, w.x << 16), __builtin_bit_cast(float, w.x & 0xffff0000u), __builtin_bit_cast(float, w.y << 16), __builtin_bit_cast(float, w.y & 0xffff0000u)}; const f16x2 a = __builtin_bit_cast(f16x2, w.x), b = __builtin_bit_cast(f16x2, w.y); return (f32x4){(float)a[0], (float)a[1], (float)b[0], (float)b[1]}; }

constexpr float kLog2e = 1.4426950408889634f;
__device__ __forceinline__ u32x2 pack4(const f32x4 v) { u32x2 w; w.x = cvt_pk_bf16(v[0], v[1]); w.y = cvt_pk_bf16(v[2], v[3]); return w; }
template <int NP> __device__ __forceinline__ float row_rstd(const float* ss, int row, float inv_n) {
    float s = 0.f;
#pragma unroll
    for (int i = 0; i < NP / 4; ++i) { const f32x4 v = *(const f32x4*)(ss + (size_t)row * NP + 4 * i); s += (v[0] + v[1]) + (v[2] + v[3]); }
    return __builtin_amdgcn_rsqf(s * inv_n + kEps);
}
__device__ __forceinline__ float quad_sum(float s) { s += __shfl_xor(s, 16); s += __shfl_xor(s, 32); return s; }


template <int NP> __device__ __forceinline__ void load_rstd8(const float* ss, const Unit& u, int wr, int fr, int fq, float inv_n, float (&rs)[2][4]) {
    f32x4 v[2][4];
#pragma unroll
    for (int ai = 0; ai < 2; ++ai)
#pragma unroll
        for (int m = 0; m < 4; ++m) { const int row = u.pm * BM + ai * HALF + wr * 64 + m * 16 + fr; v[ai][m] = *(const f32x4*)(ss + (size_t)row * NP + (NP == 16 ? 4 * fq : 0)); }
#pragma unroll
    for (int ai = 0; ai < 2; ++ai)
#pragma unroll
        for (int m = 0; m < 4; ++m) { float t = (v[ai][m][0] + v[ai][m][1]) + (v[ai][m][2] + v[ai][m][3]); if (NP == 16) t = quad_sum(t); rs[ai][m] = __builtin_amdgcn_rsqf(t * inv_n + kEps); }
}

struct EpiGU {
    static constexpr bool PERM = true, AFTER_DRAIN = false, F16 = (RES_FP16 != 0);
    const float* ss; bf16_t* H;
    __device__ __forceinline__ void operator()(const f32x4 (&acc)[2][2][4][2], const Unit& u, int wr, int wc, int fr, int fq) const {
        float rsv[2][4]; load_rstd8<16>(ss, u, wr, fr, fq, 1.0f / 1024.0f, rsv);
        typedef unsigned u32x4_ __attribute__((ext_vector_type(4)));
#pragma unroll
        for (int ai = 0; ai < 2; ++ai)
#pragma unroll
            for (int m = 0; m < 4; ++m) {
                const int row = u.pm * BM + ai * HALF + wr * 64 + m * 16 + fr;
                const float rs = rsv[ai][m];
                u32x2 w[2];
#pragma unroll
                for (int n = 0; n < 2; ++n) {
                    const f32x4 g = acc[ai][0][m][n] * rs, up = acc[ai][1][m][n] * rs; f32x4 o;
#pragma unroll
                    for (int j = 0; j < 4; ++j) { const float e = __builtin_amdgcn_exp2f(-g[j] * kLog2e); o[j] = g[j] * up[j] * __builtin_amdgcn_rcpf(1.0f + e); }
                    w[n] = pack4(o);
                }
                *(u32x4_*)(H + (size_t)row * 2816 + u.pn * 128 + wc * 32 + fq * 8) = (u32x4_){w[0].x, w[0].y, w[1].x, w[1].y};
            }
    }
};
template <bool SRC32> struct EpiResidT {
    static constexpr bool PERM = false, AFTER_DRAIN = false, F16 = false;
    const float* x32; bf16_t* X16; float* ss; float alpha; float* wlds;
    __device__ __forceinline__ void operator()(const f32x4 (&acc)[2][2][4][2], const Unit& u, int wr, int wc, int fr, int fq) const {
        float* wl = wlds + (wr * 4 + wc) * 576;
        const int lane = fq * 16 + fr, rl = lane >> 3, ch = lane & 7;
        f32x4 rb[2][2][2][2];
        const size_t cbase = (size_t)u.pn * BM + wc * 32 + ch * 4;
#define RES_LOAD(buf, b) do { _Pragma("unroll") for (int gg = 0; gg < 2; ++gg) { const int g_ = 2 * (b) + gg; const int row0_ = u.pm * BM + (g_ >> 2) * HALF + wr * 64 + (g_ & 3) * 16 + rl; \
            _Pragma("unroll") for (int bj = 0; bj < 2; ++bj) _Pragma("unroll") for (int i = 0; i < 2; ++i) { const size_t o_ = (size_t)(row0_ + 8 * i) * 1024 + cbase + bj * HALF; \
                if (SRC32) rb[buf][gg][bj][i] = *(const f32x4*)(x32 + o_); else rb[buf][gg][bj][i] = unpk4h(*(const u32x2*)(X16 + o_)); } } } while (0)
        RES_LOAD(0, 0);
#pragma unroll
        for (int b = 0; b < 4; ++b) {
            if (b + 1 < 4) RES_LOAD((b + 1) & 1, b + 1);
#pragma unroll
            for (int gg = 0; gg < 2; ++gg) {
                const int g = 2 * b + gg, ai = g >> 2, m = g & 3;
                const int row0 = u.pm * BM + ai * HALF + wr * 64 + m * 16 + rl;
                float sq[2] = {0.f, 0.f};
#pragma unroll
                for (int bj = 0; bj < 2; ++bj) {
                    *(f32x4*)(wl + fr * 36 + fq * 4) = acc[ai][bj][m][0] * alpha; *(f32x4*)(wl + fr * 36 + 16 + fq * 4) = acc[ai][bj][m][1] * alpha;
                    asm volatile("s_waitcnt lgkmcnt(0)" ::: "memory");
#pragma unroll
                    for (int i = 0; i < 2; ++i) {
                        const f32x4 x = rb[b & 1][gg][bj][i] + *(const f32x4*)(wl + (rl + 8 * i) * 36 + ch * 4);
                        const size_t off = (size_t)(row0 + 8 * i) * 1024 + cbase + bj * HALF;
                        u32x2 w; w.x = pkh(x[0], x[1]); w.y = pkh(x[2], x[3]); *(u32x2*)(X16 + off) = w;
                        sq[i] += (x[0] * x[0] + x[1] * x[1]) + (x[2] * x[2] + x[3] * x[3]);
                    }
                    asm volatile("s_waitcnt lgkmcnt(0)" ::: "memory");
                }
#pragma unroll
                for (int i = 0; i < 2; ++i) { float t = sq[i]; t += __shfl_xor(t, 1); t += __shfl_xor(t, 2); t += __shfl_xor(t, 4);
                    if (ch == 0) ss[(size_t)(row0 + 8 * i) * 16 + u.pn * 4 + wc] = t; }
            }
        }
#undef RES_LOAD
    }
};
struct EpiScale {
    static constexpr bool PERM = true, AFTER_DRAIN = false, F16 = (RES_FP16 != 0);
    const float* ss; bf16_t* O; int ldc;
    __device__ __forceinline__ void operator()(const f32x4 (&acc)[2][2][4][2], const Unit& u, int wr, int wc, int fr, int fq) const {
        float rsv[2][4]; load_rstd8<16>(ss, u, wr, fr, fq, 1.0f / 1024.0f, rsv);
        typedef unsigned u32x4_ __attribute__((ext_vector_type(4)));
#pragma unroll
        for (int ai = 0; ai < 2; ++ai)
#pragma unroll
            for (int m = 0; m < 4; ++m) {
                const int row = u.pm * BM + ai * HALF + wr * 64 + m * 16 + fr;
                const float rs = rsv[ai][m];
#pragma unroll
                for (int bj = 0; bj < 2; ++bj) {
                    const u32x2 lo = pack4(acc[ai][bj][m][0] * rs), hi = pack4(acc[ai][bj][m][1] * rs);
                    *(u32x4_*)(O + (size_t)row * ldc + u.pn * BM + bj * HALF + wc * 32 + fq * 8) = (u32x4_){lo.x, lo.y, hi.x, hi.y};
                }
            }
    }
};
struct EpiInAB {
    static constexpr bool PERM = false, AFTER_DRAIN = false, F16 = (RES_FP16 != 0);
    const float* ss; bf16_t* AQKV; bf16_t* CQ; bf16_t* CKV; bf16_t* KM; float* ssq; float* sskv; const float* rope;
    __device__ __forceinline__ void operator()(const f32x4 (&acc)[2][2][4][2], const Unit& u, int wr, int wc, int fr, int fq) const {
        float rsv[2][4]; load_rstd8<16>(ss, u, wr, fr, fq, 1.0f / 1024.0f, rsv);
#pragma unroll
        for (int ai = 0; ai < 2; ++ai)
#pragma unroll
            for (int m = 0; m < 4; ++m) {
                asm volatile("" ::: "memory"); const int row = u.pm * BM + ai * HALF + wr * 64 + m * 16 + fr;
                const float rs = rsv[ai][m];
                if (u.pn < 6) {
#pragma unroll
                    for (int bj = 0; bj < 2; ++bj)
#pragma unroll
                        for (int n = 0; n < 2; ++n)
                            *(u32x2*)(AQKV + (size_t)row * 1536 + u.pn * BM + bj * HALF + wc * 32 + n * 16 + fq * 4) = pack4(acc[ai][bj][m][n] * rs);
                } else if (u.pn == 6) {
                    float s = 0.f;
#pragma unroll
                    for (int bj = 0; bj < 2; ++bj)
#pragma unroll
                        for (int n = 0; n < 2; ++n) { const f32x4 x = acc[ai][bj][m][n] * rs;
                            *(u32x2*)(CQ + (size_t)row * 256 + bj * HALF + wc * 32 + n * 16 + fq * 4) = pack4(x);
                            s += (x[0] * x[0] + x[1] * x[1]) + (x[2] * x[2] + x[3] * x[3]); }
                    s = quad_sum(s);
                    if (fq == 0) ssq[(size_t)row * 4 + wc] = s;
                } else {
                    float s = 0.f;
#pragma unroll
                    for (int n = 0; n < 2; ++n) { const f32x4 x = acc[ai][0][m][n] * rs;
                        *(u32x2*)(CKV + (size_t)row * 128 + wc * 32 + n * 16 + fq * 4) = pack4(x);
                        s += (x[0] * x[0] + x[1] * x[1]) + (x[2] * x[2] + x[3] * x[3]); }
                    s = quad_sum(s);
                    if (fq == 0) sskv[(size_t)row * 4 + wc] = s;
                    if (wc == 0) {
                        const f32x4 x1 = acc[ai][1][m][0] * rs, x2 = acc[ai][1][m][1] * rs;
                        const int pos = row & 2047;
                        const f32x4 c = *(const f32x4*)(rope + pos * 32 + fq * 4), sn = *(const f32x4*)(rope + pos * 32 + 16 + fq * 4);
                        const u32x2 o1 = pack4(x1 * c - x2 * sn), o2 = pack4(x1 * sn + x2 * c);
#pragma unroll
                        for (int h = 0; h < 8; ++h) { bf16_t* kp = KM + (size_t)row * 768 + h * 96 + 64 + fq * 4; *(u32x2*)kp = o1; *(u32x2*)(kp + 16) = o2; }
                    }
                }
            }
    }
};
struct EpiUQ {
    static constexpr bool PERM = false, AFTER_DRAIN = false, F16 = false;
    const float* ssq; bf16_t* Q; const float* rope;
    __device__ __forceinline__ void operator()(const f32x4 (&acc)[2][2][4][2], const Unit& u, int wr, int wc, int fr, int fq) const {
        float rsv[2][4]; load_rstd8<4>(ssq, u, wr, fr, fq, 1.0f / 256.0f, rsv);
        f32x4 rc[2][4], rsn[2][4];
#pragma unroll
        for (int ai = 0; ai < 2; ++ai)
#pragma unroll
            for (int m = 0; m < 4; ++m) { const int pos = (u.pm * BM + ai * HALF + wr * 64 + m * 16 + fr) & 2047;
                rc[ai][m] = *(const f32x4*)(rope + pos * 32 + fq * 4); rsn[ai][m] = *(const f32x4*)(rope + pos * 32 + 16 + fq * 4); }
#pragma unroll
        for (int ai = 0; ai < 2; ++ai)
#pragma unroll
            for (int m = 0; m < 4; ++m) {
                const int row = u.pm * BM + ai * HALF + wr * 64 + m * 16 + fr;
                const float rs = rsv[ai][m];
#pragma unroll
                for (int bj = 0; bj < 2; ++bj) {
                    const int cb = u.pn * BM + bj * HALF + wc * 32;
                    f32x4 x1 = acc[ai][bj][m][0] * rs, x2 = acc[ai][bj][m][1] * rs;
                    if ((cb % 96) == 64) { const f32x4 c = rc[ai][m], sn = rsn[ai][m]; const f32x4 y1 = x1 * c - x2 * sn, y2 = x1 * sn + x2 * c; x1 = y1; x2 = y2; }
                    bf16_t* qp = Q + (size_t)row * 768 + cb + fq * 4; *(u32x2*)qp = pack4(x1); *(u32x2*)(qp + 16) = pack4(x2);
                }
            }
    }
};
struct EpiUKV {
    static constexpr bool PERM = false, AFTER_DRAIN = false, F16 = false;
    const float* sskv; bf16_t* KM; bf16_t* VM;
    __device__ __forceinline__ void operator()(const f32x4 (&acc)[2][2][4][2], const Unit& u, int wr, int wc, int fr, int fq) const {
        float rsv[2][4]; load_rstd8<4>(sskv, u, wr, fr, fq, 1.0f / 128.0f, rsv);
#pragma unroll
        for (int ai = 0; ai < 2; ++ai)
#pragma unroll
            for (int m = 0; m < 4; ++m) {
                asm volatile("" ::: "memory"); const int row = u.pm * BM + ai * HALF + wr * 64 + m * 16 + fr;
                const float rs = rsv[ai][m];
#pragma unroll
                for (int bj = 0; bj < 2; ++bj) {
                    const int cb = u.pn * BM + bj * HALF + wc * 32, h = cb >> 7, w = cb & 127;
                    bf16_t* p = (w < 64) ? (KM + (size_t)row * 768 + h * 96 + w + fq * 4) : (VM + (size_t)row * 512 + h * 64 + (w - 64) + fq * 4);
                    *(u32x2*)p = pack4(acc[ai][bj][m][0] * rs); *(u32x2*)(p + 16) = pack4(acc[ai][bj][m][1] * rs);
                }
            }
    }
};

struct EpiNull {
    static constexpr bool PERM = false, AFTER_DRAIN = false, F16 = false;
    __device__ __forceinline__ void operator()(const f32x4 (&acc)[2][2][4][2], const Unit& u, int wr, int wc, int fr, int fq) const {
#pragma unroll
        for (int ai = 0; ai < 2; ++ai)
#pragma unroll
            for (int bj = 0; bj < 2; ++bj)
#pragma unroll
                for (int m = 0; m < 4; ++m)
#pragma unroll
                    for (int n = 0; n < 2; ++n) asm volatile("" :: "v"(acc[ai][bj][m][n]));
    }
};
template <class Epi, class Sched, bool ALIGN_EPI = false, bool SP2 = false>
__device__ __forceinline__ void gemm_phase(PG8_LAS unsigned char* lds, const Gemm g, const Sched& S, const Epi& E) {
    const int tid = opaque_tid(), wid = __builtin_amdgcn_readfirstlane(tid >> 6), lane = tid & 63, wr = wid >> 2, wc = wid & 3, fr = lane & 15, fq = lane >> 4;
    const int K = g.K, nt = K / BK;
    unsigned voffA[2], voffB[2];
#pragma unroll
    for (int i = 0; i < 2; ++i) { int R, C; stage_rc(tid * 16 + i * 8192, R, C); const int Rb = Epi::PERM ? ((R & ~31) + perm32(R & 31)) : R;
        voffA[i] = (unsigned)(R * K + C) * 2u; voffB[i] = (unsigned)(Rb * K + C) * 2u; }
    const size_t kstep = (size_t)(BK * 2);
    const size_t hstep = (size_t)HALF * K * 2;
    const size_t tstep = 2 * hstep;
    const unsigned ldsw = (unsigned)wid * 1024u;
    const int aoff = lds_byte(wr * 64 + fr, fq * 8), boff = lds_byte(wc * 32 + fr, fq * 8);
#define PG8_SA(b, h) (((b) * 2 + (h)) * HTB)
#define PG8_SB(b, h) ((4 + (b) * 2 + (h)) * HTB)
#define PG8_STAGE(bufoff, gbase, voff) do { _Pragma("unroll") for (int _i = 0; _i < 2; ++_i) \
        __builtin_amdgcn_global_load_lds((const unsigned*)((const char*)(gbase) + (voff)[_i]), (PG8_LAS unsigned*)(lds + (bufoff) + ldsw + _i * 8192), 16, 0, 0); } while (0)
#define PG8_LDA(dst, b, h) do { _Pragma("unroll") for (int m = 0; m < 4; ++m) _Pragma("unroll") for (int k = 0; k < 2; ++k) dst[m][k] = *(const PG8_LAS bf16x8*)(lds + PG8_SA(b, h) + aoff + m * 2048 + k * 1024); } while (0)
#define PG8_LDB(dst, b, h) do { _Pragma("unroll") for (int n = 0; n < 2; ++n) _Pragma("unroll") for (int k = 0; k < 2; ++k) dst[n][k] = *(const PG8_LAS bf16x8*)(lds + PG8_SB(b, h) + boff + n * 2048 + k * 1024); } while (0)
#define PG8_MMA(ai, bj, At, Bt) do { __builtin_amdgcn_s_setprio(1); _Pragma("unroll") for (int m = 0; m < 4; ++m) _Pragma("unroll") for (int n = 0; n < 2; ++n) _Pragma("unroll") for (int k = 0; k < 2; ++k) \
        acc[ai][bj][m][n] = mma16<Epi::F16>(Bt[n][k], At[m][k], acc[ai][bj][m][n]); __builtin_amdgcn_s_setprio(0); } while (0)
#define PG8_WAIT_V(n) asm volatile("s_waitcnt vmcnt(" #n ")" ::: "memory")
#define PG8_WAIT_L(n) asm volatile("s_waitcnt lgkmcnt(" #n ")" ::: "memory")
#define PG8_BAR __builtin_amdgcn_s_barrier()
#define PG8_SCHED __builtin_amdgcn_sched_barrier(0)
    Unit cur, nxt; int ui = 0;
    if (!S.next(0, cur)) return;
    f32x4 acc[2][2][4][2];
#pragma unroll
    for (int a = 0; a < 2; ++a)
#pragma unroll
        for (int b = 0; b < 2; ++b)
#pragma unroll
            for (int m = 0; m < 4; ++m)
#pragma unroll
                for (int n = 0; n < 2; ++n) acc[a][b][m][n] = (f32x4){0.f, 0.f, 0.f, 0.f};
    bf16x8 At[4][2], B0[2][2], B1[2][2];
    const char* cA = (const char*)g.A + (size_t)cur.pm * tstep; const char* cB = (const char*)g.Bt + (size_t)cur.pn * tstep;
    S.a_ready(cur);
    if constexpr (SP2) {
        PG8_STAGE(PG8_SB(0, 0), cB, voffB); PG8_STAGE(PG8_SB(0, 1), cB + hstep, voffB); PG8_STAGE(PG8_SA(0, 0), cA, voffA); PG8_STAGE(PG8_SA(0, 1), cA + hstep, voffA);
        if (wr == 1) PG8_BAR;
        PG8_WAIT_V(2); PG8_BAR;
        PG8_STAGE(PG8_SB(1, 0), cB + kstep, voffB); PG8_STAGE(PG8_SA(1, 0), cA + kstep, voffA); PG8_STAGE(PG8_SB(1, 1), cB + hstep + kstep, voffB);
        PG8_WAIT_V(6); PG8_BAR;
    } else {
        PG8_STAGE(PG8_SB(0, 0), cB, voffB); PG8_STAGE(PG8_SA(0, 0), cA, voffA); PG8_STAGE(PG8_SB(0, 1), cB + hstep, voffB); PG8_STAGE(PG8_SA(0, 1), cA + hstep, voffA);
        if (wr == 1) PG8_BAR;
        PG8_WAIT_V(4); PG8_BAR;
        PG8_STAGE(PG8_SB(1, 0), cB + kstep, voffB); PG8_STAGE(PG8_SA(1, 0), cA + kstep, voffA); PG8_STAGE(PG8_SB(1, 1), cB + hstep + kstep, voffB);
        PG8_WAIT_V(6); PG8_BAR;
    }
    for (;;) {
        const bool has_next = S.next(ui + 1, nxt);
        const char* nA = has_next ? (const char*)g.A + (size_t)nxt.pm * tstep : cA; const char* nB = has_next ? (const char*)g.Bt + (size_t)nxt.pn * tstep : cB;
        for (int t = 0; t < nt; t += 2) {
            const bool last = (t == nt - 2);
            const char* a1 = cA + (size_t)(t + 1) * kstep;
            const char* a2 = last ? nA : cA + (size_t)(t + 2) * kstep; const char* b2 = last ? nB : cB + (size_t)(t + 2) * kstep;
            const char* a3 = a2 + kstep; const char* b3 = b2 + kstep;
            if (last && has_next) S.a_ready(nxt);
            if constexpr (SP2) {
            PG8_LDB(B0, 0, 0); PG8_LDB(B1, 0, 1); PG8_SCHED; PG8_LDA(At, 0, 0); PG8_STAGE(PG8_SA(1, 1), a1 + hstep, voffA);
            PG8_WAIT_V(8); PG8_WAIT_L(0); PG8_BAR; PG8_MMA(0, 0, At, B0); PG8_MMA(0, 1, At, B1); PG8_BAR; PG8_SCHED;
            PG8_LDA(At, 0, 1); PG8_STAGE(PG8_SB(0, 0), b2, voffB); PG8_STAGE(PG8_SB(0, 1), b2 + hstep, voffB); PG8_STAGE(PG8_SA(0, 0), a2, voffA);
            PG8_WAIT_V(8); PG8_WAIT_L(0); PG8_BAR; PG8_MMA(1, 0, At, B0); PG8_MMA(1, 1, At, B1); PG8_BAR; PG8_SCHED;
            PG8_LDB(B0, 1, 0); PG8_LDB(B1, 1, 1); PG8_SCHED; PG8_LDA(At, 1, 0); PG8_STAGE(PG8_SA(0, 1), a2 + hstep, voffA);
            PG8_WAIT_V(8); PG8_WAIT_L(0); PG8_BAR; PG8_MMA(0, 0, At, B0); PG8_MMA(0, 1, At, B1); PG8_BAR; PG8_SCHED;
            PG8_LDA(At, 1, 1); PG8_STAGE(PG8_SB(1, 0), b3, voffB); PG8_STAGE(PG8_SB(1, 1), b3 + hstep, voffB); PG8_STAGE(PG8_SA(1, 0), a3, voffA);
            PG8_WAIT_V(8); PG8_WAIT_L(0); PG8_BAR; PG8_MMA(1, 0, At, B0); PG8_MMA(1, 1, At, B1); PG8_BAR; PG8_SCHED;
            } else {
            PG8_LDB(B0, 0, 0); PG8_SCHED; PG8_LDA(At, 0, 0); PG8_STAGE(PG8_SA(1, 1), a1 + hstep, voffA);
            PG8_WAIT_L(8); PG8_BAR; PG8_WAIT_L(0); PG8_MMA(0, 0, At, B0); PG8_BAR; PG8_SCHED;
            PG8_LDB(B1, 0, 1); PG8_STAGE(PG8_SB(0, 0), b2, voffB);
            PG8_BAR; PG8_WAIT_L(0); PG8_MMA(0, 1, At, B1); PG8_BAR;
            PG8_LDA(At, 0, 1); PG8_STAGE(PG8_SA(0, 0), a2, voffA);
            PG8_BAR; PG8_WAIT_L(0); PG8_MMA(1, 0, At, B0); PG8_BAR; PG8_SCHED;
            PG8_STAGE(PG8_SB(0, 1), b2 + hstep, voffB);
            PG8_WAIT_V(6); PG8_BAR; PG8_MMA(1, 1, At, B1); PG8_BAR;
            PG8_LDB(B0, 1, 0); PG8_SCHED; PG8_LDA(At, 1, 0); PG8_STAGE(PG8_SA(0, 1), a2 + hstep, voffA);
            PG8_WAIT_L(8); PG8_BAR; PG8_WAIT_L(0); PG8_MMA(0, 0, At, B0); PG8_BAR; PG8_SCHED;
            PG8_LDB(B1, 1, 1); PG8_STAGE(PG8_SB(1, 0), b3, voffB);
            PG8_BAR; PG8_WAIT_L(0); PG8_MMA(0, 1, At, B1); PG8_BAR;
            PG8_LDA(At, 1, 1); PG8_STAGE(PG8_SA(1, 0), a3, voffA);
            PG8_BAR; PG8_WAIT_L(0); PG8_MMA(1, 0, At, B0); PG8_BAR; PG8_SCHED;
            PG8_STAGE(PG8_SB(1, 1), b3 + hstep, voffB);
            PG8_WAIT_V(6); PG8_BAR; PG8_MMA(1, 1, At, B1); PG8_BAR;
            }
        }
        if constexpr (ALIGN_EPI) { if (wr == 0) PG8_BAR; }
        if constexpr (!Epi::AFTER_DRAIN) { E(acc, cur, wr, wc, fr, fq); S.done(cur); }
        if (!has_next) break;
#pragma unroll
        for (int a = 0; a < 2; ++a)
#pragma unroll
            for (int b = 0; b < 2; ++b)
#pragma unroll
                for (int m = 0; m < 4; ++m)
#pragma unroll
                    for (int n = 0; n < 2; ++n) acc[a][b][m][n] = (f32x4){0.f, 0.f, 0.f, 0.f};
        cur = nxt; cA = nA; cB = nB; ++ui;
        if constexpr (ALIGN_EPI) { if (wr == 1) PG8_BAR; }
    }
    PG8_WAIT_V(0);
    if constexpr (!ALIGN_EPI) { if (wr == 0) PG8_BAR; }
    PG8_BAR;
    if constexpr (Epi::AFTER_DRAIN) { E.fused(acc, cur, wr, wc, fr, fq, lds, wid, lane); S.done(cur); }
#undef PG8_SA
#undef PG8_SB
#undef PG8_STAGE
#undef PG8_LDA
#undef PG8_LDB
#undef PG8_MMA
#undef PG8_WAIT_V
#undef PG8_WAIT_L
#undef PG8_BAR
#undef PG8_SCHED
}
}
namespace att {
typedef unsigned short bf16_t;
typedef short bf16x8 __attribute__((ext_vector_type(8)));
typedef short s16x4 __attribute__((ext_vector_type(4)));
typedef float f32x16 __attribute__((ext_vector_type(16)));
typedef float f32x4 __attribute__((ext_vector_type(4)));
typedef unsigned u32x4 __attribute__((ext_vector_type(4)));
typedef unsigned u32x2 __attribute__((ext_vector_type(2)));
#define ATT_LAS __attribute__((address_space(3)))
typedef ATT_LAS const char* lds_cptr;
typedef ATT_LAS char* lds_ptr;
constexpr float kLog2e = 1.4426950408889634f;
__device__ __forceinline__ int crow(int r, int hi) { return (r & 3) + 8 * (r >> 2) + 4 * hi; }
__device__ __forceinline__ unsigned cvtpk(float lo, float hi) { unsigned r; asm volatile("v_cvt_pk_bf16_f32 %0, %1, %2" : "=v"(r) : "v"(lo), "v"(hi)); return r; }
__device__ __forceinline__ s16x4 vtr(lds_cptr p) { return __builtin_bit_cast(s16x4, __builtin_amdgcn_ds_read_tr16_b64_v4i16((ATT_LAS s16x4*)p)); }
__device__ __forceinline__ bf16x8 cat8(s16x4 lo, s16x4 hi) { return (bf16x8){lo[0], lo[1], lo[2], lo[3], hi[0], hi[1], hi[2], hi[3]}; }
__device__ __forceinline__ bf16x8 packp(const f32x16& p, int b) {
    u32x4 w; w.x = cvtpk(p[b], p[b + 1]); w.y = cvtpk(p[b + 2], p[b + 3]); w.z = cvtpk(p[b + 4], p[b + 5]); w.w = cvtpk(p[b + 6], p[b + 7]);
    return __builtin_bit_cast(bf16x8, w);
}
__device__ __forceinline__ float max16(const f32x16& p) {
    float a = fmaxf(fmaxf(p[0], p[1]), fmaxf(p[2], p[3])), b = fmaxf(fmaxf(p[4], p[5]), fmaxf(p[6], p[7]));
    float c = fmaxf(fmaxf(p[8], p[9]), fmaxf(p[10], p[11])), d = fmaxf(fmaxf(p[12], p[13]), fmaxf(p[14], p[15]));
    return fmaxf(fmaxf(a, b), fmaxf(c, d));
}
__device__ __forceinline__ float sum16(const f32x16& p) {
    return ((p[0] + p[1]) + (p[2] + p[3])) + ((p[4] + p[5]) + (p[6] + p[7])) + (((p[8] + p[9]) + (p[10] + p[11])) + ((p[12] + p[13]) + (p[14] + p[15])));
}
__device__ __forceinline__ float xmax32(float x) { const auto rr = __builtin_amdgcn_permlane32_swap(__float_as_uint(x), __float_as_uint(x), false, false); return fmaxf(__uint_as_float(rr[0]), __uint_as_float(rr[1])); }
__device__ __forceinline__ float xsum32(float x) { const auto rr = __builtin_amdgcn_permlane32_swap(__float_as_uint(x), __float_as_uint(x), false, false); return __uint_as_float(rr[0]) + __uint_as_float(rr[1]); }
__device__ __forceinline__ float xother32(float x, int hi) { const auto rr = __builtin_amdgcn_permlane32_swap(__float_as_uint(x), __float_as_uint(x), false, false); return hi ? __uint_as_float(rr[0]) : __uint_as_float(rr[1]); }
template <int KEYS> __device__ __forceinline__ void pv_tile(f32x16 (&o)[2], lds_cptr vbase, const bf16x8 (&pf)[KEYS / 16], int lane) {
    const int hi = lane >> 5, li = lane & 15;
    lds_cptr vp = vbase + (4 * hi + (li >> 2)) * 64 + ((lane >> 4) & 1) * 32 + (lane & 3) * 8;
#pragma unroll
    for (int d0 = 0; d0 < 2; ++d0)
#pragma unroll
        for (int ks = 0; ks < KEYS / 16; ++ks) {
            const s16x4 lo = vtr(vp + d0 * (KEYS * 64) + ks * 1024), hh = vtr(vp + d0 * (KEYS * 64) + ks * 1024 + 512);
            o[d0] = __builtin_amdgcn_mfma_f32_32x32x16_bf16(cat8(lo, hh), pf[ks], o[d0], 0, 0, 0);
        }
}
__device__ __forceinline__ void store_o(const f32x16 (&o)[2], float sc, bf16_t* orow, int hi) {
#pragma unroll
    for (int d0 = 0; d0 < 2; ++d0)
#pragma unroll
        for (int g = 0; g < 4; ++g) {
            u32x2 w; w.x = cvtpk(o[d0][4 * g] * sc, o[d0][4 * g + 1] * sc); w.y = cvtpk(o[d0][4 * g + 2] * sc, o[d0][4 * g + 3] * sc);
            *(u32x2*)(orow + d0 * 32 + g * 8 + hi * 4) = w;
        }
}

template <int DK> struct AttL { static constexpr int KS = DK * 2 + 16, KB = 64 * KS, VB = 8192, BUF = KB + VB, TOTAL = 2 * BUF; };
template <int DK, int MODE>
__device__ __forceinline__ void attn_unit(const bf16_t* Q, int ldq, const bf16_t* K, int ldk, const bf16_t* V, int ldv, bf16_t* O, int ldo, int qb, char* shm, float sc) {
    typedef AttL<DK> L;
    constexpr int NS = DK / 16, CPR = DK / 8;
    const int tid = opaque_tid(), lane = tid & 63, r32 = lane & 31, hi = lane >> 5; const int wid = __builtin_amdgcn_readfirstlane(tid >> 6);
    const int qpos = qb * 256 + wid * 32 + r32;
    bf16x8 qf[NS];
#pragma unroll
    for (int s = 0; s < NS; ++s) qf[s] = *(const bf16x8*)(Q + (size_t)qpos * ldq + s * 16 + hi * 8);
    const int kc0 = tid, kkey0 = kc0 / CPR, kch0 = kc0 % CPR;
    const int kc1 = 512 + tid, kkey1 = kc1 / CPR, kch1 = kc1 % CPR; const bool k2 = (DK == 96) && (tid < 256);
    const int vkey = tid >> 3, vch = tid & 7;
    const int voff = (vch >> 2) * 4096 + vkey * 64 + (vch & 3) * 16;
    const int nt = 4 * (qb + 1);
    f32x16 o[2]; o[0] = f32x16{}; o[1] = f32x16{};
    constexpr float SB_SAT = 160.0f; float wminR = 0.f;
    float mrun = -1e30f, lrun = (MODE == 1) ? 1.f : 0.f;
    u32x4 kr0A, kr1A = u32x4{}, vrA, kr0B, kr1B = u32x4{}, vrB;
#define ATT_FETCH(KR0, KR1, VR, tt) do { const size_t kb_ = (size_t)(tt) * 64; \
        KR0 = *(const u32x4*)(K + (kb_ + kkey0) * ldk + kch0 * 8); \
        if (k2) KR1 = *(const u32x4*)(K + (kb_ + kkey1) * ldk + kch1 * 8); \
        VR = *(const u32x4*)(V + (kb_ + vkey) * ldv + vch * 8); } while (0)
#define ATT_TILE(i_) ((MODE == 0) ? (i_) : nt - 1 - (i_))
    ATT_FETCH(kr0A, kr1A, vrA, ATT_TILE(0)); ATT_FETCH(kr0B, kr1B, vrB, ATT_TILE(1));
    bool done = false;
#define ATT_STEP(it, KR0, KR1, VR) { \
        const int tt = ATT_TILE(it); \
        char* buf = shm + ((it) & 1) * L::BUF; \
        *(u32x4*)(buf + kkey0 * L::KS + kch0 * 16) = KR0; \
        if (k2) *(u32x4*)(buf + kkey1 * L::KS + kch1 * 16) = KR1; \
        *(u32x4*)(buf + L::KB + voff) = VR; \
        __syncthreads(); \
        if (MODE == 1 && (it) > 0) { \
            const float* fl = (const float*)(shm + L::TOTAL) + (((it) - 1) & 1) * 8; \
            const float mnr = fminf(fminf(fminf(fl[0], fl[1]), fminf(fl[2], fl[3])), fminf(fminf(fl[4], fl[5]), fminf(fl[6], fl[7]))); \
            if (mnr >= SB_SAT) done = true; \
        } \
        if (!done) { \
        ATT_FETCH(KR0, KR1, VR, ATT_TILE(((it) + 2 < nt) ? (it) + 2 : nt - 1)); \
        att_compute(it, tt, buf); } }
    auto att_compute = [&](int it, int tt, char* buf) __attribute__((always_inline)) {
        const int kbase = tt * 64;
        bool active = !(kbase > qb * 256 + wid * 32 + 31);
        if (MODE == 1) active = active && (wminR < SB_SAT);
        if (active) {
        f32x16 p0 = f32x16{}, p1 = f32x16{};
        const char* kp = buf + r32 * L::KS + hi * 16;
#pragma unroll
        for (int s = 0; s < NS; ++s) {
            const bf16x8 a0 = *(const bf16x8*)(kp + s * 32), a1 = *(const bf16x8*)(kp + 32 * L::KS + s * 32);
            p0 = __builtin_amdgcn_mfma_f32_32x32x16_bf16(a0, qf[s], p0, 0, 0, 0);
            p1 = __builtin_amdgcn_mfma_f32_32x32x16_bf16(a1, qf[s], p1, 0, 0, 0);
        }
        const bool diag = (kbase + 63 >= qb * 256 + wid * 32);
        bf16x8 pf[4];
        if (MODE == 0) {
#pragma unroll
            for (int r = 0; r < 16; ++r) { p0[r] *= sc; p1[r] *= sc; }
            if (diag) {
#pragma unroll
                for (int r = 0; r < 16; ++r) { const int key = kbase + crow(r, hi); if (key > qpos) p0[r] = -INFINITY; if (key + 32 > qpos) p1[r] = -INFINITY; }
            }
            float rm = fmaxf(max16(p0), max16(p1)); rm = xmax32(rm);
            const float mn = fmaxf(mrun, rm), f = __builtin_amdgcn_exp2f(mrun - mn); mrun = mn;
#pragma unroll
            for (int r = 0; r < 16; ++r) { p0[r] = __builtin_amdgcn_exp2f(p0[r] - mn); p1[r] = __builtin_amdgcn_exp2f(p1[r] - mn); }
            lrun = lrun * f + (sum16(p0) + sum16(p1));
#pragma unroll
            for (int r = 0; r < 16; ++r) { o[0][r] *= f; o[1][r] *= f; }
        } else {
            f32x16 om0, om1;
#pragma unroll
            for (int r = 0; r < 16; ++r) {
                const float e0 = __builtin_amdgcn_exp2f(-fmaxf(p0[r] * sc, -100.f)), e1 = __builtin_amdgcn_exp2f(-fmaxf(p1[r] * sc, -100.f));
                const float s0 = __builtin_amdgcn_rcpf(1.0f + e0), s1 = __builtin_amdgcn_rcpf(1.0f + e1);
                om0[r] = e0 * s0; om1[r] = e1 * s1; p0[r] = s0; p1[r] = s1;
            }
            if (diag) {
#pragma unroll
                for (int r = 0; r < 16; ++r) { const int key = kbase + crow(r, hi);
                    if (key >= qpos) { om0[r] = 1.f; p0[r] = 0.f; } if (key + 32 >= qpos) { om1[r] = 1.f; p1[r] = 0.f; } }
            }
            float gs[8], og[8];
#pragma unroll
            for (int g = 0; g < 4; ++g) { gs[g] = (om0[4 * g] * om0[4 * g + 1]) * (om0[4 * g + 2] * om0[4 * g + 3]); gs[4 + g] = (om1[4 * g] * om1[4 * g + 1]) * (om1[4 * g + 2] * om1[4 * g + 3]); }
#pragma unroll
            for (int g = 0; g < 8; ++g) og[g] = xother32(gs[g], hi);
            float suf = lrun;
#pragma unroll
            for (int g = 7; g >= 0; --g) {
                const float T = suf * (hi == 0 ? og[g] : 1.f);
                f32x16& om = (g < 4) ? om0 : om1; f32x16& pp = (g < 4) ? p0 : p1; const int b = 4 * (g & 3);
                const float l3 = T, l2 = l3 * om[b + 3], l1 = l2 * om[b + 2], l0 = l1 * om[b + 1];
                pp[b + 3] *= l3; pp[b + 2] *= l2; pp[b + 1] *= l1; pp[b] *= l0;
                suf *= gs[g] * og[g];
            }
            lrun = suf;
        }
        pf[0] = packp(p0, 0); pf[1] = packp(p0, 8); pf[2] = packp(p1, 0); pf[3] = packp(p1, 8);
        pv_tile<64>(o, (lds_cptr)(buf + L::KB), pf, lane);
        }
        if (MODE == 1) {
            float w = lrun;
#pragma unroll
            for (int sh = 1; sh < 32; sh <<= 1) w = fmaxf(w, __shfl_xor(w, sh));
            w = (w > 0.f) ? 0.f : 1000.f;
            wminR = __builtin_bit_cast(float, __builtin_amdgcn_readfirstlane(__builtin_bit_cast(int, w)));
            if (lane == 0) ((float*)(shm + L::TOTAL))[(it & 1) * 8 + wid] = wminR;
        }
    };
    for (int it = 0; it < nt && !done; it += 2) {
        ATT_STEP(it, kr0A, kr1A, vrA)
        if (done) break;
        ATT_STEP(it + 1, kr0B, kr1B, vrB)
    }
#undef ATT_STEP
#undef ATT_TILE
#undef ATT_FETCH
    float scl = 1.0f;
    if (MODE == 0) { const float lt = xsum32(lrun); scl = 1.0f / lt; }
    store_o(o, scl, O + (size_t)qpos * ldo, hi);
}

__device__ __forceinline__ void sb_unit_big(const bf16_t* Q, const bf16_t* K, const bf16_t* V, int ld, bf16_t* O, int ldo, int qb, char* shm, int maxch) {
    constexpr int KS = 144, KSUB = 64 * KS, KB = 4 * KSUB, VSUB = 8192, BUF = KB + 4 * VSUB, TOTAL = 2 * BUF;
    const int tid = opaque_tid(), lane = tid & 63, r32 = lane & 31, hi = lane >> 5; const int wid = __builtin_amdgcn_readfirstlane(tid >> 6);
    const float sc = 0.125f * kLog2e;
    const int qpos = qb * 256 + wid * 32 + r32;
    bf16x8 qf[4];
#pragma unroll
    for (int s = 0; s < 4; ++s) qf[s] = *(const bf16x8*)(Q + (size_t)qpos * ld + s * 16 + hi * 8);
    const int lkey = tid >> 3, lch = tid & 7;
    const int koff = lkey * KS + lch * 16, voff = KB + (lch >> 2) * 4096 + lkey * 64 + (lch & 3) * 16;
    f32x16 o[2]; o[0] = f32x16{}; o[1] = f32x16{};
    float carry = 1.f; bool wsat = false;
    u32x4 kr[4], vr[4];
#define SBB_FETCH(c) do { const size_t cb_ = (size_t)(c) * 256 + lkey; \
        _Pragma("unroll") for (int i = 0; i < 4; ++i) { kr[i] = *(const u32x4*)(K + (cb_ + 64 * i) * ld + lch * 8); vr[i] = *(const u32x4*)(V + (cb_ + 64 * i) * ld + lch * 8); } } while (0)
    auto sub_compute = [&](int kbase, const char* kt, const char* vt) __attribute__((always_inline)) {
        f32x16 p0 = f32x16{}, p1 = f32x16{};
        const char* kp = kt + r32 * KS + hi * 16;
#pragma unroll
        for (int s = 0; s < 4; ++s) {
            const bf16x8 a0 = *(const bf16x8*)(kp + s * 32), a1 = *(const bf16x8*)(kp + 32 * KS + s * 32);
            p0 = __builtin_amdgcn_mfma_f32_32x32x16_bf16(a0, qf[s], p0, 0, 0, 0);
            p1 = __builtin_amdgcn_mfma_f32_32x32x16_bf16(a1, qf[s], p1, 0, 0, 0);
        }
        f32x16 om0, om1;
#pragma unroll
        for (int r = 0; r < 16; ++r) {
            const float e0 = __builtin_amdgcn_exp2f(-fmaxf(p0[r] * sc, -100.f)), e1 = __builtin_amdgcn_exp2f(-fmaxf(p1[r] * sc, -100.f));
            const float s0 = __builtin_amdgcn_rcpf(1.0f + e0), s1 = __builtin_amdgcn_rcpf(1.0f + e1);
            om0[r] = e0 * s0; om1[r] = e1 * s1; p0[r] = s0; p1[r] = s1;
        }
        if (kbase + 63 >= qb * 256 + wid * 32) {
#pragma unroll
            for (int r = 0; r < 16; ++r) { const int key = kbase + crow(r, hi);
                if (key >= qpos) { om0[r] = 1.f; p0[r] = 0.f; } if (key + 32 >= qpos) { om1[r] = 1.f; p1[r] = 0.f; } }
        }
        float gs[8], og[8];
#pragma unroll
        for (int g = 0; g < 4; ++g) { gs[g] = (om0[4 * g] * om0[4 * g + 1]) * (om0[4 * g + 2] * om0[4 * g + 3]); gs[4 + g] = (om1[4 * g] * om1[4 * g + 1]) * (om1[4 * g + 2] * om1[4 * g + 3]); }
#pragma unroll
        for (int g = 0; g < 8; ++g) og[g] = xother32(gs[g], hi);
        float suf = carry;
#pragma unroll
        for (int g = 7; g >= 0; --g) {
            const float T = suf * (hi == 0 ? og[g] : 1.f);
            f32x16& om = (g < 4) ? om0 : om1; f32x16& pp = (g < 4) ? p0 : p1; const int b = 4 * (g & 3);
            const float l3 = T, l2 = l3 * om[b + 3], l1 = l2 * om[b + 2], l0 = l1 * om[b + 1];
            pp[b + 3] *= l3; pp[b + 2] *= l2; pp[b + 1] *= l1; pp[b] *= l0;
            suf *= gs[g] * og[g];
        }
        carry = suf;
        bf16x8 pf[4]; pf[0] = packp(p0, 0); pf[1] = packp(p0, 8); pf[2] = packp(p1, 0); pf[3] = packp(p1, 8);
        pv_tile<64>(o, (lds_cptr)vt, pf, lane);
        wsat = !__any(carry > 0.f);
    };
    const int nch = (qb + 1 < maxch) ? qb + 1 : maxch;
    SBB_FETCH(qb);
    for (int it = 0; it < nch; ++it) {
        char* buf = shm + (it & 1) * BUF;
#pragma unroll
        for (int i = 0; i < 4; ++i) { *(u32x4*)(buf + i * KSUB + koff) = kr[i]; *(u32x4*)(buf + i * VSUB + voff) = vr[i]; }
        __syncthreads();
        if (it > 0) {
            const float* fl = (const float*)(shm + TOTAL) + ((it - 1) & 1) * 8;
            const float mnr = fminf(fminf(fminf(fl[0], fl[1]), fminf(fl[2], fl[3])), fminf(fminf(fl[4], fl[5]), fminf(fl[6], fl[7])));
            if (mnr > 0.5f) break;
        }
        if (it + 1 < nch) SBB_FETCH(qb - it - 1);
        const int cbase = (qb - it) * 256;
#pragma unroll 1
        for (int sub = 3; sub >= 0; --sub) {
            const int kbase = cbase + 64 * sub;
            if (!(kbase > qb * 256 + wid * 32 + 31) && !wsat) sub_compute(kbase, buf + sub * KSUB, buf + KB + sub * VSUB);
        }
        if (lane == 0) ((float*)(shm + TOTAL))[(it & 1) * 8 + wid] = wsat ? 1.f : 0.f;
    }
#undef SBB_FETCH
    store_o(o, 1.0f, O + (size_t)qpos * ldo, hi);
    __syncthreads();
}

__device__ __forceinline__ void sb_wave_unit(const bf16_t* Q, const bf16_t* K, const bf16_t* V, int ld, bf16_t* O, int ldo, int q0, char* wl, int lane) {
    const int r32 = lane & 31, hi = lane >> 5;
    const float sc = 0.125f * kLog2e;
    const int qpos = q0 + r32;
    bf16x8 qf[4];
#pragma unroll
    for (int s = 0; s < 4; ++s) qf[s] = *(const bf16x8*)(Q + (size_t)qpos * ld + s * 16 + hi * 8);
    f32x16 o[2]; o[0] = f32x16{}; o[1] = f32x16{};
    float carry = 1.f;
#define SBW_LOAD(j, KF, VR) do { const size_t kb_ = (size_t)(j) * 32; \
        _Pragma("unroll") for (int s = 0; s < 4; ++s) KF[s] = *(const bf16x8*)(K + (kb_ + r32) * ld + s * 16 + hi * 8); \
        _Pragma("unroll") for (int c4 = 0; c4 < 4; ++c4) VR[c4] = *(const u32x4*)(V + (kb_ + (lane >> 3) + 8 * c4) * ld + (lane & 7) * 8); } while (0)
#define SBW_TILE(j, KF, VR) do { const int kbase = (j) * 32; \
        asm volatile("s_waitcnt lgkmcnt(0)" ::: "memory"); \
        _Pragma("unroll") for (int c4 = 0; c4 < 4; ++c4) { const int key = (lane >> 3) + 8 * c4, ch = lane & 7; \
            *(u32x4*)(wl + (ch >> 2) * 2048 + key * 64 + (ch & 3) * 16) = VR[c4]; } \
        f32x16 p = f32x16{}; \
        _Pragma("unroll") for (int s = 0; s < 4; ++s) p = __builtin_amdgcn_mfma_f32_32x32x16_bf16(KF[s], qf[s], p, 0, 0, 0); \
        f32x16 om; \
        _Pragma("unroll") for (int r = 0; r < 16; ++r) { \
            const float e = __builtin_amdgcn_exp2f(-fmaxf(p[r] * sc, -100.f)); const float sg = __builtin_amdgcn_rcpf(1.0f + e); \
            om[r] = e * sg; p[r] = sg; } \
        if (kbase + 31 >= q0) { \
            _Pragma("unroll") for (int r = 0; r < 16; ++r) { if (kbase + crow(r, hi) >= qpos) { om[r] = 1.f; p[r] = 0.f; } } } \
        float gs[4], og[4]; \
        _Pragma("unroll") for (int g = 0; g < 4; ++g) gs[g] = (om[4 * g] * om[4 * g + 1]) * (om[4 * g + 2] * om[4 * g + 3]); \
        _Pragma("unroll") for (int g = 0; g < 4; ++g) og[g] = xother32(gs[g], hi); \
        float suf = carry; \
        _Pragma("unroll") for (int g = 3; g >= 0; --g) { \
            const float T = suf * (hi == 0 ? og[g] : 1.f); const int b = 4 * g; \
            const float l3 = T, l2 = l3 * om[b + 3], l1 = l2 * om[b + 2], l0 = l1 * om[b + 1]; \
            p[b + 3] *= l3; p[b + 2] *= l2; p[b + 1] *= l1; p[b] *= l0; \
            suf *= gs[g] * og[g]; } \
        carry = suf; \
        bf16x8 pf[2]; pf[0] = packp(p, 0); pf[1] = packp(p, 8); \
        asm volatile("s_waitcnt lgkmcnt(0)" ::: "memory"); \
        pv_tile<32>(o, (lds_cptr)wl, pf, lane); } while (0)
    bf16x8 kfA[4], kfB[4], kfC[4]; u32x4 vrA[4], vrB[4], vrC[4];
    int j = (q0 + 30) >> 5;
#define SBW_CL(x) ((x) < 0 ? 0 : (x))
    SBW_LOAD(j, kfA, vrA);
    SBW_LOAD(SBW_CL(j - 1), kfB, vrB);
    for (;;) {
        SBW_LOAD(SBW_CL(j - 2), kfC, vrC);
        SBW_TILE(j, kfA, vrA);
        if (j < 1 || !__any(carry > 0.f)) break;
        SBW_LOAD(SBW_CL(j - 3), kfA, vrA);
        SBW_TILE(j - 1, kfB, vrB);
        if (j < 2 || !__any(carry > 0.f)) break;
        SBW_LOAD(SBW_CL(j - 4), kfB, vrB);
        SBW_TILE(j - 2, kfC, vrC);
        if (j < 3 || !__any(carry > 0.f)) break;
        j -= 3;
    }
#undef SBW_CL
#undef SBW_LOAD
#undef SBW_TILE
    asm volatile("s_waitcnt lgkmcnt(0)" ::: "memory");
    store_o(o, 1.0f, O + (size_t)qpos * ldo, hi);
}

__device__ __forceinline__ void dil_unit(const bf16_t* QKV, float* scr, bf16_t* O, int b, int h, int blk, char* shm) {
    const int tid = opaque_tid(), lane = tid & 63, r32 = lane & 31, hi = lane >> 5; const int wid = __builtin_amdgcn_readfirstlane(tid >> 6);
    const int T0 = blk * 512; const size_t rb = (size_t)b * 2048;
    const bf16_t* Qh = QKV + h * 64; const bf16_t* Kh = QKV + 512 + h * 64; const bf16_t* Vh = QKV + 1024 + h * 64;
    const float sc = 0.125f * kLog2e, slope2 = __builtin_amdgcn_exp2f(-(float)(h + 1)) * kLog2e;
    char* wl = shm + wid * 4096;
    float* sO = scr; float* sM = scr + 512 * 64; float* sL = sM + 512;
#pragma unroll 1
    for (int br = 0; br < 3; ++br) {
        const int lg = 2 * br, d = 1 << lg;
        const float sl = slope2 * (float)d;
#pragma unroll 1
        for (int rep = 0; rep < 2; ++rep) {
            const int k = wid + 8 * rep, res = k & (d - 1), c = k >> lg, tq0 = T0 + res + d * 32 * c;
            const int tq = tq0 + d * r32;
            bf16x8 qf[4];
#pragma unroll
            for (int s = 0; s < 4; ++s) qf[s] = *(const bf16x8*)(Qh + (rb + tq) * 1536 + s * 16 + hi * 8);
            f32x16 o[2]; o[0] = f32x16{}; o[1] = f32x16{};
            float mrun = -1e30f, lrun = 0.f;
#define DIL_LOAD(kt, KF, VR) do { int ktv_ = (kt); asm volatile("" : "+s"(ktv_)); const int ik0_ = -128 + 32 * ktv_; \
                int tk_ = tq0 + d * (ik0_ + r32); tk_ = tk_ < 0 ? 0 : tk_; \
                _Pragma("unroll") for (int s = 0; s < 4; ++s) KF[s] = *(const bf16x8*)(Kh + (rb + tk_) * 1536 + s * 16 + hi * 8); \
                _Pragma("unroll") for (int c4 = 0; c4 < 4; ++c4) { const int key_ = (lane >> 3) + 8 * c4; int tv_ = tq0 + d * (ik0_ + key_); tv_ = tv_ < 0 ? 0 : tv_; \
                    VR[c4] = *(const u32x4*)(Vh + (rb + tv_) * 1536 + (lane & 7) * 8); } } while (0)
#define DIL_TILE(kt, KF, VR) do { int ktw_ = (kt); asm volatile("" : "+s"(ktw_)); const int ik0 = -128 + 32 * ktw_; \
                asm volatile("s_waitcnt lgkmcnt(0)" ::: "memory"); \
                _Pragma("unroll") for (int c4 = 0; c4 < 4; ++c4) { const int key = (lane >> 3) + 8 * c4, ch = lane & 7; \
                    *(u32x4*)(wl + (ch >> 2) * 2048 + key * 64 + (ch & 3) * 16) = VR[c4]; } \
                f32x16 p = f32x16{}; \
                _Pragma("unroll") for (int s = 0; s < 4; ++s) p = __builtin_amdgcn_mfma_f32_32x32x16_bf16(KF[s], qf[s], p, 0, 0, 0); \
                _Pragma("unroll") for (int r = 0; r < 16; ++r) { \
                    const int key = crow(r, hi), rel = r32 - (ik0 + key); \
                    const bool valid = (rel >= 0) && (rel <= 128) && (tq0 + d * (ik0 + key) >= 0); \
                    const float s2 = p[r] * sc - sl * (float)rel; \
                    p[r] = valid ? s2 : -INFINITY; } \
                float rm = max16(p); rm = xmax32(rm); \
                const float mn = fmaxf(mrun, rm), f = __builtin_amdgcn_exp2f(mrun - mn); mrun = mn; \
                _Pragma("unroll") for (int r = 0; r < 16; ++r) p[r] = __builtin_amdgcn_exp2f(p[r] - mn); \
                lrun = lrun * f + sum16(p); \
                _Pragma("unroll") for (int r = 0; r < 16; ++r) { o[0][r] *= f; o[1][r] *= f; } \
                bf16x8 pf[2]; pf[0] = packp(p, 0); pf[1] = packp(p, 8); \
                asm volatile("s_waitcnt lgkmcnt(0)" ::: "memory"); \
                pv_tile<32>(o, (lds_cptr)wl, pf, lane); } while (0)
#define DIL_LIVE(kt) (tq0 + d * (-128 + 32 * (kt) + 31) >= 0)
            bf16x8 kfA[4], kfB[4], kfC[4]; u32x4 vrA[4], vrB[4], vrC[4];
            DIL_LOAD(4, kfA, vrA);
            DIL_LOAD(3, kfB, vrB);
            DIL_LOAD(2, kfC, vrC);
            DIL_TILE(4, kfA, vrA);
            if (DIL_LIVE(3)) {
                DIL_LOAD(1, kfA, vrA);
                DIL_TILE(3, kfB, vrB);
                if (DIL_LIVE(2)) {
                    DIL_LOAD(0, kfB, vrB);
                    DIL_TILE(2, kfC, vrC);
                    if (DIL_LIVE(1)) {
                        DIL_TILE(1, kfA, vrA);
                        if (DIL_LIVE(0)) DIL_TILE(0, kfB, vrB);
                    }
                }
            }
#undef DIL_LIVE
#undef DIL_LOAD
#undef DIL_TILE
            float lt = xsum32(lrun);
            const int ti = tq - T0;
            float* so = sO + (size_t)ti * 64;
            if (br > 0) {
                const float ms = sM[ti], ls = sL[ti];
                const float mn = fmaxf(ms, mrun), fs = __builtin_amdgcn_exp2f(ms - mn), fb = __builtin_amdgcn_exp2f(mrun - mn);
                lt = lt * fb + ls * fs; mrun = mn;
#pragma unroll
                for (int d0 = 0; d0 < 2; ++d0)
#pragma unroll
                    for (int g = 0; g < 4; ++g) { const f32x4 st = *(const f32x4*)(so + d0 * 32 + g * 8 + hi * 4);
#pragma unroll
                        for (int j = 0; j < 4; ++j) o[d0][4 * g + j] = o[d0][4 * g + j] * fb + st[j] * fs; }
            }
            if (br < 2) {
#pragma unroll
                for (int d0 = 0; d0 < 2; ++d0)
#pragma unroll
                    for (int g = 0; g < 4; ++g) *(f32x4*)(so + d0 * 32 + g * 8 + hi * 4) = (f32x4){o[d0][4 * g], o[d0][4 * g + 1], o[d0][4 * g + 2], o[d0][4 * g + 3]};
                if (hi == 0) { sM[ti] = mrun; sL[ti] = lt; }
            } else {
                store_o(o, 1.0f / lt, O + (rb + tq) * 1024 + h * 64, hi);
            }
        }
        __threadfence_block();
        __syncthreads();
    }
}
#undef ATT_LAS
}

typedef unsigned short bf16_t;
typedef float f32x4 __attribute__((ext_vector_type(4)));
typedef unsigned u32x4 __attribute__((ext_vector_type(4)));
typedef unsigned u32x2 __attribute__((ext_vector_type(2)));
constexpr int M_TOK = 32768, DM = 1024, DFF = 2816, SEQ = 2048;
constexpr int NTHR = 512;
constexpr size_t MiB = 1u << 20;
constexpr size_t WS_ROPE = 0;
constexpr size_t WS_SS   = 1 * MiB;
constexpr size_t WS_SSQ  = 3 * MiB;
constexpr size_t WS_SSKV = 4 * MiB;
constexpr size_t WS_BAR  = 5 * MiB;
constexpr size_t WS_W    = 8 * MiB;
constexpr size_t SZ_WGU = (size_t)5632 * 1024 * 2, SZ_WD = (size_t)1024 * 2816 * 2;
constexpr size_t WS_WGU0 = WS_W;
constexpr size_t WS_WIN0 = WS_W + 4 * (SZ_WGU + SZ_WD);
constexpr size_t WS_WUQ  = WS_WIN0 + (size_t)2048 * 1024 * 2;
constexpr size_t WS_WUKV = WS_WUQ + (size_t)768 * 256 * 2;
constexpr size_t WS_WOUT0 = WS_WUKV + (size_t)1024 * 128 * 2;
constexpr size_t WS_WIN1 = WS_WOUT0 + (size_t)1024 * 1024 * 2;
constexpr size_t WS_WOUT1 = WS_WIN1 + (size_t)3072 * 1024 * 2;
constexpr size_t WS_WEND = WS_WOUT1 + (size_t)1024 * 1024 * 2;
constexpr size_t WS_XB   = 96 * MiB;
constexpr size_t WS_DIL  = 472 * MiB;
constexpr size_t WS_BIG  = 160 * MiB;
constexpr size_t WS_H    = WS_BIG;
constexpr size_t WS_AQKV = WS_BIG;
constexpr size_t WS_CQ   = WS_AQKV + 96 * MiB;
constexpr size_t WS_CKV  = WS_CQ + 16 * MiB;
constexpr size_t WS_QM   = WS_CKV + 8 * MiB;
constexpr size_t WS_KM   = WS_QM + 48 * MiB;
constexpr size_t WS_VM   = WS_KM + 48 * MiB;
constexpr size_t WS_O0   = WS_VM + 32 * MiB;
constexpr size_t WS_END0 = WS_O0 + 64 * MiB;
constexpr size_t WS_QKV1 = WS_BIG;
constexpr size_t WS_O1   = WS_QKV1 + 192 * MiB;
constexpr size_t WS_END1 = WS_O1 + 64 * MiB;
constexpr size_t WS_NEED = 512 * MiB;
static_assert(WS_WEND <= WS_XB && WS_END0 <= WS_NEED && WS_END1 <= WS_NEED && WS_H + (size_t)M_TOK * DFF * 2 <= WS_NEED, "d_ws map");
constexpr size_t DIL_SCR_BYTES = (512 * 64 + 1024) * 4;
static_assert(WS_DIL >= WS_END0 && WS_DIL + 256 * DIL_SCR_BYTES <= WS_NEED, "dilated state after the layer-0 mixer buffers");
constexpr int LDS_BYTES = 131072 + 18432 + 64;

struct Args {
    const float* x; const float* ffn_norm_g; const float* mix_norm_g; const float* w_gate; const float* w_up; const float* w_down;
    const float* ab_w_in; const float* q_norm_g; const float* w_uq; const float* kv_norm_g; const float* w_ukv; const float* ab_w_out;
    const float* sb_w_in; const float* sb_w_out; const float* final_g; float* out; unsigned char* ws; int ph_lo, ph_hi;
};

__device__ __forceinline__ unsigned f2bf(float f) { unsigned u = __builtin_bit_cast(unsigned, f); return (u + 0x7fffu + ((u >> 16) & 1u)) >> 16; }
__device__ __forceinline__ unsigned pk2(float lo, float hi) { return f2bf(lo) | (f2bf(hi) << 16); }
__device__ __forceinline__ float wave_sum(float v) {
#pragma unroll
    for (int o = 1; o < 64; o <<= 1) v += __shfl_xor(v, o);
    return v;
}
template <int MAP> __device__ __forceinline__ int wrow(int n) {
    if (MAP == 0) return n;
    return (n >> 7) * 256 + (n & 127) + (MAP == 2 ? 128 : 0);
}
__device__ __forceinline__ unsigned pkh2(float lo, float hi) { typedef _Float16 h2_ __attribute__((ext_vector_type(2))); if (!RES_FP16) return pk2(lo, hi); h2_ v = {(_Float16)lo, (_Float16)hi}; return __builtin_bit_cast(unsigned, v); }
template <int MAP, bool F16> __device__ __forceinline__ void tr_item(const float* W, int K, int N, bf16_t* WT, const float* gain, float* scr, int item, int lane) {
    const int nblk = N / 32, kb = item / nblk, nb = item % nblk, k0 = 64 * kb, n0 = 32 * nb;
    float wv[32];
    const float gl = gain ? gain[k0 + lane] : 1.0f;
#pragma unroll
    for (int i = 0; i < 32; ++i) { const int kk = 2 * i + (lane >> 5); wv[i] = W[(size_t)(k0 + kk) * N + n0 + (lane & 31)]; }
#pragma unroll
    for (int i = 0; i < 32; ++i) { const int kk = 2 * i + (lane >> 5);
        const float g0 = __builtin_bit_cast(float, __builtin_amdgcn_readlane(__builtin_bit_cast(int, gl), 2 * i)), g1 = __builtin_bit_cast(float, __builtin_amdgcn_readlane(__builtin_bit_cast(int, gl), 2 * i + 1));
        scr[kk * 33 + (lane & 31)] = wv[i] * ((lane >> 5) ? g1 : g0); }
    asm volatile("s_waitcnt lgkmcnt(0)" ::: "memory");
    const int c = lane & 7;
#pragma unroll
    for (int j = 0; j < 4; ++j) { const int n = (lane >> 3) + 8 * j; const float* s = scr + (8 * c) * 33 + n;
        u32x4 o; if (F16) { o.x = pkh2(s[0 * 33], s[1 * 33]); o.y = pkh2(s[2 * 33], s[3 * 33]); o.z = pkh2(s[4 * 33], s[5 * 33]); o.w = pkh2(s[6 * 33], s[7 * 33]); }
        else { o.x = pk2(s[0 * 33], s[1 * 33]); o.y = pk2(s[2 * 33], s[3 * 33]); o.z = pk2(s[4 * 33], s[5 * 33]); o.w = pk2(s[6 * 33], s[7 * 33]); }
        *(u32x4*)(WT + (size_t)wrow<MAP>(n0 + n) * K + k0 + 8 * c) = o; }
    asm volatile("s_waitcnt lgkmcnt(0)" ::: "memory");
}

struct TrP { const float* W; const float* gain; bf16_t* WT; int K, N, map, item; };
__device__ __forceinline__ void tr_load(const TrP& p, int lane, float (&wv)[32], float& gl) {
    const int nblk = p.N / 32, kb = p.item / nblk, nb = p.item % nblk, k0 = 64 * kb, n0 = 32 * nb;
    gl = p.gain ? p.gain[k0 + lane] : 1.0f;
#pragma unroll
    for (int i = 0; i < 32; ++i) { const int kk = 2 * i + (lane >> 5); wv[i] = p.W[(size_t)(k0 + kk) * p.N + n0 + (lane & 31)]; }
}
__device__ __forceinline__ void tr_store(const TrP& p, int lane, const float (&wv)[32], float gl, float* scr) {
    const int nblk = p.N / 32, kb = p.item / nblk, nb = p.item % nblk, k0 = 64 * kb, n0 = 32 * nb;
#pragma unroll
    for (int i = 0; i < 32; ++i) { const int kk = 2 * i + (lane >> 5);
        const float g0 = __builtin_bit_cast(float, __builtin_amdgcn_readlane(__builtin_bit_cast(int, gl), 2 * i)), g1 = __builtin_bit_cast(float, __builtin_amdgcn_readlane(__builtin_bit_cast(int, gl), 2 * i + 1));
        scr[kk * 33 + (lane & 31)] = wv[i] * ((lane >> 5) ? g1 : g0); }
    asm volatile("s_waitcnt lgkmcnt(0)" ::: "memory");
    const int c = lane & 7;
#pragma unroll
    for (int j = 0; j < 4; ++j) { const int n = (lane >> 3) + 8 * j; const float* s = scr + (8 * c) * 33 + n;
        u32x4 o; o.x = pkh2(s[0 * 33], s[1 * 33]); o.y = pkh2(s[2 * 33], s[3 * 33]); o.z = pkh2(s[4 * 33], s[5 * 33]); o.w = pkh2(s[6 * 33], s[7 * 33]);
        const int nn = n0 + n; const int rowd = (p.map == 0) ? nn : (nn >> 7) * 256 + (nn & 127) + (p.map == 2 ? 128 : 0);
        *(u32x4*)(p.WT + (size_t)rowd * p.K + k0 + 8 * c) = o; }
    asm volatile("s_waitcnt lgkmcnt(0)" ::: "memory");
}

#define LAS __attribute__((address_space(3)))
#define XB_TMO      128
#define XB_XCNT(j)  (256  + 64 * (j))
#define XB_XSUB(j)  (1280 + 64 * (j))
#define XB_XGEN(j)  (2304 + 64 * (j))
#define XB_TOP      3328
#define XB_TOPGEN   3392
#define XCD_BAR_WORDS 3456
#define XB_SPIN_CAP (1u << 18)

__device__ __forceinline__ unsigned xb_ld(unsigned* p)              { return __hip_atomic_load(p, __ATOMIC_RELAXED, __HIP_MEMORY_SCOPE_AGENT); }
__device__ __forceinline__ unsigned xb_add(unsigned* p, unsigned v) { return __hip_atomic_fetch_add(p, v, __ATOMIC_RELAXED, __HIP_MEMORY_SCOPE_AGENT); }
__device__ __forceinline__ unsigned xb_xcc_id() { return (unsigned)__builtin_amdgcn_s_getreg((3 << 11) | 20) & 0xFu; }
#define XB_SPIN(cond, bar) do { unsigned _sp = 0; while (cond) { __builtin_amdgcn_s_sleep(1); \
    if ((++_sp & 255u) == 0u) { if (xb_ld(&(bar)[XB_TMO])) break; if (_sp > XB_SPIN_CAP) { atomicAdd(&(bar)[XB_TMO], 1u); break; } } } } while (0)

struct XcdBarrier {
    unsigned* bar; unsigned x;
    volatile LAS unsigned* st;
};

__device__ __forceinline__ XcdBarrier xcd_barrier_post(unsigned* bar, volatile LAS unsigned* st) {
    XcdBarrier b; b.bar = bar; b.x = xb_xcc_id(); b.st = st;
    if (threadIdx.x == 0) (void)xb_add(&bar[XB_XCNT(b.x)], 1u);
    return b;
}
__device__ __forceinline__ void xcd_barrier_complete(unsigned* bar, unsigned x, unsigned& nloc, unsigned& nx) {
    const unsigned G = gridDim.x * gridDim.y * gridDim.z;
    unsigned sum, cnt, mine, sp = 0u;
    for (;;) {
        sum = 0u; cnt = 0u; mine = 0u;
#pragma unroll
        for (unsigned j = 0; j < 16; ++j) { const unsigned c = xb_ld(&bar[XB_XCNT(j)]); sum += c; cnt += (c > 0u) ? 1u : 0u; mine = (j == x) ? c : mine; }
        if (sum == G) break;
        __builtin_amdgcn_s_sleep(1);
        if ((++sp & 255u) == 0u) { if (xb_ld(&bar[XB_TMO])) break; if (sp > XB_SPIN_CAP) { atomicAdd(&bar[XB_TMO], 1u); break; } }
    }
    nloc = mine > 0u ? mine : 1u; nx = cnt > 0u ? cnt : 1u;
}

__device__ __forceinline__ void xcd_barrier(const XcdBarrier& b) {
    asm volatile("s_waitcnt vmcnt(0)" ::: "memory");
    __syncthreads();
    if (threadIdx.x == 0) {
        unsigned* bar = b.bar;
        __builtin_amdgcn_s_waitcnt(0);
        unsigned nloc = b.st[0], nx = b.st[1];
        if (nloc == 0u) { xcd_barrier_complete(bar, b.x, nloc, nx); b.st[0] = nloc; b.st[1] = nx; }
        const unsigned old = xb_add(&bar[XB_XSUB(b.x)], 1u);
        const unsigned gen = old / nloc;
        if (old + 1u == (gen + 1u) * nloc) {
            __builtin_amdgcn_fence(__ATOMIC_RELEASE, "agent");
            asm volatile("s_waitcnt vmcnt(0)" ::: "memory");
            const unsigned og = xb_add(&bar[XB_TOP], 1u);
            const unsigned tg = og / nx;
            if (og + 1u == (tg + 1u) * nx) xb_add(&bar[XB_TOPGEN], 1u);
            else XB_SPIN(xb_ld(&bar[XB_TOPGEN]) == tg, bar);
            __builtin_amdgcn_fence(__ATOMIC_ACQUIRE, "agent");
            xb_add(&bar[XB_XGEN(b.x)], 1u);
            asm volatile("s_waitcnt vmcnt(0)" ::: "memory");
        } else {
            XB_SPIN(xb_ld(&bar[XB_XGEN(b.x)]) == gen, bar);
            __builtin_amdgcn_fence(__ATOMIC_ACQUIRE, "agent");
            asm volatile("s_waitcnt vmcnt(0)" ::: "memory");
        }
    }
    __syncthreads();
}

__device__ __forceinline__ void grid_bar(unsigned* bar, unsigned nblk, unsigned& gen) {
    asm volatile("s_waitcnt vmcnt(0)" ::: "memory");
    __syncthreads();
    gen += 1u;
    if (threadIdx.x == 0) {
        __builtin_amdgcn_fence(__ATOMIC_RELEASE, "agent");
        asm volatile("s_waitcnt vmcnt(0)" ::: "memory");
        const unsigned target = gen * nblk;
        const unsigned old = __hip_atomic_fetch_add(bar, 1u, __ATOMIC_RELAXED, __HIP_MEMORY_SCOPE_AGENT);
        unsigned* flag = bar + 64;
        if (old + 1u == target) __hip_atomic_store(flag, gen, __ATOMIC_RELAXED, __HIP_MEMORY_SCOPE_AGENT);
        else { unsigned spins = 0; while (__hip_atomic_load(flag, __ATOMIC_RELAXED, __HIP_MEMORY_SCOPE_AGENT) < gen) { __builtin_amdgcn_s_sleep(2); if (++spins > (1u << 24)) break; } }
        __builtin_amdgcn_fence(__ATOMIC_ACQUIRE, "agent");
        asm volatile("s_waitcnt vmcnt(0)" ::: "memory");
    }
    __syncthreads();
}

__global__ void __launch_bounds__(NTHR, 2) mk_fwd(Args a) {
    extern __shared__ __attribute__((aligned(16))) unsigned char lds[];
    cg::grid_group grid = cg::this_grid();
    const int G = gridDim.x, bid = blockIdx.x;
    unsigned char* ws = a.ws;
    float* rope = (float*)(ws + WS_ROPE); float* ss = (float*)(ws + WS_SS); float* ssq = (float*)(ws + WS_SSQ); float* sskv = (float*)(ws + WS_SSKV);
    bf16_t* XB = (bf16_t*)(ws + WS_XB); bf16_t* H = (bf16_t*)(ws + WS_H);
    PG8_LAS unsigned char* glds = (PG8_LAS unsigned char*)lds;
    int ph = 0;
    unsigned* gbar = (unsigned*)(ws + WS_BAR); unsigned gen = 0u; (void)gen;
    volatile LAS unsigned* xst = (volatile LAS unsigned*)((LAS unsigned char*)lds + 131072 + 18432);
    if (threadIdx.x < 2) xst[threadIdx.x] = 0u;
    __syncthreads();
    const XcdBarrier xbar = xcd_barrier_post(gbar, xst);
#ifndef PROBE_REPEAT
#define PROBE_REPEAT -1
#endif
#define PHASE_BEGIN if (ph >= a.ph_lo && ph < a.ph_hi) { for (int rep_ = (ph == PROBE_REPEAT ? 2 : 1); rep_ > 0; --rep_) {
#define PHASE_END(dosync_) } if ((dosync_) && ph + 1 < a.ph_hi) { if (a.ph_lo > 1000000) grid.sync(); xcd_barrier(xbar); } } ++ph;

    PHASE_BEGIN
    {
        const int tid = opaque_tid(), lane = tid & 63, wave = __builtin_amdgcn_readfirstlane(tid >> 6);
        float* scr = (float*)(lds + wave * 16384);
        const int gw = bid * 8 + wave, NGW = G * 8;
        constexpr int I_GU = 16 * 88, I_D = 44 * 32, I_IN0 = 16 * 61, I_UQ = 4 * 24, I_UKV = 2 * 32, I_O = 16 * 32, I_IN1 = 16 * 96;
        constexpr int NITEMS = 4 * (2 * I_GU + I_D) + I_IN0 + I_UQ + I_UKV + I_O + I_IN1 + I_O;
        auto get_item = [&](int it) __attribute__((always_inline)) -> TrP {
            TrP p; int r = it;
            if (r < 4 * (2 * I_GU + I_D)) {
                const int f = r / (2 * I_GU + I_D); r -= f * (2 * I_GU + I_D);
                bf16_t* wgu = (bf16_t*)(ws + WS_WGU0 + f * (SZ_WGU + SZ_WD)); bf16_t* wd = (bf16_t*)(ws + WS_WGU0 + f * (SZ_WGU + SZ_WD) + SZ_WGU);
                const float* g = a.ffn_norm_g + f * 1024;
                if (r < I_GU) p = TrP{a.w_gate + (size_t)f * 1024 * 2816, g, wgu, 1024, 2816, 1, r};
                else if (r < 2 * I_GU) p = TrP{a.w_up + (size_t)f * 1024 * 2816, g, wgu, 1024, 2816, 2, r - I_GU};
                else p = TrP{a.w_down + (size_t)f * 2816 * 1024, nullptr, wd, 2816, 1024, 0, r - 2 * I_GU};
                return p;
            }
            r -= 4 * (2 * I_GU + I_D);
            if (r < I_IN0) return TrP{a.ab_w_in, a.mix_norm_g, (bf16_t*)(ws + WS_WIN0), 1024, 1952, 0, r}; r -= I_IN0;
            if (r < I_UQ) return TrP{a.w_uq, a.q_norm_g, (bf16_t*)(ws + WS_WUQ), 256, 768, 0, r}; r -= I_UQ;
            if (r < I_UKV) return TrP{a.w_ukv, a.kv_norm_g, (bf16_t*)(ws + WS_WUKV), 128, 1024, 0, r}; r -= I_UKV;
            if (r < I_O) return TrP{a.ab_w_out, nullptr, (bf16_t*)(ws + WS_WOUT0), 1024, 1024, 0, r}; r -= I_O;
            if (r < I_IN1) return TrP{a.sb_w_in, a.mix_norm_g + 1024, (bf16_t*)(ws + WS_WIN1), 1024, 3072, 0, r}; r -= I_IN1;
            return TrP{a.sb_w_out, nullptr, (bf16_t*)(ws + WS_WOUT1), 1024, 1024, 0, r};
        };
        if (gw < NITEMS) {
            TrP cur = get_item(gw); float wv[32], gl; tr_load(cur, lane, wv, gl);
            for (int it = gw; it < NITEMS; it += NGW) {
                const int itn = (it + NGW < NITEMS) ? it + NGW : it;
                const TrP nxt = get_item(itn); float wn[32], gn; tr_load(nxt, lane, wn, gn);
                tr_store(cur, lane, wv, gl, scr);
                cur = nxt; gl = gn;
#pragma unroll
                for (int i = 0; i < 32; ++i) wv[i] = wn[i];
            }
        }
        { u32x4* z = (u32x4*)(ws + WS_WIN0 + (size_t)1952 * 1024 * 2); const int nz = 96 * 1024 * 2 / 16;
          for (int i = bid * NTHR + tid; i < nz; i += G * NTHR) z[i] = u32x4{0u, 0u, 0u, 0u}; }
        for (int i = bid * NTHR + tid; i < 2048 * 16; i += G * NTHR) {
            const int pos = i >> 4, fi = i & 15; double inv = 1.0;
            for (int q = 0; q < fi; ++q) inv *= 0.5623413251903491;
            const double rev = (double)pos * inv * 0.15915494309189535; const double fr = rev - (double)(long long)rev;
            const float ang = (float)(fr * 6.283185307179586);
            float sv, cv; sincosf(ang, &sv, &cv);
            rope[pos * 32 + fi] = cv; rope[pos * 32 + 16 + fi] = sv;
        }
        for (int m0 = gw; m0 < M_TOK; m0 += 4 * NGW) {
            f32x4 v[4][4];
#pragma unroll
            for (int q = 0; q < 4; ++q)
#pragma unroll
                for (int j = 0; j < 4; ++j) v[q][j] = ((const f32x4*)(a.x + (size_t)(m0 + q * NGW) * 1024) + lane)[64 * j];
#pragma unroll
            for (int q = 0; q < 4; ++q) { const int m = m0 + q * NGW; float s = 0.f;
                unsigned long long* o8 = (unsigned long long*)(XB + (size_t)m * 1024) + lane;
#pragma unroll
                for (int j = 0; j < 4; ++j) { const f32x4 w = v[q][j]; s += (w[0] * w[0] + w[1] * w[1]) + (w[2] * w[2] + w[3] * w[3]);
                    o8[64 * j] = (unsigned long long)pkh2(w[0], w[1]) | ((unsigned long long)pkh2(w[2], w[3]) << 32); }
                s = wave_sum(s);
                if (lane < 16) ss[(size_t)m * 16 + lane] = (lane == 0) ? s : 0.f; }
        }
        __syncthreads();
    }
    PHASE_END(true)

#define GEMM_PHASE(EPI, E, Aptr, Bptr, Nn, Kk) do { int kk_ = (Kk), nn_ = (Nn); asm volatile("" : "+s"(kk_), "+s"(nn_)); pg8::Gemm g_{(const bf16_t*)(Aptr), (const bf16_t*)(Bptr), M_TOK, nn_, kk_}; pg8::StaticOrder S_; S_.init(M_TOK, nn_, G, bid); \
        pg8::gemm_phase<EPI, pg8::StaticOrder, true, true>(glds, g_, S_, E); } while (0)

#pragma unroll 1
    for (int layer = 0; layer < 2; ++layer) {
#pragma unroll 1
        for (int half = 0; half < 2; ++half) {
            const int f = layer * 2 + half;
            const bf16_t* wgu = (const bf16_t*)(ws + WS_WGU0 + f * (SZ_WGU + SZ_WD)); const bf16_t* wd = (const bf16_t*)(ws + WS_WGU0 + f * (SZ_WGU + SZ_WD) + SZ_WGU);
            PHASE_BEGIN
            { pg8::EpiGU E{ss, H}; GEMM_PHASE(pg8::EpiGU, E, XB, wgu, 5632, 1024); }
            PHASE_END(true)
            PHASE_BEGIN
                        { if (f == 0) { pg8::EpiResidT<true> E{a.x, XB, ss, (rep_ == 2) ? 0.f : 0.5f, (float*)(lds + 131072)}; GEMM_PHASE(pg8::EpiResidT<true>, E, H, wd, 1024, 2816); }
              else { pg8::EpiResidT<false> E{a.x, XB, ss, (rep_ == 2) ? 0.f : 0.5f, (float*)(lds + 131072)}; GEMM_PHASE(pg8::EpiResidT<false>, E, H, wd, 1024, 2816); } }
            PHASE_END(true)
            if (half == 1) continue;
            if (layer == 0) {
                bf16_t* AQKV = (bf16_t*)(ws + WS_AQKV); bf16_t* CQ = (bf16_t*)(ws + WS_CQ); bf16_t* CKV = (bf16_t*)(ws + WS_CKV);
                bf16_t* QM = (bf16_t*)(ws + WS_QM); bf16_t* KM = (bf16_t*)(ws + WS_KM); bf16_t* VM = (bf16_t*)(ws + WS_VM); bf16_t* O0 = (bf16_t*)(ws + WS_O0);
                PHASE_BEGIN
                { pg8::EpiInAB E{ss, AQKV, CQ, CKV, KM, ssq, sskv, rope}; GEMM_PHASE(pg8::EpiInAB, E, XB, ws + WS_WIN0, 2048, 1024); }
                PHASE_END(true)
                PHASE_BEGIN
                { pg8::EpiUQ E{ssq, QM, rope}; GEMM_PHASE(pg8::EpiUQ, E, CQ, ws + WS_WUQ, 768, 256); }
                { pg8::EpiUKV E{sskv, KM, VM}; GEMM_PHASE(pg8::EpiUKV, E, CKV, ws + WS_WUKV, 1024, 128); }
                __syncthreads();
                for (int u = bid; u < 512; u += G) {
                    const int blk = u & 3, h = (u >> 2) & 7, b = u >> 5;
                    att::dil_unit(AQKV, (float*)(ws + WS_DIL + (size_t)bid * DIL_SCR_BYTES), O0, b, h, blk, (char*)lds);
                }
                PHASE_END(true)
                PHASE_BEGIN
                for (int i = 0; i < 4; ++i) {
                    const int v = bid + i * G; if (v >= 1024) break;
                    const int c = v & 255, rnd = v >> 8, bh = c >> 1, s = c & 1;
                    const int qb = (rnd == 0) ? s : (rnd == 1) ? 7 - s : (rnd == 2) ? 2 + s : 5 - s;
                    const int b = bh >> 3, h = bh & 7; const size_t rb = (size_t)b * 2048;
                    att::attn_unit<96, 0>(QM + rb * 768 + h * 96, 768, KM + rb * 768 + h * 96, 768, VM + rb * 512 + h * 64, 512, O0 + rb * 1024 + 512 + h * 64, 1024, qb, (char*)lds,
                                          0.10206207261596575f * att::kLog2e);
                }
                __syncthreads();
                PHASE_END(true)
                PHASE_BEGIN
                { pg8::EpiResidT<false> E{a.x, XB, ss, (rep_ == 2) ? 0.f : 1.0f, (float*)(lds + 131072)}; GEMM_PHASE(pg8::EpiResidT<false>, E, O0, ws + WS_WOUT0, 1024, 1024); }
                PHASE_END(true)
            } else {
                bf16_t* QKV = (bf16_t*)(ws + WS_QKV1); bf16_t* O1 = (bf16_t*)(ws + WS_O1);
                PHASE_BEGIN
                { pg8::EpiScale E{ss, QKV, 3072}; GEMM_PHASE(pg8::EpiScale, E, XB, ws + WS_WIN1, 3072, 1024); }
                PHASE_END(true)
                PHASE_BEGIN
                {
                    const int tid = opaque_tid(), lane = tid & 63, wave = __builtin_amdgcn_readfirstlane(tid >> 6);
                    for (int bh = bid; bh < 256; bh += G) {
                        const int b = bh >> 4, h = bh & 15; const size_t rb = (size_t)b * 2048;
                        for (int rnd = 7; rnd >= 0; --rnd)
                            att::sb_wave_unit(QKV + rb * 3072 + h * 64, QKV + rb * 3072 + 1024 + h * 64, QKV + rb * 3072 + 2048 + h * 64, 3072, O1 + rb * 1024 + h * 64, 1024, (rnd * 8 + wave) * 32, (char*)lds + wave * 4096, lane);
                    }
                }
                __syncthreads();
                PHASE_END(true)
                PHASE_BEGIN
                { pg8::EpiResidT<false> E{a.x, XB, ss, (rep_ == 2) ? 0.f : 1.0f, (float*)(lds + 131072)}; GEMM_PHASE(pg8::EpiResidT<false>, E, O1, ws + WS_WOUT1, 1024, 1024); }
                PHASE_END(true)
            }
        }
    }
    PHASE_BEGIN
    {
        const int tid = opaque_tid(), lane = tid & 63, wave = __builtin_amdgcn_readfirstlane(tid >> 6);
        const int gw = bid * 8 + wave, NGW = G * 8;
        f32x4 gv[4];
#pragma unroll
        for (int j = 0; j < 4; ++j) gv[j] = ((const f32x4*)a.final_g + lane)[64 * j];
        for (int m0 = gw; m0 < M_TOK; m0 += 4 * NGW) {
            u32x2 v[4][4]; float sq[4];
#pragma unroll
            for (int q = 0; q < 4; ++q) { const int m = m0 + q * NGW; sq[q] = (lane < 16) ? ss[(size_t)m * 16 + lane] : 0.f;
#pragma unroll
                for (int j = 0; j < 4; ++j) v[q][j] = ((const u32x2*)(XB + (size_t)m * 1024) + lane)[64 * j]; }
#pragma unroll
            for (int q = 0; q < 4; ++q) { const int m = m0 + q * NGW; const float rs = __builtin_amdgcn_rsqf(wave_sum(sq[q]) * (1.0f / 1024.0f) + 1e-6f);
                f32x4* xr = (f32x4*)(a.out + (size_t)m * 1024) + lane;
#pragma unroll
                for (int j = 0; j < 4; ++j) xr[64 * j] = pg8::unpk4h(v[q][j]) * rs * gv[j]; }
        }
    }
    PHASE_END(false)
#undef PHASE_BEGIN
#undef PHASE_END
#undef GEMM_PHASE
}

extern "C" void kernel_launch(void* const* d_in, const int* in_sizes, int n_in, void* d_out, int out_size, void* d_ws, size_t ws_size, hipStream_t stream) {
    static int grid = 0;
    if (grid == 0) {
        if (n_in != 15 || in_sizes[0] != M_TOK * DM || out_size != M_TOK * DM || ws_size < WS_NEED) {
            fprintf(stderr, "kernel_launch: unexpected shapes (n_in %d in0 %d out %d ws %zu)\n", n_in, n_in > 0 ? in_sizes[0] : -1, out_size, ws_size); grid = -1; return; }
        int dev = 0, cus = 0, per_cu = 0;
        (void)hipGetDevice(&dev); (void)hipDeviceGetAttribute(&cus, hipDeviceAttributeMultiprocessorCount, dev);
        if (hipFuncSetAttribute((const void*)mk_fwd, hipFuncAttributeMaxDynamicSharedMemorySize, LDS_BYTES) != hipSuccess) { fprintf(stderr, "kernel_launch: hipFuncSetAttribute failed\n"); grid = -1; return; }
        if (hipOccupancyMaxActiveBlocksPerMultiprocessor(&per_cu, (const void*)mk_fwd, NTHR, LDS_BYTES) != hipSuccess || per_cu < 1) { fprintf(stderr, "kernel_launch: occupancy query failed (%d)\n", per_cu); per_cu = 1; }
        (void)hipGetLastError();
        grid = cus * 1;
        if (grid <= 0) grid = 256;
    }
    if (grid < 0) return;
    Args a{};
    a.x = (const float*)d_in[0]; a.ffn_norm_g = (const float*)d_in[1]; a.mix_norm_g = (const float*)d_in[2]; a.w_gate = (const float*)d_in[3]; a.w_up = (const float*)d_in[4]; a.w_down = (const float*)d_in[5];
    a.ab_w_in = (const float*)d_in[6]; a.q_norm_g = (const float*)d_in[7]; a.w_uq = (const float*)d_in[8]; a.kv_norm_g = (const float*)d_in[9]; a.w_ukv = (const float*)d_in[10]; a.ab_w_out = (const float*)d_in[11];
    a.sb_w_in = (const float*)d_in[12]; a.sb_w_out = (const float*)d_in[13]; a.final_g = (const float*)d_in[14]; a.out = (float*)d_out; a.ws = (unsigned char*)d_ws;
    a.ph_lo = 0; a.ph_hi = 1000;
    if (hipMemsetAsync((char*)d_ws + WS_BAR, 0, 16384, stream) != hipSuccess) { fprintf(stderr, "kernel_launch: memset of the barrier words failed\n"); return; }
    void* args[] = {&a};
    hipError_t e = hipLaunchCooperativeKernel((const void*)mk_fwd, dim3(grid), dim3(NTHR), args, LDS_BYTES, stream);
    if (e != hipSuccess) fprintf(stderr, "kernel_launch: cooperative launch failed: %s (grid %d)\n", hipGetErrorString(e), grid);
}
```

```cpp
#include <hip/hip_runtime.h>
#include <hip/hip_cooperative_groups.h>
#include <cstdio>
#include <cstdint>
namespace cg = cooperative_groups;

__device__ __forceinline__ int opaque_tid() { int t = threadIdx.x; asm volatile("" : "+v"(t)); return t; }
namespace pg8 {
#define PG8_LAS __attribute__((address_space(3)))
typedef unsigned short bf16_t;
typedef short bf16x8 __attribute__((ext_vector_type(8)));
typedef float f32x4 __attribute__((ext_vector_type(4)));
typedef unsigned u32x4 __attribute__((ext_vector_type(4)));
constexpr int BM = 256, BK = 64, HALF = 128, HTB = HALF * BK * 2  , STAGE_BYTES = 8 * HTB, NXCD = 8, WGM = 8;

__host__ __device__ __forceinline__ int lds_byte(int r, int c) { const int st = (r >> 4) * 2 + (c >> 5), rr = r & 15, cc = c & 31, ob = rr * 64 + cc * 2; return st * 1024 + (ob ^ (((ob >> 9) & 1) << 5)); }
__host__ __device__ __forceinline__ void stage_rc(int b, int& R, int& C) { const int st = b / 1024, sb = b % 1024, swz = sb ^ (((sb >> 9) & 1) << 5); R = (st >> 1) * 16 + swz / 64; C = (st & 1) * 32 + (swz % 64) / 2; }
__host__ __device__ __forceinline__ int perm32(int rho) { const int n = rho >> 4, i = rho & 15; return 8 * (i >> 2) + 4 * n + (i & 3); }

struct Unit { int pm, pn; };
struct Gemm { const bf16_t* A; const bf16_t* Bt; int M, N, K; };

struct StaticOrder {
    int nM, nN, nwg, G, c;
    __host__ __device__ void init(int M, int N, int G_, int c_) { nM = M / BM; nN = N / BM; nwg = nM * nN; G = G_; c = c_; }
    __host__ __device__ bool next(int i, Unit& u) const {
        const long L = (long)i * G + c; if (L >= nwg) return false;
        int wgid = (int)L; { const int q = nwg / NXCD, r = nwg % NXCD, xcd = wgid % NXCD, off = wgid / NXCD; wgid = (xcd < r ? xcd * (q + 1) : r * (q + 1) + (xcd - r) * q) + off; }
        const int nig = WGM * nN, gid = wgid / nig, fm = gid * WGM, gsz = (nM - fm) < WGM ? (nM - fm) : WGM;
        u.pm = fm + ((wgid % nig) % gsz); u.pn = (wgid % nig) / gsz; return true;
    }
    __device__ __forceinline__ void a_ready(const Unit&) const {}
    __device__ __forceinline__ void done(const Unit&) const {}
};

__device__ __forceinline__ unsigned cvt_pk_bf16(float lo, float hi) { unsigned r; asm volatile("v_cvt_pk_bf16_f32 %0, %1, %2" : "=v"(r) : "v"(lo), "v"(hi)); return r; }
typedef unsigned u32x2 __attribute__((ext_vector_type(2)));
constexpr float kEps = 1e-6f;
typedef _Float16 f16x8 __attribute__((ext_vector_type(8)));
typedef _Float16 f16x2 __attribute__((ext_vector_type(2)));
template <bool F16> __device__ __forceinline__ f32x4 mma16(bf16x8 a, bf16x8 b, f32x4 c) {
    if (F16) return __builtin_amdgcn_mfma_f32_16x16x32_f16(__builtin_bit_cast(f16x8, a), __builtin_bit_cast(f16x8, b), c, 0, 0, 0);
    return __builtin_amdgcn_mfma_f32_16x16x32_bf16(a, b, c, 0, 0, 0);
}
#ifndef RES_FP16
#define RES_FP16 0
#endif
__device__ __forceinline__ unsigned pkh(float lo, float hi) { if (!RES_FP16) return cvt_pk_bf16(lo, hi); f16x2 v = {(_Float16)lo, (_Float16)hi}; return __builtin_bit_cast(unsigned, v); }
__device__ __forceinline__ f32x4 unpk4h(u32x2 w) { if (!RES_FP16) return (f32x4){__builtin_bit_cast(float, w.x << 16), __builtin_bit_cast(float, w.x & 0xffff0000u), __builtin_bit_cast(float, w.y << 16), __builtin_bit_cast(float, w.y & 0xffff0000u)}; const f16x2 a = __builtin_bit_cast(f16x2, w.x), b = __builtin_bit_cast(f16x2, w.y); return (f32x4){(float)a[0], (float)a[1], (float)b[0], (float)b[1]}; }

constexpr float kLog2e = 1.4426950408889634f;
__device__ __forceinline__ u32x2 pack4(const f32x4 v) { u32x2 w; w.x = cvt_pk_bf16(v[0], v[1]); w.y = cvt_pk_bf16(v[2], v[3]); return w; }
template <int NP> __device__ __forceinline__ float row_rstd(const float* ss, int row, float inv_n) {
    float s = 0.f;
#pragma unroll
    for (int i = 0; i < NP / 4; ++i) { const f32x4 v = *(const f32x4*)(ss + (size_t)row * NP + 4 * i); s += (v[0] + v[1]) + (v[2] + v[3]); }
    return __builtin_amdgcn_rsqf(s * inv_n + kEps);
}
__device__ __forceinline__ float quad_sum(float s) {
    const auto a = __builtin_amdgcn_permlane16_swap(__float_as_uint(s), __float_as_uint(s), false, false); s = __uint_as_float(a[0]) + __uint_as_float(a[1]);
    const auto b = __builtin_amdgcn_permlane32_swap(__float_as_uint(s), __float_as_uint(s), false, false); return __uint_as_float(b[0]) + __uint_as_float(b[1]);
}
__device__ __forceinline__ float dpp_f(float v, int ctrl_sel) {
    const int x = __float_as_int(v);
    const int r = ctrl_sel == 0 ? __builtin_amdgcn_update_dpp(0, x, 0xB1, 0xF, 0xF, true) : ctrl_sel == 1 ? __builtin_amdgcn_update_dpp(0, x, 0x4E, 0xF, 0xF, true) : __builtin_amdgcn_update_dpp(0, x, 0x104, 0xF, 0xF, true);
    return __int_as_float(r);
}


template <int NP> __device__ __forceinline__ void load_rstd8(const float* ss, const Unit& u, int wr, int fr, int fq, float inv_n, float (&rs)[2][4]) {
    f32x4 v[2][4];
#pragma unroll
    for (int ai = 0; ai < 2; ++ai)
#pragma unroll
        for (int m = 0; m < 4; ++m) { const int row = u.pm * BM + ai * HALF + wr * 64 + m * 16 + fr; v[ai][m] = *(const f32x4*)(ss + (size_t)row * NP + (NP == 16 ? 4 * fq : 0)); }
#pragma unroll
    for (int ai = 0; ai < 2; ++ai)
#pragma unroll
        for (int m = 0; m < 4; ++m) { float t = (v[ai][m][0] + v[ai][m][1]) + (v[ai][m][2] + v[ai][m][3]); if (NP == 16) t = quad_sum(t); rs[ai][m] = __builtin_amdgcn_rsqf(t * inv_n + kEps); }
}

struct EpiGU {
    static constexpr bool PERM = true, AFTER_DRAIN = false, F16 = (RES_FP16 != 0);
    const float* ss; bf16_t* H;
    __device__ __forceinline__ void operator()(const f32x4 (&acc)[2][2][4][2], const Unit& u, int wr, int wc, int fr, int fq) const {
        float rsv[2][4]; load_rstd8<16>(ss, u, wr, fr, fq, 1.0f / 1024.0f, rsv);
        typedef unsigned u32x4_ __attribute__((ext_vector_type(4)));
#pragma unroll
        for (int ai = 0; ai < 2; ++ai)
#pragma unroll
            for (int m = 0; m < 4; ++m) {
                const int row = u.pm * BM + ai * HALF + wr * 64 + m * 16 + fr;
                const float rs = rsv[ai][m];
                u32x2 w[2];
#pragma unroll
                for (int n = 0; n < 2; ++n) {
                    const f32x4 g = acc[ai][0][m][n] * rs, up = acc[ai][1][m][n] * rs; f32x4 o;
#pragma unroll
                    for (int j = 0; j < 4; ++j) { const float e = __builtin_amdgcn_exp2f(-g[j] * kLog2e); o[j] = g[j] * up[j] * __builtin_amdgcn_rcpf(1.0f + e); }
                    w[n] = pack4(o);
                }
                *(u32x4_*)(H + (size_t)row * 2816 + u.pn * 128 + wc * 32 + fq * 8) = (u32x4_){w[0].x, w[0].y, w[1].x, w[1].y};
            }
    }
};
template <bool SRC32> struct EpiResidT {
    static constexpr bool PERM = false, AFTER_DRAIN = false, F16 = false;
    const float* x32; bf16_t* X16; float* ss; float alpha; float* wlds;
    __device__ __forceinline__ void operator()(const f32x4 (&acc)[2][2][4][2], const Unit& u, int wr, int wc, int fr, int fq) const {
        float* wl = wlds + (wr * 4 + wc) * 576;
        const int lane = fq * 16 + fr, rl = lane >> 3, ch = lane & 7;
        f32x4 rb[2][2][2][2];
        const size_t cbase = (size_t)u.pn * BM + wc * 32 + ch * 4;
#define RES_LOAD(buf, b) do { _Pragma("unroll") for (int gg = 0; gg < 2; ++gg) { const int g_ = 2 * (b) + gg; const int row0_ = u.pm * BM + (g_ >> 2) * HALF + wr * 64 + (g_ & 3) * 16 + rl; \
            _Pragma("unroll") for (int bj = 0; bj < 2; ++bj) _Pragma("unroll") for (int i = 0; i < 2; ++i) { const size_t o_ = (size_t)(row0_ + 8 * i) * 1024 + cbase + bj * HALF; \
                if (SRC32) rb[buf][gg][bj][i] = *(const f32x4*)(x32 + o_); else rb[buf][gg][bj][i] = unpk4h(*(const u32x2*)(X16 + o_)); } } } while (0)
        RES_LOAD(0, 0);
#pragma unroll
        for (int b = 0; b < 4; ++b) {
            if (b + 1 < 4) RES_LOAD((b + 1) & 1, b + 1);
#pragma unroll
            for (int gg = 0; gg < 2; ++gg) {
                const int g = 2 * b + gg, ai = g >> 2, m = g & 3;
                const int row0 = u.pm * BM + ai * HALF + wr * 64 + m * 16 + rl;
                float sq[2] = {0.f, 0.f};
#pragma unroll
                for (int bj = 0; bj < 2; ++bj) {
                    *(f32x4*)(wl + fr * 36 + fq * 4) = acc[ai][bj][m][0] * alpha; *(f32x4*)(wl + fr * 36 + 16 + fq * 4) = acc[ai][bj][m][1] * alpha;
                    asm volatile("s_waitcnt lgkmcnt(0)" ::: "memory");
#pragma unroll
                    for (int i = 0; i < 2; ++i) {
                        const f32x4 x = rb[b & 1][gg][bj][i] + *(const f32x4*)(wl + (rl + 8 * i) * 36 + ch * 4);
                        const size_t off = (size_t)(row0 + 8 * i) * 1024 + cbase + bj * HALF;
                        u32x2 w; w.x = pkh(x[0], x[1]); w.y = pkh(x[2], x[3]); *(u32x2*)(X16 + off) = w;
                        sq[i] += (x[0] * x[0] + x[1] * x[1]) + (x[2] * x[2] + x[3] * x[3]);
                    }
                    asm volatile("s_waitcnt lgkmcnt(0)" ::: "memory");
                }
#pragma unroll
                for (int i = 0; i < 2; ++i) { float t = sq[i]; t += dpp_f(t, 0); t += dpp_f(t, 1); t += dpp_f(t, 2);
                    if (ch == 0) ss[(size_t)(row0 + 8 * i) * 16 + u.pn * 4 + wc] = t; }
            }
        }
#undef RES_LOAD
    }
};
struct EpiScale {
    static constexpr bool PERM = true, AFTER_DRAIN = false, F16 = (RES_FP16 != 0);
    const float* ss; bf16_t* O; int ldc;
    __device__ __forceinline__ void operator()(const f32x4 (&acc)[2][2][4][2], const Unit& u, int wr, int wc, int fr, int fq) const {
        float rsv[2][4]; load_rstd8<16>(ss, u, wr, fr, fq, 1.0f / 1024.0f, rsv);
        typedef unsigned u32x4_ __attribute__((ext_vector_type(4)));
#pragma unroll
        for (int ai = 0; ai < 2; ++ai)
#pragma unroll
            for (int m = 0; m < 4; ++m) {
                const int row = u.pm * BM + ai * HALF + wr * 64 + m * 16 + fr;
                const float rs = rsv[ai][m];
#pragma unroll
                for (int bj = 0; bj < 2; ++bj) {
                    const u32x2 lo = pack4(acc[ai][bj][m][0] * rs), hi = pack4(acc[ai][bj][m][1] * rs);
                    *(u32x4_*)(O + (size_t)row * ldc + u.pn * BM + bj * HALF + wc * 32 + fq * 8) = (u32x4_){lo.x, lo.y, hi.x, hi.y};
                }
            }
    }
};
struct EpiInAB {
    static constexpr bool PERM = false, AFTER_DRAIN = false, F16 = (RES_FP16 != 0);
    const float* ss; bf16_t* AQKV; bf16_t* CQ; bf16_t* CKV; bf16_t* KM; float* ssq; float* sskv; const float* rope;
    __device__ __forceinline__ void operator()(const f32x4 (&acc)[2][2][4][2], const Unit& u, int wr, int wc, int fr, int fq) const {
        float rsv[2][4]; load_rstd8<16>(ss, u, wr, fr, fq, 1.0f / 1024.0f, rsv);
#pragma unroll
        for (int ai = 0; ai < 2; ++ai)
#pragma unroll
            for (int m = 0; m < 4; ++m) {
                asm volatile("" ::: "memory"); const int row = u.pm * BM + ai * HALF + wr * 64 + m * 16 + fr;
                const float rs = rsv[ai][m];
                if (u.pn < 6) {
#pragma unroll
                    for (int bj = 0; bj < 2; ++bj)
#pragma unroll
                        for (int n = 0; n < 2; ++n)
                            *(u32x2*)(AQKV + (size_t)row * 1536 + u.pn * BM + bj * HALF + wc * 32 + n * 16 + fq * 4) = pack4(acc[ai][bj][m][n] * rs);
                } else if (u.pn == 6) {
                    float s = 0.f;
#pragma unroll
                    for (int bj = 0; bj < 2; ++bj)
#pragma unroll
                        for (int n = 0; n < 2; ++n) { const f32x4 x = acc[ai][bj][m][n] * rs;
                            *(u32x2*)(CQ + (size_t)row * 256 + bj * HALF + wc * 32 + n * 16 + fq * 4) = pack4(x);
                            s += (x[0] * x[0] + x[1] * x[1]) + (x[2] * x[2] + x[3] * x[3]); }
                    s = quad_sum(s);
                    if (fq == 0) ssq[(size_t)row * 4 + wc] = s;
                } else {
                    float s = 0.f;
#pragma unroll
                    for (int n = 0; n < 2; ++n) { const f32x4 x = acc[ai][0][m][n] * rs;
                        *(u32x2*)(CKV + (size_t)row * 128 + wc * 32 + n * 16 + fq * 4) = pack4(x);
                        s += (x[0] * x[0] + x[1] * x[1]) + (x[2] * x[2] + x[3] * x[3]); }
                    s = quad_sum(s);
                    if (fq == 0) sskv[(size_t)row * 4 + wc] = s;
                    if (wc == 0) {
                        const f32x4 x1 = acc[ai][1][m][0] * rs, x2 = acc[ai][1][m][1] * rs;
                        const int pos = row & 2047;
                        const f32x4 c = *(const f32x4*)(rope + pos * 32 + fq * 4), sn = *(const f32x4*)(rope + pos * 32 + 16 + fq * 4);
                        const u32x2 o1 = pack4(x1 * c - x2 * sn), o2 = pack4(x1 * sn + x2 * c);
#pragma unroll
                        for (int h = 0; h < 8; ++h) { bf16_t* kp = KM + (size_t)row * 768 + h * 96 + 64 + fq * 4; *(u32x2*)kp = o1; *(u32x2*)(kp + 16) = o2; }
                    }
                }
            }
    }
};
struct EpiUQ {
    static constexpr bool PERM = false, AFTER_DRAIN = false, F16 = false;
    const float* ssq; bf16_t* Q; const float* rope;
    __device__ __forceinline__ void operator()(const f32x4 (&acc)[2][2][4][2], const Unit& u, int wr, int wc, int fr, int fq) const {
        float rsv[2][4]; load_rstd8<4>(ssq, u, wr, fr, fq, 1.0f / 256.0f, rsv);
        f32x4 rc[2][4], rsn[2][4];
#pragma unroll
        for (int ai = 0; ai < 2; ++ai)
#pragma unroll
            for (int m = 0; m < 4; ++m) { const int pos = (u.pm * BM + ai * HALF + wr * 64 + m * 16 + fr) & 2047;
                rc[ai][m] = *(const f32x4*)(rope + pos * 32 + fq * 4); rsn[ai][m] = *(const f32x4*)(rope + pos * 32 + 16 + fq * 4); }
#pragma unroll
        for (int ai = 0; ai < 2; ++ai)
#pragma unroll
            for (int m = 0; m < 4; ++m) {
                const int row = u.pm * BM + ai * HALF + wr * 64 + m * 16 + fr;
                const float rs = rsv[ai][m];
#pragma unroll
                for (int bj = 0; bj < 2; ++bj) {
                    const int cb = u.pn * BM + bj * HALF + wc * 32;
                    f32x4 x1 = acc[ai][bj][m][0] * rs, x2 = acc[ai][bj][m][1] * rs;
                    if ((cb % 96) == 64) { const f32x4 c = rc[ai][m], sn = rsn[ai][m]; const f32x4 y1 = x1 * c - x2 * sn, y2 = x1 * sn + x2 * c; x1 = y1; x2 = y2; }
                    bf16_t* qp = Q + (size_t)row * 768 + cb + fq * 4; *(u32x2*)qp = pack4(x1); *(u32x2*)(qp + 16) = pack4(x2);
                }
            }
    }
};
struct EpiUKV {
    static constexpr bool PERM = false, AFTER_DRAIN = false, F16 = false;
    const float* sskv; bf16_t* KM; bf16_t* VM;
    __device__ __forceinline__ void operator()(const f32x4 (&acc)[2][2][4][2], const Unit& u, int wr, int wc, int fr, int fq) const {
        float rsv[2][4]; load_rstd8<4>(sskv, u, wr, fr, fq, 1.0f / 128.0f, rsv);
#pragma unroll
        for (int ai = 0; ai < 2; ++ai)
#pragma unroll
            for (int m = 0; m < 4; ++m) {
                asm volatile("" ::: "memory"); const int row = u.pm * BM + ai * HALF + wr * 64 + m * 16 + fr;
                const float rs = rsv[ai][m];
#pragma unroll
                for (int bj = 0; bj < 2; ++bj) {
                    const int cb = u.pn * BM + bj * HALF + wc * 32, h = cb >> 7, w = cb & 127;
                    bf16_t* p = (w < 64) ? (KM + (size_t)row * 768 + h * 96 + w + fq * 4) : (VM + (size_t)row * 512 + h * 64 + (w - 64) + fq * 4);
                    *(u32x2*)p = pack4(acc[ai][bj][m][0] * rs); *(u32x2*)(p + 16) = pack4(acc[ai][bj][m][1] * rs);
                }
            }
    }
};

struct EpiNull {
    static constexpr bool PERM = false, AFTER_DRAIN = false, F16 = false;
    __device__ __forceinline__ void operator()(const f32x4 (&acc)[2][2][4][2], const Unit& u, int wr, int wc, int fr, int fq) const {
#pragma unroll
        for (int ai = 0; ai < 2; ++ai)
#pragma unroll
            for (int bj = 0; bj < 2; ++bj)
#pragma unroll
                for (int m = 0; m < 4; ++m)
#pragma unroll
                    for (int n = 0; n < 2; ++n) asm volatile("" :: "v"(acc[ai][bj][m][n]));
    }
};
template <class Epi, class Sched, bool ALIGN_EPI = false, bool SP2 = false>
__device__ __forceinline__ void gemm_phase(PG8_LAS unsigned char* lds, const Gemm g, const Sched& S, const Epi& E) {
    const int tid = opaque_tid(), wid = __builtin_amdgcn_readfirstlane(tid >> 6), lane = tid & 63, wr = wid >> 2, wc = wid & 3, fr = lane & 15, fq = lane >> 4;
    const int K = g.K, nt = K / BK;
    unsigned voffA[2], voffB[2];
#pragma unroll
    for (int i = 0; i < 2; ++i) { int R, C; stage_rc(tid * 16 + i * 8192, R, C); const int Rb = Epi::PERM ? ((R & ~31) + perm32(R & 31)) : R;
        voffA[i] = (unsigned)(R * K + C) * 2u; voffB[i] = (unsigned)(Rb * K + C) * 2u; }
    const size_t kstep = (size_t)(BK * 2);
    const size_t hstep = (size_t)HALF * K * 2;
    const size_t tstep = 2 * hstep;
    const unsigned ldsw = (unsigned)wid * 1024u;
    const int aoff = lds_byte(wr * 64 + fr, fq * 8), boff = lds_byte(wc * 32 + fr, fq * 8);
#define PG8_SA(b, h) (((b) * 2 + (h)) * HTB)
#define PG8_SB(b, h) ((4 + (b) * 2 + (h)) * HTB)
#define PG8_STAGE(bufoff, gbase, voff) do { _Pragma("unroll") for (int _i = 0; _i < 2; ++_i) \
        __builtin_amdgcn_global_load_lds((const unsigned*)((const char*)(gbase) + (voff)[_i]), (PG8_LAS unsigned*)(lds + (bufoff) + ldsw + _i * 8192), 16, 0, 0); } while (0)
#define PG8_LDA(dst, b, h) do { _Pragma("unroll") for (int m = 0; m < 4; ++m) _Pragma("unroll") for (int k = 0; k < 2; ++k) dst[m][k] = *(const PG8_LAS bf16x8*)(lds + PG8_SA(b, h) + aoff + m * 2048 + k * 1024); } while (0)
#define PG8_LDB(dst, b, h) do { _Pragma("unroll") for (int n = 0; n < 2; ++n) _Pragma("unroll") for (int k = 0; k < 2; ++k) dst[n][k] = *(const PG8_LAS bf16x8*)(lds + PG8_SB(b, h) + boff + n * 2048 + k * 1024); } while (0)
#define PG8_MMA(ai, bj, At, Bt) do { __builtin_amdgcn_s_setprio(1); _Pragma("unroll") for (int m = 0; m < 4; ++m) _Pragma("unroll") for (int n = 0; n < 2; ++n) _Pragma("unroll") for (int k = 0; k < 2; ++k) \
        acc[ai][bj][m][n] = mma16<Epi::F16>(Bt[n][k], At[m][k], acc[ai][bj][m][n]); __builtin_amdgcn_s_setprio(0); } while (0)
#define PG8_WAIT_V(n) asm volatile("s_waitcnt vmcnt(" #n ")" ::: "memory")
#define PG8_WAIT_L(n) asm volatile("s_waitcnt lgkmcnt(" #n ")" ::: "memory")
#define PG8_BAR __builtin_amdgcn_s_barrier()
#define PG8_SCHED __builtin_amdgcn_sched_barrier(0)
    Unit cur, nxt; int ui = 0;
    if (!S.next(0, cur)) return;
    f32x4 acc[2][2][4][2];
#pragma unroll
    for (int a = 0; a < 2; ++a)
#pragma unroll
        for (int b = 0; b < 2; ++b)
#pragma unroll
            for (int m = 0; m < 4; ++m)
#pragma unroll
                for (int n = 0; n < 2; ++n) acc[a][b][m][n] = (f32x4){0.f, 0.f, 0.f, 0.f};
    bf16x8 At[4][2], B0[2][2], B1[2][2];
    const char* cA = (const char*)g.A + (size_t)cur.pm * tstep; const char* cB = (const char*)g.Bt + (size_t)cur.pn * tstep;
    S.a_ready(cur);
    if constexpr (SP2) {
        PG8_STAGE(PG8_SB(0, 0), cB, voffB); PG8_STAGE(PG8_SB(0, 1), cB + hstep, voffB); PG8_STAGE(PG8_SA(0, 0), cA, voffA); PG8_STAGE(PG8_SA(0, 1), cA + hstep, voffA);
        if (wr == 1) PG8_BAR;
        PG8_WAIT_V(2); PG8_BAR;
        PG8_STAGE(PG8_SB(1, 0), cB + kstep, voffB); PG8_STAGE(PG8_SA(1, 0), cA + kstep, voffA); PG8_STAGE(PG8_SB(1, 1), cB + hstep + kstep, voffB);
        PG8_WAIT_V(6); PG8_BAR;
    } else {
        PG8_STAGE(PG8_SB(0, 0), cB, voffB); PG8_STAGE(PG8_SA(0, 0), cA, voffA); PG8_STAGE(PG8_SB(0, 1), cB + hstep, voffB); PG8_STAGE(PG8_SA(0, 1), cA + hstep, voffA);
        if (wr == 1) PG8_BAR;
        PG8_WAIT_V(4); PG8_BAR;
        PG8_STAGE(PG8_SB(1, 0), cB + kstep, voffB); PG8_STAGE(PG8_SA(1, 0), cA + kstep, voffA); PG8_STAGE(PG8_SB(1, 1), cB + hstep + kstep, voffB);
        PG8_WAIT_V(6); PG8_BAR;
    }
    for (;;) {
        const bool has_next = S.next(ui + 1, nxt);
        const char* nA = has_next ? (const char*)g.A + (size_t)nxt.pm * tstep : cA; const char* nB = has_next ? (const char*)g.Bt + (size_t)nxt.pn * tstep : cB;
        for (int t = 0; t < nt; t += 2) {
            const bool last = (t == nt - 2);
            const char* a1 = cA + (size_t)(t + 1) * kstep;
            const char* a2 = last ? nA : cA + (size_t)(t + 2) * kstep; const char* b2 = last ? nB : cB + (size_t)(t + 2) * kstep;
            const char* a3 = a2 + kstep; const char* b3 = b2 + kstep;
            if (last && has_next) S.a_ready(nxt);
            if constexpr (SP2) {
            PG8_LDB(B0, 0, 0); PG8_LDB(B1, 0, 1); PG8_SCHED; PG8_LDA(At, 0, 0); PG8_STAGE(PG8_SA(1, 1), a1 + hstep, voffA);
            PG8_WAIT_V(8); PG8_WAIT_L(0); PG8_BAR; PG8_MMA(0, 0, At, B0); PG8_MMA(0, 1, At, B1); PG8_BAR; PG8_SCHED;
            PG8_LDA(At, 0, 1); PG8_STAGE(PG8_SB(0, 0), b2, voffB); PG8_STAGE(PG8_SB(0, 1), b2 + hstep, voffB); PG8_STAGE(PG8_SA(0, 0), a2, voffA);
            PG8_WAIT_V(8); PG8_WAIT_L(0); PG8_BAR; PG8_MMA(1, 0, At, B0); PG8_MMA(1, 1, At, B1); PG8_BAR; PG8_SCHED;
            PG8_LDB(B0, 1, 0); PG8_LDB(B1, 1, 1); PG8_SCHED; PG8_LDA(At, 1, 0); PG8_STAGE(PG8_SA(0, 1), a2 + hstep, voffA);
            PG8_WAIT_V(8); PG8_WAIT_L(0); PG8_BAR; PG8_MMA(0, 0, At, B0); PG8_MMA(0, 1, At, B1); PG8_BAR; PG8_SCHED;
            PG8_LDA(At, 1, 1); PG8_STAGE(PG8_SB(1, 0), b3, voffB); PG8_STAGE(PG8_SB(1, 1), b3 + hstep, voffB); PG8_STAGE(PG8_SA(1, 0), a3, voffA);
            PG8_WAIT_V(8); PG8_WAIT_L(0); PG8_BAR; PG8_MMA(1, 0, At, B0); PG8_MMA(1, 1, At, B1); PG8_BAR; PG8_SCHED;
            } else {
            PG8_LDB(B0, 0, 0); PG8_SCHED; PG8_LDA(At, 0, 0); PG8_STAGE(PG8_SA(1, 1), a1 + hstep, voffA);
            PG8_WAIT_L(8); PG8_BAR; PG8_WAIT_L(0); PG8_MMA(0, 0, At, B0); PG8_BAR; PG8_SCHED;
            PG8_LDB(B1, 0, 1); PG8_STAGE(PG8_SB(0, 0), b2, voffB);
            PG8_BAR; PG8_WAIT_L(0); PG8_MMA(0, 1, At, B1); PG8_BAR;
            PG8_LDA(At, 0, 1); PG8_STAGE(PG8_SA(0, 0), a2, voffA);
            PG8_BAR; PG8_WAIT_L(0); PG8_MMA(1, 0, At, B0); PG8_BAR; PG8_SCHED;
            PG8_STAGE(PG8_SB(0, 1), b2 + hstep, voffB);
            PG8_WAIT_V(6); PG8_BAR; PG8_MMA(1, 1, At, B1); PG8_BAR;
            PG8_LDB(B0, 1, 0); PG8_SCHED; PG8_LDA(At, 1, 0); PG8_STAGE(PG8_SA(0, 1), a2 + hstep, voffA);
            PG8_WAIT_L(8); PG8_BAR; PG8_WAIT_L(0); PG8_MMA(0, 0, At, B0); PG8_BAR; PG8_SCHED;
            PG8_LDB(B1, 1, 1); PG8_STAGE(PG8_SB(1, 0), b3, voffB);
            PG8_BAR; PG8_WAIT_L(0); PG8_MMA(0, 1, At, B1); PG8_BAR;
            PG8_LDA(At, 1, 1); PG8_STAGE(PG8_SA(1, 0), a3, voffA);
            PG8_BAR; PG8_WAIT_L(0); PG8_MMA(1, 0, At, B0); PG8_BAR; PG8_SCHED;
            PG8_STAGE(PG8_SB(1, 1), b3 + hstep, voffB);
            PG8_WAIT_V(6); PG8_BAR; PG8_MMA(1, 1, At, B1); PG8_BAR;
            }
        }
        if constexpr (ALIGN_EPI) { if (wr == 0) PG8_BAR; }
        if constexpr (!Epi::AFTER_DRAIN) { E(acc, cur, wr, wc, fr, fq); S.done(cur); }
        if (!has_next) break;
#pragma unroll
        for (int a = 0; a < 2; ++a)
#pragma unroll
            for (int b = 0; b < 2; ++b)
#pragma unroll
                for (int m = 0; m < 4; ++m)
#pragma unroll
                    for (int n = 0; n < 2; ++n) acc[a][b][m][n] = (f32x4){0.f, 0.f, 0.f, 0.f};
        cur = nxt; cA = nA; cB = nB; ++ui;
        if constexpr (ALIGN_EPI) { if (wr == 1) PG8_BAR; }
    }
    PG8_WAIT_V(0);
    if constexpr (!ALIGN_EPI) { if (wr == 0) PG8_BAR; }
    PG8_BAR;
    if constexpr (Epi::AFTER_DRAIN) { E.fused(acc, cur, wr, wc, fr, fq, lds, wid, lane); S.done(cur); }
#undef PG8_SA
#undef PG8_SB
#undef PG8_STAGE
#undef PG8_LDA
#undef PG8_LDB
#undef PG8_MMA
#undef PG8_WAIT_V
#undef PG8_WAIT_L
#undef PG8_BAR
#undef PG8_SCHED
}
}
namespace att {
typedef unsigned short bf16_t;
typedef short bf16x8 __attribute__((ext_vector_type(8)));
typedef short s16x4 __attribute__((ext_vector_type(4)));
typedef float f32x16 __attribute__((ext_vector_type(16)));
typedef float f32x4 __attribute__((ext_vector_type(4)));
typedef unsigned u32x4 __attribute__((ext_vector_type(4)));
typedef unsigned u32x2 __attribute__((ext_vector_type(2)));
#define ATT_LAS __attribute__((address_space(3)))
typedef ATT_LAS const char* lds_cptr;
typedef ATT_LAS char* lds_ptr;
constexpr float kLog2e = 1.4426950408889634f;
__device__ __forceinline__ int crow(int r, int hi) { return (r & 3) + 8 * (r >> 2) + 4 * hi; }
__device__ __forceinline__ unsigned cvtpk(float lo, float hi) { unsigned r; asm volatile("v_cvt_pk_bf16_f32 %0, %1, %2" : "=v"(r) : "v"(lo), "v"(hi)); return r; }
__device__ __forceinline__ s16x4 vtr(lds_cptr p) { return __builtin_bit_cast(s16x4, __builtin_amdgcn_ds_read_tr16_b64_v4i16((ATT_LAS s16x4*)p)); }
__device__ __forceinline__ bf16x8 cat8(s16x4 lo, s16x4 hi) { return (bf16x8){lo[0], lo[1], lo[2], lo[3], hi[0], hi[1], hi[2], hi[3]}; }
__device__ __forceinline__ bf16x8 packp(const f32x16& p, int b) {
    u32x4 w; w.x = cvtpk(p[b], p[b + 1]); w.y = cvtpk(p[b + 2], p[b + 3]); w.z = cvtpk(p[b + 4], p[b + 5]); w.w = cvtpk(p[b + 6], p[b + 7]);
    return __builtin_bit_cast(bf16x8, w);
}
__device__ __forceinline__ float max16(const f32x16& p) {
    float a = fmaxf(fmaxf(p[0], p[1]), fmaxf(p[2], p[3])), b = fmaxf(fmaxf(p[4], p[5]), fmaxf(p[6], p[7]));
    float c = fmaxf(fmaxf(p[8], p[9]), fmaxf(p[10], p[11])), d = fmaxf(fmaxf(p[12], p[13]), fmaxf(p[14], p[15]));
    return fmaxf(fmaxf(a, b), fmaxf(c, d));
}
__device__ __forceinline__ float sum16(const f32x16& p) {
    return ((p[0] + p[1]) + (p[2] + p[3])) + ((p[4] + p[5]) + (p[6] + p[7])) + (((p[8] + p[9]) + (p[10] + p[11])) + ((p[12] + p[13]) + (p[14] + p[15])));
}
__device__ __forceinline__ float xmax32(float x) { const auto rr = __builtin_amdgcn_permlane32_swap(__float_as_uint(x), __float_as_uint(x), false, false); return fmaxf(__uint_as_float(rr[0]), __uint_as_float(rr[1])); }
__device__ __forceinline__ float xsum32(float x) { const auto rr = __builtin_amdgcn_permlane32_swap(__float_as_uint(x), __float_as_uint(x), false, false); return __uint_as_float(rr[0]) + __uint_as_float(rr[1]); }
__device__ __forceinline__ float xother32(float x, int hi) { const auto rr = __builtin_amdgcn_permlane32_swap(__float_as_uint(x), __float_as_uint(x), false, false); return hi ? __uint_as_float(rr[0]) : __uint_as_float(rr[1]); }
template <int KEYS> __device__ __forceinline__ void pv_tile(f32x16 (&o)[2], lds_cptr vbase, const bf16x8 (&pf)[KEYS / 16], int lane) {
    const int hi = lane >> 5, li = lane & 15;
    lds_cptr vp = vbase + (4 * hi + (li >> 2)) * 64 + ((lane >> 4) & 1) * 32 + (lane & 3) * 8;
#pragma unroll
    for (int d0 = 0; d0 < 2; ++d0)
#pragma unroll
        for (int ks = 0; ks < KEYS / 16; ++ks) {
            const s16x4 lo = vtr(vp + d0 * (KEYS * 64) + ks * 1024), hh = vtr(vp + d0 * (KEYS * 64) + ks * 1024 + 512);
            o[d0] = __builtin_amdgcn_mfma_f32_32x32x16_bf16(cat8(lo, hh), pf[ks], o[d0], 0, 0, 0);
        }
}
__device__ __forceinline__ void store_o(const f32x16 (&o)[2], float sc, bf16_t* orow, int hi) {
#pragma unroll
    for (int d0 = 0; d0 < 2; ++d0)
#pragma unroll
        for (int g = 0; g < 4; ++g) {
            u32x2 w; w.x = cvtpk(o[d0][4 * g] * sc, o[d0][4 * g + 1] * sc); w.y = cvtpk(o[d0][4 * g + 2] * sc, o[d0][4 * g + 3] * sc);
            *(u32x2*)(orow + d0 * 32 + g * 8 + hi * 4) = w;
        }
}

template <int DK> struct AttL { static constexpr int KS = DK * 2 + 16, KB = 64 * KS, VB = 8192, BUF = KB + VB, TOTAL = 2 * BUF; };
template <int DK, int MODE>
__device__ __forceinline__ void attn_unit(const bf16_t* Q, int ldq, const bf16_t* K, int ldk, const bf16_t* V, int ldv, bf16_t* O, int ldo, int qb, char* shm, float sc) {
    typedef AttL<DK> L;
    constexpr int NS = DK / 16, CPR = DK / 8;
    const int tid = opaque_tid(), lane = tid & 63, r32 = lane & 31, hi = lane >> 5; const int wid = __builtin_amdgcn_readfirstlane(tid >> 6);
    const int qpos = qb * 256 + wid * 32 + r32;
    bf16x8 qf[NS];
#pragma unroll
    for (int s = 0; s < NS; ++s) qf[s] = *(const bf16x8*)(Q + (size_t)qpos * ldq + s * 16 + hi * 8);
    const int kc0 = tid, kkey0 = kc0 / CPR, kch0 = kc0 % CPR;
    const int kc1 = 512 + tid, kkey1 = kc1 / CPR, kch1 = kc1 % CPR; const bool k2 = (DK == 96) && (tid < 256);
    const int vkey = tid >> 3, vch = tid & 7;
    const int voff = (vch >> 2) * 4096 + vkey * 64 + (vch & 3) * 16;
    const int nt = 4 * (qb + 1);
    f32x16 o[2]; o[0] = f32x16{}; o[1] = f32x16{};
    constexpr float SB_SAT = 160.0f; float wminR = 0.f;
    float mrun = -1e30f, lrun = (MODE == 1) ? 1.f : 0.f;
    u32x4 kr0A, kr1A = u32x4{}, vrA, kr0B, kr1B = u32x4{}, vrB;
#define ATT_FETCH(KR0, KR1, VR, tt) do { const size_t kb_ = (size_t)(tt) * 64; \
        KR0 = *(const u32x4*)(K + (kb_ + kkey0) * ldk + kch0 * 8); \
        if (k2) KR1 = *(const u32x4*)(K + (kb_ + kkey1) * ldk + kch1 * 8); \
        VR = *(const u32x4*)(V + (kb_ + vkey) * ldv + vch * 8); } while (0)
#define ATT_TILE(i_) ((MODE == 0) ? (i_) : nt - 1 - (i_))
    ATT_FETCH(kr0A, kr1A, vrA, ATT_TILE(0)); ATT_FETCH(kr0B, kr1B, vrB, ATT_TILE(1));
    bool done = false;
#define ATT_STEP(it, KR0, KR1, VR) { \
        const int tt = ATT_TILE(it); \
        char* buf = shm + ((it) & 1) * L::BUF; \
        *(u32x4*)(buf + kkey0 * L::KS + kch0 * 16) = KR0; \
        if (k2) *(u32x4*)(buf + kkey1 * L::KS + kch1 * 16) = KR1; \
        *(u32x4*)(buf + L::KB + voff) = VR; \
        __syncthreads(); \
        if (MODE == 1 && (it) > 0) { \
            const float* fl = (const float*)(shm + L::TOTAL) + (((it) - 1) & 1) * 8; \
            const float mnr = fminf(fminf(fminf(fl[0], fl[1]), fminf(fl[2], fl[3])), fminf(fminf(fl[4], fl[5]), fminf(fl[6], fl[7]))); \
            if (mnr >= SB_SAT) done = true; \
        } \
        if (!done) { \
        ATT_FETCH(KR0, KR1, VR, ATT_TILE(((it) + 2 < nt) ? (it) + 2 : nt - 1)); \
        att_compute(it, tt, buf); } }
    auto att_compute = [&](int it, int tt, char* buf) __attribute__((always_inline)) {
        const int kbase = tt * 64;
        bool active = !(kbase > qb * 256 + wid * 32 + 31);
        if (MODE == 1) active = active && (wminR < SB_SAT);
        if (active) {
        f32x16 p0 = f32x16{}, p1 = f32x16{};
        const char* kp = buf + r32 * L::KS + hi * 16;
#pragma unroll
        for (int s = 0; s < NS; ++s) {
            const bf16x8 a0 = *(const bf16x8*)(kp + s * 32), a1 = *(const bf16x8*)(kp + 32 * L::KS + s * 32);
            p0 = __builtin_amdgcn_mfma_f32_32x32x16_bf16(a0, qf[s], p0, 0, 0, 0);
            p1 = __builtin_amdgcn_mfma_f32_32x32x16_bf16(a1, qf[s], p1, 0, 0, 0);
        }
        const bool diag = (kbase + 63 >= qb * 256 + wid * 32);
        bf16x8 pf[4];
        if (MODE == 0) {
#pragma unroll
            for (int r = 0; r < 16; ++r) { p0[r] *= sc; p1[r] *= sc; }
            if (diag) {
#pragma unroll
                for (int r = 0; r < 16; ++r) { const int key = kbase + crow(r, hi); if (key > qpos) p0[r] = -INFINITY; if (key + 32 > qpos) p1[r] = -INFINITY; }
            }
            float rm = fmaxf(max16(p0), max16(p1)); rm = xmax32(rm);
            const float mn = fmaxf(mrun, rm), f = __builtin_amdgcn_exp2f(mrun - mn); mrun = mn;
#pragma unroll
            for (int r = 0; r < 16; ++r) { p0[r] = __builtin_amdgcn_exp2f(p0[r] - mn); p1[r] = __builtin_amdgcn_exp2f(p1[r] - mn); }
            lrun = lrun * f + (sum16(p0) + sum16(p1));
#pragma unroll
            for (int r = 0; r < 16; ++r) { o[0][r] *= f; o[1][r] *= f; }
        } else {
            f32x16 om0, om1;
#pragma unroll
            for (int r = 0; r < 16; ++r) {
                const float e0 = __builtin_amdgcn_exp2f(-fmaxf(p0[r] * sc, -100.f)), e1 = __builtin_amdgcn_exp2f(-fmaxf(p1[r] * sc, -100.f));
                const float s0 = __builtin_amdgcn_rcpf(1.0f + e0), s1 = __builtin_amdgcn_rcpf(1.0f + e1);
                om0[r] = e0 * s0; om1[r] = e1 * s1; p0[r] = s0; p1[r] = s1;
            }
            if (diag) {
#pragma unroll
                for (int r = 0; r < 16; ++r) { const int key = kbase + crow(r, hi);
                    if (key >= qpos) { om0[r] = 1.f; p0[r] = 0.f; } if (key + 32 >= qpos) { om1[r] = 1.f; p1[r] = 0.f; } }
            }
            float gs[8], og[8];
#pragma unroll
            for (int g = 0; g < 4; ++g) { gs[g] = (om0[4 * g] * om0[4 * g + 1]) * (om0[4 * g + 2] * om0[4 * g + 3]); gs[4 + g] = (om1[4 * g] * om1[4 * g + 1]) * (om1[4 * g + 2] * om1[4 * g + 3]); }
#pragma unroll
            for (int g = 0; g < 8; ++g) og[g] = xother32(gs[g], hi);
            float suf = lrun;
#pragma unroll
            for (int g = 7; g >= 0; --g) {
                const float T = suf * (hi == 0 ? og[g] : 1.f);
                f32x16& om = (g < 4) ? om0 : om1; f32x16& pp = (g < 4) ? p0 : p1; const int b = 4 * (g & 3);
                const float l3 = T, l2 = l3 * om[b + 3], l1 = l2 * om[b + 2], l0 = l1 * om[b + 1];
                pp[b + 3] *= l3; pp[b + 2] *= l2; pp[b + 1] *= l1; pp[b] *= l0;
                suf *= gs[g] * og[g];
            }
            lrun = suf;
        }
        pf[0] = packp(p0, 0); pf[1] = packp(p0, 8); pf[2] = packp(p1, 0); pf[3] = packp(p1, 8);
        pv_tile<64>(o, (lds_cptr)(buf + L::KB), pf, lane);
        }
        if (MODE == 1) {
            float w = lrun;
#pragma unroll
            for (int sh = 1; sh < 32; sh <<= 1) w = fmaxf(w, __shfl_xor(w, sh));
            w = (w > 0.f) ? 0.f : 1000.f;
            wminR = __builtin_bit_cast(float, __builtin_amdgcn_readfirstlane(__builtin_bit_cast(int, w)));
            if (lane == 0) ((float*)(shm + L::TOTAL))[(it & 1) * 8 + wid] = wminR;
        }
    };
    for (int it = 0; it < nt && !done; it += 2) {
        ATT_STEP(it, kr0A, kr1A, vrA)
        if (done) break;
        ATT_STEP(it + 1, kr0B, kr1B, vrB)
    }
#undef ATT_STEP
#undef ATT_TILE
#undef ATT_FETCH
    float scl = 1.0f;
    if (MODE == 0) { const float lt = xsum32(lrun); scl = 1.0f / lt; }
    store_o(o, scl, O + (size_t)qpos * ldo, hi);
}

__device__ __forceinline__ void sb_unit_big(const bf16_t* Q, const bf16_t* K, const bf16_t* V, int ld, bf16_t* O, int ldo, int qb, char* shm, int maxch) {
    constexpr int KS = 144, KSUB = 64 * KS, KB = 4 * KSUB, VSUB = 8192, BUF = KB + 4 * VSUB, TOTAL = 2 * BUF;
    const int tid = opaque_tid(), lane = tid & 63, r32 = lane & 31, hi = lane >> 5; const int wid = __builtin_amdgcn_readfirstlane(tid >> 6);
    const float sc = 0.125f * kLog2e;
    const int qpos = qb * 256 + wid * 32 + r32;
    bf16x8 qf[4];
#pragma unroll
    for (int s = 0; s < 4; ++s) qf[s] = *(const bf16x8*)(Q + (size_t)qpos * ld + s * 16 + hi * 8);
    const int lkey = tid >> 3, lch = tid & 7;
    const int koff = lkey * KS + lch * 16, voff = KB + (lch >> 2) * 4096 + lkey * 64 + (lch & 3) * 16;
    f32x16 o[2]; o[0] = f32x16{}; o[1] = f32x16{};
    float carry = 1.f; bool wsat = false;
    u32x4 kr[4], vr[4];
#define SBB_FETCH(c) do { const size_t cb_ = (size_t)(c) * 256 + lkey; \
        _Pragma("unroll") for (int i = 0; i < 4; ++i) { kr[i] = *(const u32x4*)(K + (cb_ + 64 * i) * ld + lch * 8); vr[i] = *(const u32x4*)(V + (cb_ + 64 * i) * ld + lch * 8); } } while (0)
    auto sub_compute = [&](int kbase, const char* kt, const char* vt) __attribute__((always_inline)) {
        f32x16 p0 = f32x16{}, p1 = f32x16{};
        const char* kp = kt + r32 * KS + hi * 16;
#pragma unroll
        for (int s = 0; s < 4; ++s) {
            const bf16x8 a0 = *(const bf16x8*)(kp + s * 32), a1 = *(const bf16x8*)(kp + 32 * KS + s * 32);
            p0 = __builtin_amdgcn_mfma_f32_32x32x16_bf16(a0, qf[s], p0, 0, 0, 0);
            p1 = __builtin_amdgcn_mfma_f32_32x32x16_bf16(a1, qf[s], p1, 0, 0, 0);
        }
        f32x16 om0, om1;
#pragma unroll
        for (int r = 0; r < 16; ++r) {
            const float e0 = __builtin_amdgcn_exp2f(-fmaxf(p0[r] * sc, -100.f)), e1 = __builtin_amdgcn_exp2f(-fmaxf(p1[r] * sc, -100.f));
            const float s0 = __builtin_amdgcn_rcpf(1.0f + e0), s1 = __builtin_amdgcn_rcpf(1.0f + e1);
            om0[r] = e0 * s0; om1[r] = e1 * s1; p0[r] = s0; p1[r] = s1;
        }
        if (kbase + 63 >= qb * 256 + wid * 32) {
#pragma unroll
            for (int r = 0; r < 16; ++r) { const int key = kbase + crow(r, hi);
                if (key >= qpos) { om0[r] = 1.f; p0[r] = 0.f; } if (key + 32 >= qpos) { om1[r] = 1.f; p1[r] = 0.f; } }
        }
        float gs[8], og[8];
#pragma unroll
        for (int g = 0; g < 4; ++g) { gs[g] = (om0[4 * g] * om0[4 * g + 1]) * (om0[4 * g + 2] * om0[4 * g + 3]); gs[4 + g] = (om1[4 * g] * om1[4 * g + 1]) * (om1[4 * g + 2] * om1[4 * g + 3]); }
#pragma unroll
        for (int g = 0; g < 8; ++g) og[g] = xother32(gs[g], hi);
        float suf = carry;
#pragma unroll
        for (int g = 7; g >= 0; --g) {
            const float T = suf * (hi == 0 ? og[g] : 1.f);
            f32x16& om = (g < 4) ? om0 : om1; f32x16& pp = (g < 4) ? p0 : p1; const int b = 4 * (g & 3);
            const float l3 = T, l2 = l3 * om[b + 3], l1 = l2 * om[b + 2], l0 = l1 * om[b + 1];
            pp[b + 3] *= l3; pp[b + 2] *= l2; pp[b + 1] *= l1; pp[b] *= l0;
            suf *= gs[g] * og[g];
        }
        carry = suf;
        bf16x8 pf[4]; pf[0] = packp(p0, 0); pf[1] = packp(p0, 8); pf[2] = packp(p1, 0); pf[3] = packp(p1, 8);
        pv_tile<64>(o, (lds_cptr)vt, pf, lane);
        wsat = !__any(carry > 0.f);
    };
    const int nch = (qb + 1 < maxch) ? qb + 1 : maxch;
    SBB_FETCH(qb);
    for (int it = 0; it < nch; ++it) {
        char* buf = shm + (it & 1) * BUF;
#pragma unroll
        for (int i = 0; i < 4; ++i) { *(u32x4*)(buf + i * KSUB + koff) = kr[i]; *(u32x4*)(buf + i * VSUB + voff) = vr[i]; }
        __syncthreads();
        if (it > 0) {
            const float* fl = (const float*)(shm + TOTAL) + ((it - 1) & 1) * 8;
            const float mnr = fminf(fminf(fminf(fl[0], fl[1]), fminf(fl[2], fl[3])), fminf(fminf(fl[4], fl[5]), fminf(fl[6], fl[7])));
            if (mnr > 0.5f) break;
        }
        if (it + 1 < nch) SBB_FETCH(qb - it - 1);
        const int cbase = (qb - it) * 256;
#pragma unroll 1
        for (int sub = 3; sub >= 0; --sub) {
            const int kbase = cbase + 64 * sub;
            if (!(kbase > qb * 256 + wid * 32 + 31) && !wsat) sub_compute(kbase, buf + sub * KSUB, buf + KB + sub * VSUB);
        }
        if (lane == 0) ((float*)(shm + TOTAL))[(it & 1) * 8 + wid] = wsat ? 1.f : 0.f;
    }
#undef SBB_FETCH
    store_o(o, 1.0f, O + (size_t)qpos * ldo, hi);
    __syncthreads();
}

__device__ __forceinline__ void sb_wave_unit(const bf16_t* Q, const bf16_t* K, const bf16_t* V, int ld, bf16_t* O, int ldo, int q0, char* wl, int lane) {
    const int r32 = lane & 31, hi = lane >> 5;
    const float sc = 0.125f * kLog2e;
    const int qpos = q0 + r32;
    bf16x8 qf[4];
#pragma unroll
    for (int s = 0; s < 4; ++s) qf[s] = *(const bf16x8*)(Q + (size_t)qpos * ld + s * 16 + hi * 8);
    f32x16 o[2]; o[0] = f32x16{}; o[1] = f32x16{};
    float carry = 1.f;
#define SBW_LOAD(j, KF, VR) do { const size_t kb_ = (size_t)(j) * 32; \
        _Pragma("unroll") for (int s = 0; s < 4; ++s) KF[s] = *(const bf16x8*)(K + (kb_ + r32) * ld + s * 16 + hi * 8); \
        _Pragma("unroll") for (int c4 = 0; c4 < 4; ++c4) VR[c4] = *(const u32x4*)(V + (kb_ + (lane >> 3) + 8 * c4) * ld + (lane & 7) * 8); } while (0)
#define SBW_TILE(j, KF, VR) do { const int kbase = (j) * 32; \
        asm volatile("s_waitcnt lgkmcnt(0)" ::: "memory"); \
        _Pragma("unroll") for (int c4 = 0; c4 < 4; ++c4) { const int key = (lane >> 3) + 8 * c4, ch = lane & 7; \
            *(u32x4*)(wl + (ch >> 2) * 2048 + key * 64 + (ch & 3) * 16) = VR[c4]; } \
        f32x16 p = f32x16{}; \
        _Pragma("unroll") for (int s = 0; s < 4; ++s) p = __builtin_amdgcn_mfma_f32_32x32x16_bf16(KF[s], qf[s], p, 0, 0, 0); \
        f32x16 om; \
        _Pragma("unroll") for (int r = 0; r < 16; ++r) { \
            const float e = __builtin_amdgcn_exp2f(-fmaxf(p[r] * sc, -100.f)); const float sg = __builtin_amdgcn_rcpf(1.0f + e); \
            om[r] = e * sg; p[r] = sg; } \
        if (kbase + 31 >= q0) { \
            _Pragma("unroll") for (int r = 0; r < 16; ++r) { if (kbase + crow(r, hi) >= qpos) { om[r] = 1.f; p[r] = 0.f; } } } \
        float gs[4], og[4]; \
        _Pragma("unroll") for (int g = 0; g < 4; ++g) gs[g] = (om[4 * g] * om[4 * g + 1]) * (om[4 * g + 2] * om[4 * g + 3]); \
        _Pragma("unroll") for (int g = 0; g < 4; ++g) og[g] = xother32(gs[g], hi); \
        float suf = carry; \
        _Pragma("unroll") for (int g = 3; g >= 0; --g) { \
            const float T = suf * (hi == 0 ? og[g] : 1.f); const int b = 4 * g; \
            const float l3 = T, l2 = l3 * om[b + 3], l1 = l2 * om[b + 2], l0 = l1 * om[b + 1]; \
            p[b + 3] *= l3; p[b + 2] *= l2; p[b + 1] *= l1; p[b] *= l0; \
            suf *= gs[g] * og[g]; } \
        carry = suf; \
        bf16x8 pf[2]; pf[0] = packp(p, 0); pf[1] = packp(p, 8); \
        asm volatile("s_waitcnt lgkmcnt(0)" ::: "memory"); \
        pv_tile<32>(o, (lds_cptr)wl, pf, lane); } while (0)
    bf16x8 kfA[4], kfB[4], kfC[4]; u32x4 vrA[4], vrB[4], vrC[4];
    int j = (q0 + 30) >> 5;
#define SBW_CL(x) ((x) < 0 ? 0 : (x))
    SBW_LOAD(j, kfA, vrA);
    SBW_LOAD(SBW_CL(j - 1), kfB, vrB);
    for (;;) {
        SBW_LOAD(SBW_CL(j - 2), kfC, vrC);
        SBW_TILE(j, kfA, vrA);
        if (j < 1 || !__any(carry > 0.f)) break;
        SBW_LOAD(SBW_CL(j - 3), kfA, vrA);
        SBW_TILE(j - 1, kfB, vrB);
        if (j < 2 || !__any(carry > 0.f)) break;
        SBW_LOAD(SBW_CL(j - 4), kfB, vrB);
        SBW_TILE(j - 2, kfC, vrC);
        if (j < 3 || !__any(carry > 0.f)) break;
        j -= 3;
    }
#undef SBW_CL
#undef SBW_LOAD
#undef SBW_TILE
    asm volatile("s_waitcnt lgkmcnt(0)" ::: "memory");
    store_o(o, 1.0f, O + (size_t)qpos * ldo, hi);
}

__device__ __forceinline__ void dil_unit(const bf16_t* QKV, float* scr, bf16_t* O, int b, int h, int blk, char* shm) {
    const int tid = opaque_tid(), lane = tid & 63, r32 = lane & 31, hi = lane >> 5; const int wid = __builtin_amdgcn_readfirstlane(tid >> 6);
    const int T0 = blk * 512; const size_t rb = (size_t)b * 2048;
    const bf16_t* Qh = QKV + h * 64; const bf16_t* Kh = QKV + 512 + h * 64; const bf16_t* Vh = QKV + 1024 + h * 64;
    const float sc = 0.125f * kLog2e, slope2 = __builtin_amdgcn_exp2f(-(float)(h + 1)) * kLog2e;
    char* wl = shm + wid * 4096;
    float* sO = scr; float* sM = scr + 512 * 64; float* sL = sM + 512;
#pragma unroll 1
    for (int br = 0; br < 3; ++br) {
        const int lg = 2 * br, d = 1 << lg;
        const float sl = slope2 * (float)d;
#pragma unroll 1
        for (int rep = 0; rep < 2; ++rep) {
            const int k = wid + 8 * rep, res = k & (d - 1), c = k >> lg, tq0 = T0 + res + d * 32 * c;
            const int tq = tq0 + d * r32;
            bf16x8 qf[4];
#pragma unroll
            for (int s = 0; s < 4; ++s) qf[s] = *(const bf16x8*)(Qh + (rb + tq) * 1536 + s * 16 + hi * 8);
            f32x16 o[2]; o[0] = f32x16{}; o[1] = f32x16{};
            float mrun = -1e30f, lrun = 0.f;
#define DIL_LOAD(kt, KF, VR) do { int ktv_ = (kt); asm volatile("" : "+s"(ktv_)); const int ik0_ = -128 + 32 * ktv_; \
                int tk_ = tq0 + d * (ik0_ + r32); tk_ = tk_ < 0 ? 0 : tk_; \
                _Pragma("unroll") for (int s = 0; s < 4; ++s) KF[s] = *(const bf16x8*)(Kh + (rb + tk_) * 1536 + s * 16 + hi * 8); \
                _Pragma("unroll") for (int c4 = 0; c4 < 4; ++c4) { const int key_ = (lane >> 3) + 8 * c4; int tv_ = tq0 + d * (ik0_ + key_); tv_ = tv_ < 0 ? 0 : tv_; \
                    VR[c4] = *(const u32x4*)(Vh + (rb + tv_) * 1536 + (lane & 7) * 8); } } while (0)
#define DIL_TILE(kt, KF, VR) do { int ktw_ = (kt); asm volatile("" : "+s"(ktw_)); const int ik0 = -128 + 32 * ktw_; \
                asm volatile("s_waitcnt lgkmcnt(0)" ::: "memory"); \
                _Pragma("unroll") for (int c4 = 0; c4 < 4; ++c4) { const int key = (lane >> 3) + 8 * c4, ch = lane & 7; \
                    *(u32x4*)(wl + (ch >> 2) * 2048 + key * 64 + (ch & 3) * 16) = VR[c4]; } \
                f32x16 p = f32x16{}; \
                _Pragma("unroll") for (int s = 0; s < 4; ++s) p = __builtin_amdgcn_mfma_f32_32x32x16_bf16(KF[s], qf[s], p, 0, 0, 0); \
                _Pragma("unroll") for (int r = 0; r < 16; ++r) { \
                    const int key = crow(r, hi), rel = r32 - (ik0 + key); \
                    const bool valid = (rel >= 0) && (rel <= 128) && (tq0 + d * (ik0 + key) >= 0); \
                    const float s2 = p[r] * sc - sl * (float)rel; \
                    p[r] = valid ? s2 : -INFINITY; } \
                float rm = max16(p); rm = xmax32(rm); \
                const float mn = fmaxf(mrun, rm), f = __builtin_amdgcn_exp2f(mrun - mn); mrun = mn; \
                _Pragma("unroll") for (int r = 0; r < 16; ++r) p[r] = __builtin_amdgcn_exp2f(p[r] - mn); \
                lrun = lrun * f + sum16(p); \
                _Pragma("unroll") for (int r = 0; r < 16; ++r) { o[0][r] *= f; o[1][r] *= f; } \
                bf16x8 pf[2]; pf[0] = packp(p, 0); pf[1] = packp(p, 8); \
                asm volatile("s_waitcnt lgkmcnt(0)" ::: "memory"); \
                pv_tile<32>(o, (lds_cptr)wl, pf, lane); } while (0)
#define DIL_LIVE(kt) (tq0 + d * (-128 + 32 * (kt) + 31) >= 0)
            bf16x8 kfA[4], kfB[4], kfC[4]; u32x4 vrA[4], vrB[4], vrC[4];
            DIL_LOAD(4, kfA, vrA);
            DIL_LOAD(3, kfB, vrB);
            DIL_LOAD(2, kfC, vrC);
            DIL_TILE(4, kfA, vrA);
            if (DIL_LIVE(3)) {
                DIL_LOAD(1, kfA, vrA);
                DIL_TILE(3, kfB, vrB);
                if (DIL_LIVE(2)) {
                    DIL_LOAD(0, kfB, vrB);
                    DIL_TILE(2, kfC, vrC);
                    if (DIL_LIVE(1)) {
                        DIL_TILE(1, kfA, vrA);
                        if (DIL_LIVE(0)) DIL_TILE(0, kfB, vrB);
                    }
                }
            }
#undef DIL_LIVE
#undef DIL_LOAD
#undef DIL_TILE
            float lt = xsum32(lrun);
            const int ti = tq - T0;
            float* so = sO + (size_t)ti * 64;
            if (br > 0) {
                const float ms = sM[ti], ls = sL[ti];
                const float mn = fmaxf(ms, mrun), fs = __builtin_amdgcn_exp2f(ms - mn), fb = __builtin_amdgcn_exp2f(mrun - mn);
                lt = lt * fb + ls * fs; mrun = mn;
#pragma unroll
                for (int d0 = 0; d0 < 2; ++d0)
#pragma unroll
                    for (int g = 0; g < 4; ++g) { const f32x4 st = *(const f32x4*)(so + d0 * 32 + g * 8 + hi * 4);
#pragma unroll
                        for (int j = 0; j < 4; ++j) o[d0][4 * g + j] = o[d0][4 * g + j] * fb + st[j] * fs; }
            }
            if (br < 2) {
#pragma unroll
                for (int d0 = 0; d0 < 2; ++d0)
#pragma unroll
                    for (int g = 0; g < 4; ++g) *(f32x4*)(so + d0 * 32 + g * 8 + hi * 4) = (f32x4){o[d0][4 * g], o[d0][4 * g + 1], o[d0][4 * g + 2], o[d0][4 * g + 3]};
                if (hi == 0) { sM[ti] = mrun; sL[ti] = lt; }
            } else {
                store_o(o, 1.0f / lt, O + (rb + tq) * 1024 + h * 64, hi);
            }
        }
        __threadfence_block();
        __syncthreads();
    }
}
#undef ATT_LAS
}

typedef unsigned short bf16_t;
typedef float f32x4 __attribute__((ext_vector_type(4)));
typedef unsigned u32x4 __attribute__((ext_vector_type(4)));
typedef unsigned u32x2 __attribute__((ext_vector_type(2)));
constexpr int M_TOK = 32768, DM = 1024, DFF = 2816, SEQ = 2048;
constexpr int NTHR = 512;
constexpr size_t MiB = 1u << 20;
constexpr size_t WS_ROPE = 0;
constexpr size_t WS_SS   = 1 * MiB;
constexpr size_t WS_SSQ  = 3 * MiB;
constexpr size_t WS_SSKV = 4 * MiB;
constexpr size_t WS_BAR  = 5 * MiB;
constexpr size_t WS_W    = 8 * MiB;
constexpr size_t SZ_WGU = (size_t)5632 * 1024 * 2, SZ_WD = (size_t)1024 * 2816 * 2;
constexpr size_t WS_WGU0 = WS_W;
constexpr size_t WS_WIN0 = WS_W + 4 * (SZ_WGU + SZ_WD);
constexpr size_t WS_WUQ  = WS_WIN0 + (size_t)2048 * 1024 * 2;
constexpr size_t WS_WUKV = WS_WUQ + (size_t)768 * 256 * 2;
constexpr size_t WS_WOUT0 = WS_WUKV + (size_t)1024 * 128 * 2;
constexpr size_t WS_WIN1 = WS_WOUT0 + (size_t)1024 * 1024 * 2;
constexpr size_t WS_WOUT1 = WS_WIN1 + (size_t)3072 * 1024 * 2;
constexpr size_t WS_WEND = WS_WOUT1 + (size_t)1024 * 1024 * 2;
constexpr size_t WS_XB   = 96 * MiB;
constexpr size_t WS_DIL  = 472 * MiB;
constexpr size_t WS_BIG  = 160 * MiB;
constexpr size_t WS_H    = WS_BIG;
constexpr size_t WS_AQKV = WS_BIG;
constexpr size_t WS_CQ   = WS_AQKV + 96 * MiB;
constexpr size_t WS_CKV  = WS_CQ + 16 * MiB;
constexpr size_t WS_QM   = WS_CKV + 8 * MiB;
constexpr size_t WS_KM   = WS_QM + 48 * MiB;
constexpr size_t WS_VM   = WS_KM + 48 * MiB;
constexpr size_t WS_O0   = WS_VM + 32 * MiB;
constexpr size_t WS_END0 = WS_O0 + 64 * MiB;
constexpr size_t WS_QKV1 = WS_BIG;
constexpr size_t WS_O1   = WS_QKV1 + 192 * MiB;
constexpr size_t WS_END1 = WS_O1 + 64 * MiB;
constexpr size_t WS_NEED = 512 * MiB;
static_assert(WS_WEND <= WS_XB && WS_END0 <= WS_NEED && WS_END1 <= WS_NEED && WS_H + (size_t)M_TOK * DFF * 2 <= WS_NEED, "d_ws map");
constexpr size_t DIL_SCR_BYTES = (512 * 64 + 1024) * 4;
static_assert(WS_DIL >= WS_END0 && WS_DIL + 256 * DIL_SCR_BYTES <= WS_NEED, "dilated state after the layer-0 mixer buffers");
constexpr int LDS_BYTES = 131072 + 18432 + 64;

struct Args {
    const float* x; const float* ffn_norm_g; const float* mix_norm_g; const float* w_gate; const float* w_up; const float* w_down;
    const float* ab_w_in; const float* q_norm_g; const float* w_uq; const float* kv_norm_g; const float* w_ukv; const float* ab_w_out;
    const float* sb_w_in; const float* sb_w_out; const float* final_g; float* out; unsigned char* ws; int ph_lo, ph_hi;
};

__device__ __forceinline__ unsigned f2bf(float f) { unsigned u = __builtin_bit_cast(unsigned, f); return (u + 0x7fffu + ((u >> 16) & 1u)) >> 16; }
__device__ __forceinline__ unsigned pk2(float lo, float hi) { return f2bf(lo) | (f2bf(hi) << 16); }
__device__ __forceinline__ float wave_sum(float v) {
#pragma unroll
    for (int o = 1; o < 64; o <<= 1) v += __shfl_xor(v, o);
    return v;
}
template <int MAP> __device__ __forceinline__ int wrow(int n) {
    if (MAP == 0) return n;
    return (n >> 7) * 256 + (n & 127) + (MAP == 2 ? 128 : 0);
}
__device__ __forceinline__ unsigned pkh2(float lo, float hi) { typedef _Float16 h2_ __attribute__((ext_vector_type(2))); if (!RES_FP16) return pk2(lo, hi); h2_ v = {(_Float16)lo, (_Float16)hi}; return __builtin_bit_cast(unsigned, v); }
template <int MAP, bool F16> __device__ __forceinline__ void tr_item(const float* W, int K, int N, bf16_t* WT, const float* gain, float* scr, int item, int lane) {
    const int nblk = N / 32, kb = item / nblk, nb = item % nblk, k0 = 64 * kb, n0 = 32 * nb;
    float wv[32];
    const float gl = gain ? gain[k0 + lane] : 1.0f;
#pragma unroll
    for (int i = 0; i < 32; ++i) { const int kk = 2 * i + (lane >> 5); wv[i] = W[(size_t)(k0 + kk) * N + n0 + (lane & 31)]; }
#pragma unroll
    for (int i = 0; i < 32; ++i) { const int kk = 2 * i + (lane >> 5);
        const float g0 = __builtin_bit_cast(float, __builtin_amdgcn_readlane(__builtin_bit_cast(int, gl), 2 * i)), g1 = __builtin_bit_cast(float, __builtin_amdgcn_readlane(__builtin_bit_cast(int, gl), 2 * i + 1));
        scr[kk * 33 + (lane & 31)] = wv[i] * ((lane >> 5) ? g1 : g0); }
    asm volatile("s_waitcnt lgkmcnt(0)" ::: "memory");
    const int c = lane & 7;
#pragma unroll
    for (int j = 0; j < 4; ++j) { const int n = (lane >> 3) + 8 * j; const float* s = scr + (8 * c) * 33 + n;
        u32x4 o; if (F16) { o.x = pkh2(s[0 * 33], s[1 * 33]); o.y = pkh2(s[2 * 33], s[3 * 33]); o.z = pkh2(s[4 * 33], s[5 * 33]); o.w = pkh2(s[6 * 33], s[7 * 33]); }
        else { o.x = pk2(s[0 * 33], s[1 * 33]); o.y = pk2(s[2 * 33], s[3 * 33]); o.z = pk2(s[4 * 33], s[5 * 33]); o.w = pk2(s[6 * 33], s[7 * 33]); }
        *(u32x4*)(WT + (size_t)wrow<MAP>(n0 + n) * K + k0 + 8 * c) = o; }
    asm volatile("s_waitcnt lgkmcnt(0)" ::: "memory");
}

struct TrP { const float* W; const float* gain; bf16_t* WT; int K, N, map, item; };
__device__ __forceinline__ void tr_load(const TrP& p, int lane, float (&wv)[32], float& gl) {
    const int nblk = p.N / 32, kb = p.item / nblk, nb = p.item % nblk, k0 = 64 * kb, n0 = 32 * nb;
    gl = p.gain ? p.gain[k0 + lane] : 1.0f;
#pragma unroll
    for (int i = 0; i < 32; ++i) { const int kk = 2 * i + (lane >> 5); wv[i] = p.W[(size_t)(k0 + kk) * p.N + n0 + (lane & 31)]; }
}
__device__ __forceinline__ void tr_store(const TrP& p, int lane, const float (&wv)[32], float gl, float* scr) {
    const int nblk = p.N / 32, kb = p.item / nblk, nb = p.item % nblk, k0 = 64 * kb, n0 = 32 * nb;
#pragma unroll
    for (int i = 0; i < 32; ++i) { const int kk = 2 * i + (lane >> 5);
        const float g0 = __builtin_bit_cast(float, __builtin_amdgcn_readlane(__builtin_bit_cast(int, gl), 2 * i)), g1 = __builtin_bit_cast(float, __builtin_amdgcn_readlane(__builtin_bit_cast(int, gl), 2 * i + 1));
        scr[kk * 33 + (lane & 31)] = wv[i] * ((lane >> 5) ? g1 : g0); }
    asm volatile("s_waitcnt lgkmcnt(0)" ::: "memory");
    const int c = lane & 7;
#pragma unroll
    for (int j = 0; j < 4; ++j) { const int n = (lane >> 3) + 8 * j; const float* s = scr + (8 * c) * 33 + n;
        u32x4 o; o.x = pkh2(s[0 * 33], s[1 * 33]); o.y = pkh2(s[2 * 33], s[3 * 33]); o.z = pkh2(s[4 * 33], s[5 * 33]); o.w = pkh2(s[6 * 33], s[7 * 33]);
        const int nn = n0 + n; const int rowd = (p.map == 0) ? nn : (nn >> 7) * 256 + (nn & 127) + (p.map == 2 ? 128 : 0);
        *(u32x4*)(p.WT + (size_t)rowd * p.K + k0 + 8 * c) = o; }
    asm volatile("s_waitcnt lgkmcnt(0)" ::: "memory");
}

#define LAS __attribute__((address_space(3)))
#define XB_TMO      128
#define XB_XCNT(j)  (256  + 64 * (j))
#define XB_XSUB(j)  (1280 + 64 * (j))
#define XB_XGEN(j)  (2304 + 64 * (j))
#define XB_TOP      3328
#define XB_TOPGEN   3392
#define XCD_BAR_WORDS 3456
#define XB_SPIN_CAP (1u << 18)

__device__ __forceinline__ unsigned xb_ld(unsigned* p)              { return __hip_atomic_load(p, __ATOMIC_RELAXED, __HIP_MEMORY_SCOPE_AGENT); }
__device__ __forceinline__ unsigned xb_add(unsigned* p, unsigned v) { return __hip_atomic_fetch_add(p, v, __ATOMIC_RELAXED, __HIP_MEMORY_SCOPE_AGENT); }
__device__ __forceinline__ unsigned xb_xcc_id() { return (unsigned)__builtin_amdgcn_s_getreg((3 << 11) | 20) & 0xFu; }
#define XB_SPIN(cond, bar) do { unsigned _sp = 0; while (cond) { __builtin_amdgcn_s_sleep(1); \
    if ((++_sp & 255u) == 0u) { if (xb_ld(&(bar)[XB_TMO])) break; if (_sp > XB_SPIN_CAP) { atomicAdd(&(bar)[XB_TMO], 1u); break; } } } } while (0)

struct XcdBarrier {
    unsigned* bar; unsigned x;
    volatile LAS unsigned* st;
};

__device__ __forceinline__ XcdBarrier xcd_barrier_post(unsigned* bar, volatile LAS unsigned* st) {
    XcdBarrier b; b.bar = bar; b.x = xb_xcc_id(); b.st = st;
    if (threadIdx.x == 0) (void)xb_add(&bar[XB_XCNT(b.x)], 1u);
    return b;
}
__device__ __forceinline__ void xcd_barrier_complete(unsigned* bar, unsigned x, unsigned& nloc, unsigned& nx) {
    const unsigned G = gridDim.x * gridDim.y * gridDim.z;
    unsigned sum, cnt, mine, sp = 0u;
    for (;;) {
        sum = 0u; cnt = 0u; mine = 0u;
#pragma unroll
        for (unsigned j = 0; j < 16; ++j) { const unsigned c = xb_ld(&bar[XB_XCNT(j)]); sum += c; cnt += (c > 0u) ? 1u : 0u; mine = (j == x) ? c : mine; }
        if (sum == G) break;
        __builtin_amdgcn_s_sleep(1);
        if ((++sp & 255u) == 0u) { if (xb_ld(&bar[XB_TMO])) break; if (sp > XB_SPIN_CAP) { atomicAdd(&bar[XB_TMO], 1u); break; } }
    }
    nloc = mine > 0u ? mine : 1u; nx = cnt > 0u ? cnt : 1u;
}

__device__ __forceinline__ void xcd_barrier(const XcdBarrier& b) {
    asm volatile("s_waitcnt vmcnt(0)" ::: "memory");
    __syncthreads();
    if (threadIdx.x == 0) {
        unsigned* bar = b.bar;
        __builtin_amdgcn_s_waitcnt(0);
        unsigned nloc = b.st[0], nx = b.st[1];
        if (nloc == 0u) { xcd_barrier_complete(bar, b.x, nloc, nx); b.st[0] = nloc; b.st[1] = nx; }
        const unsigned old = xb_add(&bar[XB_XSUB(b.x)], 1u);
        const unsigned gen = old / nloc;
        if (old + 1u == (gen + 1u) * nloc) {
            __builtin_amdgcn_fence(__ATOMIC_RELEASE, "agent");
            asm volatile("s_waitcnt vmcnt(0)" ::: "memory");
            const unsigned og = xb_add(&bar[XB_TOP], 1u);
            const unsigned tg = og / nx;
            if (og + 1u == (tg + 1u) * nx) xb_add(&bar[XB_TOPGEN], 1u);
            else XB_SPIN(xb_ld(&bar[XB_TOPGEN]) == tg, bar);
            __builtin_amdgcn_fence(__ATOMIC_ACQUIRE, "agent");
            xb_add(&bar[XB_XGEN(b.x)], 1u);
            asm volatile("s_waitcnt vmcnt(0)" ::: "memory");
        } else {
            XB_SPIN(xb_ld(&bar[XB_XGEN(b.x)]) == gen, bar);
            __builtin_amdgcn_fence(__ATOMIC_ACQUIRE, "agent");
            asm volatile("s_waitcnt vmcnt(0)" ::: "memory");
        }
    }
    __syncthreads();
}

__device__ __forceinline__ void grid_bar(unsigned* bar, unsigned nblk, unsigned& gen) {
    asm volatile("s_waitcnt vmcnt(0)" ::: "memory");
    __syncthreads();
    gen += 1u;
    if (threadIdx.x == 0) {
        __builtin_amdgcn_fence(__ATOMIC_RELEASE, "agent");
        asm volatile("s_waitcnt vmcnt(0)" ::: "memory");
        const unsigned target = gen * nblk;
        const unsigned old = __hip_atomic_fetch_add(bar, 1u, __ATOMIC_RELAXED, __HIP_MEMORY_SCOPE_AGENT);
        unsigned* flag = bar + 64;
        if (old + 1u == target) __hip_atomic_store(flag, gen, __ATOMIC_RELAXED, __HIP_MEMORY_SCOPE_AGENT);
        else { unsigned spins = 0; while (__hip_atomic_load(flag, __ATOMIC_RELAXED, __HIP_MEMORY_SCOPE_AGENT) < gen) { __builtin_amdgcn_s_sleep(2); if (++spins > (1u << 24)) break; } }
        __builtin_amdgcn_fence(__ATOMIC_ACQUIRE, "agent");
        asm volatile("s_waitcnt vmcnt(0)" ::: "memory");
    }
    __syncthreads();
}

__global__ void __launch_bounds__(NTHR, 2) mk_fwd(Args a) {
    extern __shared__ __attribute__((aligned(16))) unsigned char lds[];
    cg::grid_group grid = cg::this_grid();
    const int G = gridDim.x, bid = blockIdx.x;
    unsigned char* ws = a.ws;
    float* rope = (float*)(ws + WS_ROPE); float* ss = (float*)(ws + WS_SS); float* ssq = (float*)(ws + WS_SSQ); float* sskv = (float*)(ws + WS_SSKV);
    bf16_t* XB = (bf16_t*)(ws + WS_XB); bf16_t* H = (bf16_t*)(ws + WS_H);
    PG8_LAS unsigned char* glds = (PG8_LAS unsigned char*)lds;
    int ph = 0;
    unsigned* gbar = (unsigned*)(ws + WS_BAR); unsigned gen = 0u; (void)gen;
    volatile LAS unsigned* xst = (volatile LAS unsigned*)((LAS unsigned char*)lds + 131072 + 18432);
    if (threadIdx.x < 2) xst[threadIdx.x] = 0u;
    __syncthreads();
    const XcdBarrier xbar = xcd_barrier_post(gbar, xst);
#ifndef PROBE_REPEAT
#define PROBE_REPEAT -1
#endif
#define PHASE_BEGIN if (ph >= a.ph_lo && ph < a.ph_hi) { for (int rep_ = (ph == PROBE_REPEAT ? 2 : 1); rep_ > 0; --rep_) {
#define PHASE_END(dosync_) } if ((dosync_) && ph + 1 < a.ph_hi) { if (a.ph_lo > 1000000) grid.sync(); xcd_barrier(xbar); } } ++ph;

    PHASE_BEGIN
    {
        const int tid = opaque_tid(), lane = tid & 63, wave = __builtin_amdgcn_readfirstlane(tid >> 6);
        float* scr = (float*)(lds + wave * 16384);
        const int gw = bid * 8 + wave, NGW = G * 8;
        constexpr int I_GU = 16 * 88, I_D = 44 * 32, I_IN0 = 16 * 61, I_UQ = 4 * 24, I_UKV = 2 * 32, I_O = 16 * 32, I_IN1 = 16 * 96;
        constexpr int NITEMS = 4 * (2 * I_GU + I_D) + I_IN0 + I_UQ + I_UKV + I_O + I_IN1 + I_O;
        auto get_item = [&](int it) __attribute__((always_inline)) -> TrP {
            TrP p; int r = it;
            if (r < 4 * (2 * I_GU + I_D)) {
                const int f = r / (2 * I_GU + I_D); r -= f * (2 * I_GU + I_D);
                bf16_t* wgu = (bf16_t*)(ws + WS_WGU0 + f * (SZ_WGU + SZ_WD)); bf16_t* wd = (bf16_t*)(ws + WS_WGU0 + f * (SZ_WGU + SZ_WD) + SZ_WGU);
                const float* g = a.ffn_norm_g + f * 1024;
                if (r < I_GU) p = TrP{a.w_gate + (size_t)f * 1024 * 2816, g, wgu, 1024, 2816, 1, r};
                else if (r < 2 * I_GU) p = TrP{a.w_up + (size_t)f * 1024 * 2816, g, wgu, 1024, 2816, 2, r - I_GU};
                else p = TrP{a.w_down + (size_t)f * 2816 * 1024, nullptr, wd, 2816, 1024, 0, r - 2 * I_GU};
                return p;
            }
            r -= 4 * (2 * I_GU + I_D);
            if (r < I_IN0) return TrP{a.ab_w_in, a.mix_norm_g, (bf16_t*)(ws + WS_WIN0), 1024, 1952, 0, r}; r -= I_IN0;
            if (r < I_UQ) return TrP{a.w_uq, a.q_norm_g, (bf16_t*)(ws + WS_WUQ), 256, 768, 0, r}; r -= I_UQ;
            if (r < I_UKV) return TrP{a.w_ukv, a.kv_norm_g, (bf16_t*)(ws + WS_WUKV), 128, 1024, 0, r}; r -= I_UKV;
            if (r < I_O) return TrP{a.ab_w_out, nullptr, (bf16_t*)(ws + WS_WOUT0), 1024, 1024, 0, r}; r -= I_O;
            if (r < I_IN1) return TrP{a.sb_w_in, a.mix_norm_g + 1024, (bf16_t*)(ws + WS_WIN1), 1024, 3072, 0, r}; r -= I_IN1;
            return TrP{a.sb_w_out, nullptr, (bf16_t*)(ws + WS_WOUT1), 1024, 1024, 0, r};
        };
        if (gw < NITEMS) {
            TrP cur = get_item(gw); float wv[32], gl; tr_load(cur, lane, wv, gl);
            for (int it = gw; it < NITEMS; it += NGW) {
                const int itn = (it + NGW < NITEMS) ? it + NGW : it;
                const TrP nxt = get_item(itn); float wn[32], gn; tr_load(nxt, lane, wn, gn);
                tr_store(cur, lane, wv, gl, scr);
                cur = nxt; gl = gn;
#pragma unroll
                for (int i = 0; i < 32; ++i) wv[i] = wn[i];
            }
        }
        { u32x4* z = (u32x4*)(ws + WS_WIN0 + (size_t)1952 * 1024 * 2); const int nz = 96 * 1024 * 2 / 16;
          for (int i = bid * NTHR + tid; i < nz; i += G * NTHR) z[i] = u32x4{0u, 0u, 0u, 0u}; }
        for (int i = bid * NTHR + tid; i < 2048 * 16; i += G * NTHR) {
            const int pos = i >> 4, fi = i & 15; double inv = 1.0;
            for (int q = 0; q < fi; ++q) inv *= 0.5623413251903491;
            const double rev = (double)pos * inv * 0.15915494309189535; const double fr = rev - (double)(long long)rev;
            const float ang = (float)(fr * 6.283185307179586);
            float sv, cv; sincosf(ang, &sv, &cv);
            rope[pos * 32 + fi] = cv; rope[pos * 32 + 16 + fi] = sv;
        }
        for (int m0 = gw; m0 < M_TOK; m0 += 4 * NGW) {
            f32x4 v[4][4];
#pragma unroll
            for (int q = 0; q < 4; ++q)
#pragma unroll
                for (int j = 0; j < 4; ++j) v[q][j] = ((const f32x4*)(a.x + (size_t)(m0 + q * NGW) * 1024) + lane)[64 * j];
#pragma unroll
            for (int q = 0; q < 4; ++q) { const int m = m0 + q * NGW; float s = 0.f;
                unsigned long long* o8 = (unsigned long long*)(XB + (size_t)m * 1024) + lane;
#pragma unroll
                for (int j = 0; j < 4; ++j) { const f32x4 w = v[q][j]; s += (w[0] * w[0] + w[1] * w[1]) + (w[2] * w[2] + w[3] * w[3]);
                    o8[64 * j] = (unsigned long long)pkh2(w[0], w[1]) | ((unsigned long long)pkh2(w[2], w[3]) << 32); }
                s = wave_sum(s);
                if (lane < 16) ss[(size_t)m * 16 + lane] = (lane == 0) ? s : 0.f; }
        }
        __syncthreads();
    }
    PHASE_END(true)

#define GEMM_PHASE(EPI, E, Aptr, Bptr, Nn, Kk) do { int kk_ = (Kk), nn_ = (Nn); asm volatile("" : "+s"(kk_), "+s"(nn_)); pg8::Gemm g_{(const bf16_t*)(Aptr), (const bf16_t*)(Bptr), M_TOK, nn_, kk_}; pg8::StaticOrder S_; S_.init(M_TOK, nn_, G, bid); \
        pg8::gemm_phase<EPI, pg8::StaticOrder, true, true>(glds, g_, S_, E); } while (0)

#pragma unroll 1
    for (int layer = 0; layer < 2; ++layer) {
#pragma unroll 1
        for (int half = 0; half < 2; ++half) {
            const int f = layer * 2 + half;
            const bf16_t* wgu = (const bf16_t*)(ws + WS_WGU0 + f * (SZ_WGU + SZ_WD)); const bf16_t* wd = (const bf16_t*)(ws + WS_WGU0 + f * (SZ_WGU + SZ_WD) + SZ_WGU);
            PHASE_BEGIN
            { pg8::EpiGU E{ss, H}; GEMM_PHASE(pg8::EpiGU, E, XB, wgu, 5632, 1024); }
            PHASE_END(true)
            PHASE_BEGIN
                        { if (f == 0) { pg8::EpiResidT<true> E{a.x, XB, ss, (rep_ == 2) ? 0.f : 0.5f, (float*)(lds + 131072)}; GEMM_PHASE(pg8::EpiResidT<true>, E, H, wd, 1024, 2816); }
              else { pg8::EpiResidT<false> E{a.x, XB, ss, (rep_ == 2) ? 0.f : 0.5f, (float*)(lds + 131072)}; GEMM_PHASE(pg8::EpiResidT<false>, E, H, wd, 1024, 2816); } }
            PHASE_END(true)
            if (half == 1) continue;
            if (layer == 0) {
                bf16_t* AQKV = (bf16_t*)(ws + WS_AQKV); bf16_t* CQ = (bf16_t*)(ws + WS_CQ); bf16_t* CKV = (bf16_t*)(ws + WS_CKV);
                bf16_t* QM = (bf16_t*)(ws + WS_QM); bf16_t* KM = (bf16_t*)(ws + WS_KM); bf16_t* VM = (bf16_t*)(ws + WS_VM); bf16_t* O0 = (bf16_t*)(ws + WS_O0);
                PHASE_BEGIN
                { pg8::EpiInAB E{ss, AQKV, CQ, CKV, KM, ssq, sskv, rope}; GEMM_PHASE(pg8::EpiInAB, E, XB, ws + WS_WIN0, 2048, 1024); }
                PHASE_END(true)
                PHASE_BEGIN
                { pg8::EpiUQ E{ssq, QM, rope}; GEMM_PHASE(pg8::EpiUQ, E, CQ, ws + WS_WUQ, 768, 256); }
                { pg8::EpiUKV E{sskv, KM, VM}; GEMM_PHASE(pg8::EpiUKV, E, CKV, ws + WS_WUKV, 1024, 128); }
                __syncthreads();
                for (int u = bid; u < 512; u += G) {
                    const int blk = u & 3, h = (u >> 2) & 7, b = u >> 5;
                    att::dil_unit(AQKV, (float*)(ws + WS_DIL + (size_t)bid * DIL_SCR_BYTES), O0, b, h, blk, (char*)lds);
                }
                PHASE_END(true)
                PHASE_BEGIN
                for (int i = 0; i < 4; ++i) {
                    const int v = bid + i * G; if (v >= 1024) break;
                    const int c = v & 255, rnd = v >> 8, bh = c >> 1, s = c & 1;
                    const int qb = (rnd == 0) ? s : (rnd == 1) ? 7 - s : (rnd == 2) ? 2 + s : 5 - s;
                    const int b = bh >> 3, h = bh & 7; const size_t rb = (size_t)b * 2048;
                    att::attn_unit<96, 0>(QM + rb * 768 + h * 96, 768, KM + rb * 768 + h * 96, 768, VM + rb * 512 + h * 64, 512, O0 + rb * 1024 + 512 + h * 64, 1024, qb, (char*)lds,
                                          0.10206207261596575f * att::kLog2e);
                }
                __syncthreads();
                PHASE_END(true)
                PHASE_BEGIN
                { pg8::EpiResidT<false> E{a.x, XB, ss, (rep_ == 2) ? 0.f : 1.0f, (float*)(lds + 131072)}; GEMM_PHASE(pg8::EpiResidT<false>, E, O0, ws + WS_WOUT0, 1024, 1024); }
                PHASE_END(true)
            } else {
                bf16_t* QKV = (bf16_t*)(ws + WS_QKV1); bf16_t* O1 = (bf16_t*)(ws + WS_O1);
                PHASE_BEGIN
                { pg8::EpiScale E{ss, QKV, 3072}; GEMM_PHASE(pg8::EpiScale, E, XB, ws + WS_WIN1, 3072, 1024); }
                PHASE_END(true)
                PHASE_BEGIN
                {
                    const int tid = opaque_tid(), lane = tid & 63, wave = __builtin_amdgcn_readfirstlane(tid >> 6);
                    for (int bh = bid; bh < 256; bh += G) {
                        const int b = bh >> 4, h = bh & 15; const size_t rb = (size_t)b * 2048;
                        for (int rnd = 7; rnd >= 0; --rnd)
                            att::sb_wave_unit(QKV + rb * 3072 + h * 64, QKV + rb * 3072 + 1024 + h * 64, QKV + rb * 3072 + 2048 + h * 64, 3072, O1 + rb * 1024 + h * 64, 1024, (rnd * 8 + wave) * 32, (char*)lds + wave * 4096, lane);
                    }
                }
                __syncthreads();
                PHASE_END(true)
                PHASE_BEGIN
                { pg8::EpiResidT<false> E{a.x, XB, ss, (rep_ == 2) ? 0.f : 1.0f, (float*)(lds + 131072)}; GEMM_PHASE(pg8::EpiResidT<false>, E, O1, ws + WS_WOUT1, 1024, 1024); }
                PHASE_END(true)
            }
        }
    }
    PHASE_BEGIN
    {
        const int tid = opaque_tid(), lane = tid & 63, wave = __builtin_amdgcn_readfirstlane(tid >> 6);
        const int gw = bid * 8 + wave, NGW = G * 8;
        f32x4 gv[4];
#pragma unroll
        for (int j = 0; j < 4; ++j) gv[j] = ((const f32x4*)a.final_g + lane)[64 * j];
        for (int m0 = gw; m0 < M_TOK; m0 += 4 * NGW) {
            u32x2 v[4][4]; float sq[4];
#pragma unroll
            for (int q = 0; q < 4; ++q) { const int m = m0 + q * NGW; sq[q] = (lane < 16) ? ss[(size_t)m * 16 + lane] : 0.f;
#pragma unroll
                for (int j = 0; j < 4; ++j) v[q][j] = ((const u32x2*)(XB + (size_t)m * 1024) + lane)[64 * j]; }
#pragma unroll
            for (int q = 0; q < 4; ++q) { const int m = m0 + q * NGW; const float rs = __builtin_amdgcn_rsqf(wave_sum(sq[q]) * (1.0f / 1024.0f) + 1e-6f);
                f32x4* xr = (f32x4*)(a.out + (size_t)m * 1024) + lane;
#pragma unroll
                for (int j = 0; j < 4; ++j) xr[64 * j] = pg8::unpk4h(v[q][j]) * rs * gv[j]; }
        }
    }
    PHASE_END(false)
#undef PHASE_BEGIN
#undef PHASE_END
#undef GEMM_PHASE
}

extern "C" void kernel_launch(void* const* d_in, const int* in_sizes, int n_in, void* d_out, int out_size, void* d_ws, size_t ws_size, hipStream_t stream) {
    static int grid = 0;
    if (grid == 0) {
        if (n_in != 15 || in_sizes[0] != M_TOK * DM || out_size != M_TOK * DM || ws_size < WS_NEED) {
            fprintf(stderr, "kernel_launch: unexpected shapes (n_in %d in0 %d out %d ws %zu)\n", n_in, n_in > 0 ? in_sizes[0] : -1, out_size, ws_size); grid = -1; return; }
        int dev = 0, cus = 0, per_cu = 0;
        (void)hipGetDevice(&dev); (void)hipDeviceGetAttribute(&cus, hipDeviceAttributeMultiprocessorCount, dev);
        if (hipFuncSetAttribute((const void*)mk_fwd, hipFuncAttributeMaxDynamicSharedMemorySize, LDS_BYTES) != hipSuccess) { fprintf(stderr, "kernel_launch: hipFuncSetAttribute failed\n"); grid = -1; return; }
        if (hipOccupancyMaxActiveBlocksPerMultiprocessor(&per_cu, (const void*)mk_fwd, NTHR, LDS_BYTES) != hipSuccess || per_cu < 1) { fprintf(stderr, "kernel_launch: occupancy query failed (%d)\n", per_cu); per_cu = 1; }
        (void)hipGetLastError();
        grid = cus * 1;
        if (grid <= 0) grid = 256;
    }
    if (grid < 0) return;
    Args a{};
    a.x = (const float*)d_in[0]; a.ffn_norm_g = (const float*)d_in[1]; a.mix_norm_g = (const float*)d_in[2]; a.w_gate = (const float*)d_in[3]; a.w_up = (const float*)d_in[4]; a.w_down = (const float*)d_in[5];
    a.ab_w_in = (const float*)d_in[6]; a.q_norm_g = (const float*)d_in[7]; a.w_uq = (const float*)d_in[8]; a.kv_norm_g = (const float*)d_in[9]; a.w_ukv = (const float*)d_in[10]; a.ab_w_out = (const float*)d_in[11];
    a.sb_w_in = (const float*)d_in[12]; a.sb_w_out = (const float*)d_in[13]; a.final_g = (const float*)d_in[14]; a.out = (float*)d_out; a.ws = (unsigned char*)d_ws;
    a.ph_lo = 0; a.ph_hi = 1000;
    if (hipMemsetAsync((char*)d_ws + WS_BAR, 0, 16384, stream) != hipSuccess) { fprintf(stderr, "kernel_launch: memset of the barrier words failed\n"); return; }
    void* args[] = {&a};
    hipError_t e = hipLaunchCooperativeKernel((const void*)mk_fwd, dim3(grid), dim3(NTHR), args, LDS_BYTES, stream);
    if (e != hipSuccess) fprintf(stderr, "kernel_launch: cooperative launch failed: %s (grid %d)\n", hipGetErrorString(e), grid);
}
```

```cpp
#include <hip/hip_runtime.h>
#include <hip/hip_cooperative_groups.h>
#include <cstdio>
#include <cstdint>
namespace cg = cooperative_groups;

__device__ __forceinline__ int opaque_tid() { int t = threadIdx.x; asm volatile("" : "+v"(t)); return t; }
namespace pg8 {
#define PG8_LAS __attribute__((address_space(3)))
typedef unsigned short bf16_t;
typedef short bf16x8 __attribute__((ext_vector_type(8)));
typedef float f32x4 __attribute__((ext_vector_type(4)));
typedef unsigned u32x4 __attribute__((ext_vector_type(4)));
constexpr int BM = 256, BK = 64, HALF = 128, HTB = HALF * BK * 2  , STAGE_BYTES = 8 * HTB, NXCD = 8, WGM = 8;

__host__ __device__ __forceinline__ int lds_byte(int r, int c) { const int st = (r >> 4) * 2 + (c >> 5), rr = r & 15, cc = c & 31, ob = rr * 64 + cc * 2; return st * 1024 + (ob ^ (((ob >> 9) & 1) << 5)); }
__host__ __device__ __forceinline__ void stage_rc(int b, int& R, int& C) { const int st = b / 1024, sb = b % 1024, swz = sb ^ (((sb >> 9) & 1) << 5); R = (st >> 1) * 16 + swz / 64; C = (st & 1) * 32 + (swz % 64) / 2; }
__host__ __device__ __forceinline__ int perm32(int rho) { const int n = rho >> 4, i = rho & 15; return 8 * (i >> 2) + 4 * n + (i & 3); }

struct Unit { int pm, pn; };
struct Gemm { const bf16_t* A; const bf16_t* Bt; int M, N, K; };

struct StaticOrder {
    int nM, nN, nwg, G, c;
    __host__ __device__ void init(int M, int N, int G_, int c_) { nM = M / BM; nN = N / BM; nwg = nM * nN; G = G_; c = c_; }
    __host__ __device__ bool next(int i, Unit& u) const {
        const long L = (long)i * G + c; if (L >= nwg) return false;
        int wgid = (int)L; { const int q = nwg / NXCD, r = nwg % NXCD, xcd = wgid % NXCD, off = wgid / NXCD; wgid = (xcd < r ? xcd * (q + 1) : r * (q + 1) + (xcd - r) * q) + off; }
        const int nig = WGM * nN, gid = wgid / nig, fm = gid * WGM, gsz = (nM - fm) < WGM ? (nM - fm) : WGM;
        u.pm = fm + ((wgid % nig) % gsz); u.pn = (wgid % nig) / gsz; return true;
    }
    __device__ __forceinline__ void a_ready(const Unit&) const {}
    __device__ __forceinline__ void done(const Unit&) const {}
};

__device__ __forceinline__ unsigned cvt_pk_bf16(float lo, float hi) { unsigned r; asm volatile("v_cvt_pk_bf16_f32 %0, %1, %2" : "=v"(r) : "v"(lo), "v"(hi)); return r; }
typedef unsigned u32x2 __attribute__((ext_vector_type(2)));
constexpr float kEps = 1e-6f;
typedef _Float16 f16x8 __attribute__((ext_vector_type(8)));
typedef _Float16 f16x2 __attribute__((ext_vector_type(2)));
template <bool F16> __device__ __forceinline__ f32x4 mma16(bf16x8 a, bf16x8 b, f32x4 c) {
    if (F16) return __builtin_amdgcn_mfma_f32_16x16x32_f16(__builtin_bit_cast(f16x8, a), __builtin_bit_cast(f16x8, b), c, 0, 0, 0);
    return __builtin_amdgcn_mfma_f32_16x16x32_bf16(a, b, c, 0, 0, 0);
}
#ifndef RES_FP16
#define RES_FP16 0
#endif
__device__ __forceinline__ unsigned pkh(float lo, float hi) { if (!RES_FP16) return cvt_pk_bf16(lo, hi); f16x2 v = {(_Float16)lo, (_Float16)hi}; return __builtin_bit_cast(unsigned, v); }
__device__ __forceinline__ f32x4 unpk4h(u32x2 w) { if (!RES_FP16) return (f32x4){__builtin_bit_cast(float, w.x << 16), __builtin_bit_cast(float, w.x & 0xffff0000u), __builtin_bit_cast(float, w.y << 16), __builtin_bit_cast(float, w.y & 0xffff0000u)}; const f16x2 a = __builtin_bit_cast(f16x2, w.x), b = __builtin_bit_cast(f16x2, w.y); return (f32x4){(float)a[0], (float)a[1], (float)b[0], (float)b[1]}; }

constexpr float kLog2e = 1.4426950408889634f;
__device__ __forceinline__ u32x2 pack4(const f32x4 v) { u32x2 w; w.x = cvt_pk_bf16(v[0], v[1]); w.y = cvt_pk_bf16(v[2], v[3]); return w; }
template <int NP> __device__ __forceinline__ float row_rstd(const float* ss, int row, float inv_n) {
    float s = 0.f;
#pragma unroll
    for (int i = 0; i < NP / 4; ++i) { const f32x4 v = *(const f32x4*)(ss + (size_t)row * NP + 4 * i); s += (v[0] + v[1]) + (v[2] + v[3]); }
    return __builtin_amdgcn_rsqf(s * inv_n + kEps);
}
__device__ __forceinline__ float quad_sum(float s) {
    const auto a = __builtin_amdgcn_permlane16_swap(__float_as_uint(s), __float_as_uint(s), false, false); s = __uint_as_float(a[0]) + __uint_as_float(a[1]);
    const auto b = __builtin_amdgcn_permlane32_swap(__float_as_uint(s), __float_as_uint(s), false, false); return __uint_as_float(b[0]) + __uint_as_float(b[1]);
}
__device__ __forceinline__ float dpp_f(float v, int ctrl_sel) {
    const int x = __float_as_int(v);
    const int r = ctrl_sel == 0 ? __builtin_amdgcn_update_dpp(0, x, 0xB1, 0xF, 0xF, true) : ctrl_sel == 1 ? __builtin_amdgcn_update_dpp(0, x, 0x4E, 0xF, 0xF, true) : __builtin_amdgcn_update_dpp(0, x, 0x104, 0xF, 0xF, true);
    return __int_as_float(r);
}


template <int NP> __device__ __forceinline__ void load_rstd8(const float* ss, const Unit& u, int wr, int fr, int fq, float inv_n, float (&rs)[2][4]) {
    f32x4 v[2][4];
#pragma unroll
    for (int ai = 0; ai < 2; ++ai)
#pragma unroll
        for (int m = 0; m < 4; ++m) { const int row = u.pm * BM + ai * HALF + wr * 64 + m * 16 + fr; v[ai][m] = *(const f32x4*)(ss + (size_t)row * NP + (NP == 16 ? 4 * fq : 0)); }
#pragma unroll
    for (int ai = 0; ai < 2; ++ai)
#pragma unroll
        for (int m = 0; m < 4; ++m) { float t = (v[ai][m][0] + v[ai][m][1]) + (v[ai][m][2] + v[ai][m][3]); if (NP == 16) t = quad_sum(t); rs[ai][m] = __builtin_amdgcn_rsqf(t * inv_n + kEps); }
}

struct EpiGU {
    static constexpr bool PERM = true, AFTER_DRAIN = false, F16 = (RES_FP16 != 0);
    const float* ss; bf16_t* H;
    __device__ __forceinline__ void operator()(const f32x4 (&acc)[2][2][4][2], const Unit& u, int wr, int wc, int fr, int fq) const {
        float rsv[2][4]; load_rstd8<16>(ss, u, wr, fr, fq, 1.0f / 1024.0f, rsv);
        typedef unsigned u32x4_ __attribute__((ext_vector_type(4)));
#pragma unroll
        for (int ai = 0; ai < 2; ++ai)
#pragma unroll
            for (int m = 0; m < 4; ++m) {
                const int row = u.pm * BM + ai * HALF + wr * 64 + m * 16 + fr;
                const float rs = rsv[ai][m];
                u32x2 w[2];
#pragma unroll
                for (int n = 0; n < 2; ++n) {
                    const f32x4 g = acc[ai][0][m][n] * rs, up = acc[ai][1][m][n] * rs; f32x4 o;
#pragma unroll
                    for (int j = 0; j < 4; ++j) { const float e = __builtin_amdgcn_exp2f(-g[j] * kLog2e); o[j] = g[j] * up[j] * __builtin_amdgcn_rcpf(1.0f + e); }
                    w[n] = pack4(o);
                }
                *(u32x4_*)(H + (size_t)row * 2816 + u.pn * 128 + wc * 32 + fq * 8) = (u32x4_){w[0].x, w[0].y, w[1].x, w[1].y};
            }
    }
};
template <bool SRC32> struct EpiResidT {
    static constexpr bool PERM = false, AFTER_DRAIN = false, F16 = false;
    const float* x32; bf16_t* X16; float* ss; float alpha; float* wlds;
    __device__ __forceinline__ void operator()(const f32x4 (&acc)[2][2][4][2], const Unit& u, int wr, int wc, int fr, int fq) const {
        float* wl = wlds + (wr * 4 + wc) * 576;
        const int lane = fq * 16 + fr, rl = lane >> 3, ch = lane & 7;
        f32x4 rb[2][2][2][2];
        const size_t cbase = (size_t)u.pn * BM + wc * 32 + ch * 4;
#define RES_LOAD(buf, b) do { _Pragma("unroll") for (int gg = 0; gg < 2; ++gg) { const int g_ = 2 * (b) + gg; const int row0_ = u.pm * BM + (g_ >> 2) * HALF + wr * 64 + (g_ & 3) * 16 + rl; \
            _Pragma("unroll") for (int bj = 0; bj < 2; ++bj) _Pragma("unroll") for (int i = 0; i < 2; ++i) { const size_t o_ = (size_t)(row0_ + 8 * i) * 1024 + cbase + bj * HALF; \
                if (SRC32) rb[buf][gg][bj][i] = *(const f32x4*)(x32 + o_); else rb[buf][gg][bj][i] = unpk4h(*(const u32x2*)(X16 + o_)); } } } while (0)
        RES_LOAD(0, 0);
#pragma unroll
        for (int b = 0; b < 4; ++b) {
            if (b + 1 < 4) RES_LOAD((b + 1) & 1, b + 1);
#pragma unroll
            for (int gg = 0; gg < 2; ++gg) {
                const int g = 2 * b + gg, ai = g >> 2, m = g & 3;
                const int row0 = u.pm * BM + ai * HALF + wr * 64 + m * 16 + rl;
                float sq[2] = {0.f, 0.f};
#pragma unroll
                for (int bj = 0; bj < 2; ++bj) {
                    *(f32x4*)(wl + fr * 36 + fq * 4) = acc[ai][bj][m][0] * alpha; *(f32x4*)(wl + fr * 36 + 16 + fq * 4) = acc[ai][bj][m][1] * alpha;
                    asm volatile("s_waitcnt lgkmcnt(0)" ::: "memory");
#pragma unroll
                    for (int i = 0; i < 2; ++i) {
                        const f32x4 x = rb[b & 1][gg][bj][i] + *(const f32x4*)(wl + (rl + 8 * i) * 36 + ch * 4);
                        const size_t off = (size_t)(row0 + 8 * i) * 1024 + cbase + bj * HALF;
                        u32x2 w; w.x = pkh(x[0], x[1]); w.y = pkh(x[2], x[3]); *(u32x2*)(X16 + off) = w;
                        sq[i] += (x[0] * x[0] + x[1] * x[1]) + (x[2] * x[2] + x[3] * x[3]);
                    }
                    asm volatile("s_waitcnt lgkmcnt(0)" ::: "memory");
                }
#pragma unroll
                for (int i = 0; i < 2; ++i) { float t = sq[i]; t += dpp_f(t, 0); t += dpp_f(t, 1); t += dpp_f(t, 2);
                    if (ch == 0) ss[(size_t)(row0 + 8 * i) * 16 + u.pn * 4 + wc] = t; }
            }
        }
#undef RES_LOAD
    }
};
struct EpiScale {
    static constexpr bool PERM = true, AFTER_DRAIN = false, F16 = (RES_FP16 != 0);
    const float* ss; bf16_t* O; int ldc;
    __device__ __forceinline__ void operator()(const f32x4 (&acc)[2][2][4][2], const Unit& u, int wr, int wc, int fr, int fq) const {
        float rsv[2][4]; load_rstd8<16>(ss, u, wr, fr, fq, 1.0f / 1024.0f, rsv);
        typedef unsigned u32x4_ __attribute__((ext_vector_type(4)));
#pragma unroll
        for (int ai = 0; ai < 2; ++ai)
#pragma unroll
            for (int m = 0; m < 4; ++m) {
                const int row = u.pm * BM + ai * HALF + wr * 64 + m * 16 + fr;
                const float rs = rsv[ai][m];
#pragma unroll
                for (int bj = 0; bj < 2; ++bj) {
                    const u32x2 lo = pack4(acc[ai][bj][m][0] * rs), hi = pack4(acc[ai][bj][m][1] * rs);
                    *(u32x4_*)(O + (size_t)row * ldc + u.pn * BM + bj * HALF + wc * 32 + fq * 8) = (u32x4_){lo.x, lo.y, hi.x, hi.y};
                }
            }
    }
};
struct EpiInAB {
    static constexpr bool PERM = false, AFTER_DRAIN = false, F16 = (RES_FP16 != 0);
    const float* ss; bf16_t* AQKV; bf16_t* CQ; bf16_t* CKV; bf16_t* KM; float* ssq; float* sskv; const float* rope;
    __device__ __forceinline__ void operator()(const f32x4 (&acc)[2][2][4][2], const Unit& u, int wr, int wc, int fr, int fq) const {
        float rsv[2][4]; load_rstd8<16>(ss, u, wr, fr, fq, 1.0f / 1024.0f, rsv);
#pragma unroll
        for (int ai = 0; ai < 2; ++ai)
#pragma unroll
            for (int m = 0; m < 4; ++m) {
                asm volatile("" ::: "memory"); const int row = u.pm * BM + ai * HALF + wr * 64 + m * 16 + fr;
                const float rs = rsv[ai][m];
                if (u.pn < 6) {
#pragma unroll
                    for (int bj = 0; bj < 2; ++bj)
#pragma unroll
                        for (int n = 0; n < 2; ++n)
                            *(u32x2*)(AQKV + (size_t)row * 1536 + u.pn * BM + bj * HALF + wc * 32 + n * 16 + fq * 4) = pack4(acc[ai][bj][m][n] * rs);
                } else if (u.pn == 6) {
                    float s = 0.f;
#pragma unroll
                    for (int bj = 0; bj < 2; ++bj)
#pragma unroll
                        for (int n = 0; n < 2; ++n) { const f32x4 x = acc[ai][bj][m][n] * rs;
                            *(u32x2*)(CQ + (size_t)row * 256 + bj * HALF + wc * 32 + n * 16 + fq * 4) = pack4(x);
                            s += (x[0] * x[0] + x[1] * x[1]) + (x[2] * x[2] + x[3] * x[3]); }
                    s = quad_sum(s);
                    if (fq == 0) ssq[(size_t)row * 4 + wc] = s;
                } else {
                    float s = 0.f;
#pragma unroll
                    for (int n = 0; n < 2; ++n) { const f32x4 x = acc[ai][0][m][n] * rs;
                        *(u32x2*)(CKV + (size_t)row * 128 + wc * 32 + n * 16 + fq * 4) = pack4(x);
                        s += (x[0] * x[0] + x[1] * x[1]) + (x[2] * x[2] + x[3] * x[3]); }
                    s = quad_sum(s);
                    if (fq == 0) sskv[(size_t)row * 4 + wc] = s;
                    if (wc == 0) {
                        const f32x4 x1 = acc[ai][1][m][0] * rs, x2 = acc[ai][1][m][1] * rs;
                        const int pos = row & 2047;
                        const f32x4 c = *(const f32x4*)(rope + pos * 32 + fq * 4), sn = *(const f32x4*)(rope + pos * 32 + 16 + fq * 4);
                        const u32x2 o1 = pack4(x1 * c - x2 * sn), o2 = pack4(x1 * sn + x2 * c);
#pragma unroll
                        for (int h = 0; h < 8; ++h) { bf16_t* kp = KM + (size_t)row * 768 + h * 96 + 64 + fq * 4; *(u32x2*)kp = o1; *(u32x2*)(kp + 16) = o2; }
                    }
                }
            }
    }
};
struct EpiUQ {
    static constexpr bool PERM = false, AFTER_DRAIN = false, F16 = false;
    const float* ssq; bf16_t* Q; const float* rope;
    __device__ __forceinline__ void operator()(const f32x4 (&acc)[2][2][4][2], const Unit& u, int wr, int wc, int fr, int fq) const {
        float rsv[2][4]; load_rstd8<4>(ssq, u, wr, fr, fq, 1.0f / 256.0f, rsv);
        f32x4 rc[2][4], rsn[2][4];
#pragma unroll
        for (int ai = 0; ai < 2; ++ai)
#pragma unroll
            for (int m = 0; m < 4; ++m) { const int pos = (u.pm * BM + ai * HALF + wr * 64 + m * 16 + fr) & 2047;
                rc[ai][m] = *(const f32x4*)(rope + pos * 32 + fq * 4); rsn[ai][m] = *(const f32x4*)(rope + pos * 32 + 16 + fq * 4); }
#pragma unroll
        for (int ai = 0; ai < 2; ++ai)
#pragma unroll
            for (int m = 0; m < 4; ++m) {
                const int row = u.pm * BM + ai * HALF + wr * 64 + m * 16 + fr;
                const float rs = rsv[ai][m];
#pragma unroll
                for (int bj = 0; bj < 2; ++bj) {
                    const int cb = u.pn * BM + bj * HALF + wc * 32;
                    f32x4 x1 = acc[ai][bj][m][0] * rs, x2 = acc[ai][bj][m][1] * rs;
                    if ((cb % 96) == 64) { const f32x4 c = rc[ai][m], sn = rsn[ai][m]; const f32x4 y1 = x1 * c - x2 * sn, y2 = x1 * sn + x2 * c; x1 = y1; x2 = y2; }
                    bf16_t* qp = Q + (size_t)row * 768 + cb + fq * 4; *(u32x2*)qp = pack4(x1); *(u32x2*)(qp + 16) = pack4(x2);
                }
            }
    }
};
struct EpiUKV {
    static constexpr bool PERM = false, AFTER_DRAIN = false, F16 = false;
    const float* sskv; bf16_t* KM; bf16_t* VM;
    __device__ __forceinline__ void operator()(const f32x4 (&acc)[2][2][4][2], const Unit& u, int wr, int wc, int fr, int fq) const {
        float rsv[2][4]; load_rstd8<4>(sskv, u, wr, fr, fq, 1.0f / 128.0f, rsv);
#pragma unroll
        for (int ai = 0; ai < 2; ++ai)
#pragma unroll
            for (int m = 0; m < 4; ++m) {
                asm volatile("" ::: "memory"); const int row = u.pm * BM + ai * HALF + wr * 64 + m * 16 + fr;
                const float rs = rsv[ai][m];
#pragma unroll
                for (int bj = 0; bj < 2; ++bj) {
                    const int cb = u.pn * BM + bj * HALF + wc * 32, h = cb >> 7, w = cb & 127;
                    bf16_t* p = (w < 64) ? (KM + (size_t)row * 768 + h * 96 + w + fq * 4) : (VM + (size_t)row * 512 + h * 64 + (w - 64) + fq * 4);
                    *(u32x2*)p = pack4(acc[ai][bj][m][0] * rs); *(u32x2*)(p + 16) = pack4(acc[ai][bj][m][1] * rs);
                }
            }
    }
};

struct EpiNull {
    static constexpr bool PERM = false, AFTER_DRAIN = false, F16 = false;
    __device__ __forceinline__ void operator()(const f32x4 (&acc)[2][2][4][2], const Unit& u, int wr, int wc, int fr, int fq) const {
#pragma unroll
        for (int ai = 0; ai < 2; ++ai)
#pragma unroll
            for (int bj = 0; bj < 2; ++bj)
#pragma unroll
                for (int m = 0; m < 4; ++m)
#pragma unroll
                    for (int n = 0; n < 2; ++n) asm volatile("" :: "v"(acc[ai][bj][m][n]));
    }
};
template <class Epi, class Sched, bool ALIGN_EPI = false, bool SP2 = false>
__device__ __forceinline__ void gemm_phase(PG8_LAS unsigned char* lds, const Gemm g, const Sched& S, const Epi& E) {
    const int tid = opaque_tid(), wid = __builtin_amdgcn_readfirstlane(tid >> 6), lane = tid & 63, wr = wid >> 2, wc = wid & 3, fr = lane & 15, fq = lane >> 4;
    const int K = g.K, nt = K / BK;
    unsigned voffA[2], voffB[2];
#pragma unroll
    for (int i = 0; i < 2; ++i) { int R, C; stage_rc(tid * 16 + i * 8192, R, C); const int Rb = Epi::PERM ? ((R & ~31) + perm32(R & 31)) : R;
        voffA[i] = (unsigned)(R * K + C) * 2u; voffB[i] = (unsigned)(Rb * K + C) * 2u; }
    const size_t kstep = (size_t)(BK * 2);
    const size_t hstep = (size_t)HALF * K * 2;
    const size_t tstep = 2 * hstep;
    const unsigned ldsw = (unsigned)wid * 1024u;
    const int aoff = lds_byte(wr * 64 + fr, fq * 8), boff = lds_byte(wc * 32 + fr, fq * 8);
#define PG8_SA(b, h) (((b) * 2 + (h)) * HTB)
#define PG8_SB(b, h) ((4 + (b) * 2 + (h)) * HTB)
#define PG8_STAGE(bufoff, gbase, voff) do { _Pragma("unroll") for (int _i = 0; _i < 2; ++_i) \
        __builtin_amdgcn_global_load_lds((const unsigned*)((const char*)(gbase) + (voff)[_i]), (PG8_LAS unsigned*)(lds + (bufoff) + ldsw + _i * 8192), 16, 0, 0); } while (0)
#define PG8_LDA(dst, b, h) do { _Pragma("unroll") for (int m = 0; m < 4; ++m) _Pragma("unroll") for (int k = 0; k < 2; ++k) dst[m][k] = *(const PG8_LAS bf16x8*)(lds + PG8_SA(b, h) + aoff + m * 2048 + k * 1024); } while (0)
#define PG8_LDB(dst, b, h) do { _Pragma("unroll") for (int n = 0; n < 2; ++n) _Pragma("unroll") for (int k = 0; k < 2; ++k) dst[n][k] = *(const PG8_LAS bf16x8*)(lds + PG8_SB(b, h) + boff + n * 2048 + k * 1024); } while (0)
#define PG8_MMA(ai, bj, At, Bt) do { __builtin_amdgcn_s_setprio(1); _Pragma("unroll") for (int m = 0; m < 4; ++m) _Pragma("unroll") for (int n = 0; n < 2; ++n) _Pragma("unroll") for (int k = 0; k < 2; ++k) \
        acc[ai][bj][m][n] = mma16<Epi::F16>(Bt[n][k], At[m][k], acc[ai][bj][m][n]); __builtin_amdgcn_s_setprio(0); } while (0)
#define PG8_WAIT_V(n) asm volatile("s_waitcnt vmcnt(" #n ")" ::: "memory")
#define PG8_WAIT_L(n) asm volatile("s_waitcnt lgkmcnt(" #n ")" ::: "memory")
#define PG8_BAR __builtin_amdgcn_s_barrier()
#define PG8_SCHED __builtin_amdgcn_sched_barrier(0)
    Unit cur, nxt; int ui = 0;
    if (!S.next(0, cur)) return;
    f32x4 acc[2][2][4][2];
#pragma unroll
    for (int a = 0; a < 2; ++a)
#pragma unroll
        for (int b = 0; b < 2; ++b)
#pragma unroll
            for (int m = 0; m < 4; ++m)
#pragma unroll
                for (int n = 0; n < 2; ++n) acc[a][b][m][n] = (f32x4){0.f, 0.f, 0.f, 0.f};
    bf16x8 At[4][2], B0[2][2], B1[2][2];
    const char* cA = (const char*)g.A + (size_t)cur.pm * tstep; const char* cB = (const char*)g.Bt + (size_t)cur.pn * tstep;
    S.a_ready(cur);
    if constexpr (SP2) {
        PG8_STAGE(PG8_SB(0, 0), cB, voffB); PG8_STAGE(PG8_SB(0, 1), cB + hstep, voffB); PG8_STAGE(PG8_SA(0, 0), cA, voffA); PG8_STAGE(PG8_SA(0, 1), cA + hstep, voffA);
        if (wr == 1) PG8_BAR;
        PG8_WAIT_V(2); PG8_BAR;
        PG8_STAGE(PG8_SB(1, 0), cB + kstep, voffB); PG8_STAGE(PG8_SA(1, 0), cA + kstep, voffA); PG8_STAGE(PG8_SB(1, 1), cB + hstep + kstep, voffB);
        PG8_WAIT_V(6); PG8_BAR;
    } else {
        PG8_STAGE(PG8_SB(0, 0), cB, voffB); PG8_STAGE(PG8_SA(0, 0), cA, voffA); PG8_STAGE(PG8_SB(0, 1), cB + hstep, voffB); PG8_STAGE(PG8_SA(0, 1), cA + hstep, voffA);
        if (wr == 1) PG8_BAR;
        PG8_WAIT_V(4); PG8_BAR;
        PG8_STAGE(PG8_SB(1, 0), cB + kstep, voffB); PG8_STAGE(PG8_SA(1, 0), cA + kstep, voffA); PG8_STAGE(PG8_SB(1, 1), cB + hstep + kstep, voffB);
        PG8_WAIT_V(6); PG8_BAR;
    }
    for (;;) {
        const bool has_next = S.next(ui + 1, nxt);
        const char* nA = has_next ? (const char*)g.A + (size_t)nxt.pm * tstep : cA; const char* nB = has_next ? (const char*)g.Bt + (size_t)nxt.pn * tstep : cB;
        for (int t = 0; t < nt; t += 2) {
            const bool last = (t == nt - 2);
            const char* a1 = cA + (size_t)(t + 1) * kstep;
            const char* a2 = last ? nA : cA + (size_t)(t + 2) * kstep; const char* b2 = last ? nB : cB + (size_t)(t + 2) * kstep;
            const char* a3 = a2 + kstep; const char* b3 = b2 + kstep;
            if (last && has_next) S.a_ready(nxt);
            if constexpr (SP2) {
            PG8_LDB(B0, 0, 0); PG8_LDB(B1, 0, 1); PG8_SCHED; PG8_LDA(At, 0, 0); PG8_STAGE(PG8_SA(1, 1), a1 + hstep, voffA);
            PG8_WAIT_V(8); PG8_WAIT_L(0); PG8_BAR; PG8_MMA(0, 0, At, B0); PG8_MMA(0, 1, At, B1); PG8_BAR; PG8_SCHED;
            PG8_LDA(At, 0, 1); PG8_STAGE(PG8_SB(0, 0), b2, voffB); PG8_STAGE(PG8_SB(0, 1), b2 + hstep, voffB); PG8_STAGE(PG8_SA(0, 0), a2, voffA);
            PG8_WAIT_V(8); PG8_WAIT_L(0); PG8_BAR; PG8_MMA(1, 0, At, B0); PG8_MMA(1, 1, At, B1); PG8_BAR; PG8_SCHED;
            PG8_LDB(B0, 1, 0); PG8_LDB(B1, 1, 1); PG8_SCHED; PG8_LDA(At, 1, 0); PG8_STAGE(PG8_SA(0, 1), a2 + hstep, voffA);
            PG8_WAIT_V(8); PG8_WAIT_L(0); PG8_BAR; PG8_MMA(0, 0, At, B0); PG8_MMA(0, 1, At, B1); PG8_BAR; PG8_SCHED;
            PG8_LDA(At, 1, 1); PG8_STAGE(PG8_SB(1, 0), b3, voffB); PG8_STAGE(PG8_SB(1, 1), b3 + hstep, voffB); PG8_STAGE(PG8_SA(1, 0), a3, voffA);
            PG8_WAIT_V(8); PG8_WAIT_L(0); PG8_BAR; PG8_MMA(1, 0, At, B0); PG8_MMA(1, 1, At, B1); PG8_BAR; PG8_SCHED;
            } else {
            PG8_LDB(B0, 0, 0); PG8_SCHED; PG8_LDA(At, 0, 0); PG8_STAGE(PG8_SA(1, 1), a1 + hstep, voffA);
            PG8_WAIT_L(8); PG8_BAR; PG8_WAIT_L(0); PG8_MMA(0, 0, At, B0); PG8_BAR; PG8_SCHED;
            PG8_LDB(B1, 0, 1); PG8_STAGE(PG8_SB(0, 0), b2, voffB);
            PG8_BAR; PG8_WAIT_L(0); PG8_MMA(0, 1, At, B1); PG8_BAR;
            PG8_LDA(At, 0, 1); PG8_STAGE(PG8_SA(0, 0), a2, voffA);
            PG8_BAR; PG8_WAIT_L(0); PG8_MMA(1, 0, At, B0); PG8_BAR; PG8_SCHED;
            PG8_STAGE(PG8_SB(0, 1), b2 + hstep, voffB);
            PG8_WAIT_V(6); PG8_BAR; PG8_MMA(1, 1, At, B1); PG8_BAR;
            PG8_LDB(B0, 1, 0); PG8_SCHED; PG8_LDA(At, 1, 0); PG8_STAGE(PG8_SA(0, 1), a2 + hstep, voffA);
            PG8_WAIT_L(8); PG8_BAR; PG8_WAIT_L(0); PG8_MMA(0, 0, At, B0); PG8_BAR; PG8_SCHED;
            PG8_LDB(B1, 1, 1); PG8_STAGE(PG8_SB(1, 0), b3, voffB);
            PG8_BAR; PG8_WAIT_L(0); PG8_MMA(0, 1, At, B1); PG8_BAR;
            PG8_LDA(At, 1, 1); PG8_STAGE(PG8_SA(1, 0), a3, voffA);
            PG8_BAR; PG8_WAIT_L(0); PG8_MMA(1, 0, At, B0); PG8_BAR; PG8_SCHED;
            PG8_STAGE(PG8_SB(1, 1), b3 + hstep, voffB);
            PG8_WAIT_V(6); PG8_BAR; PG8_MMA(1, 1, At, B1); PG8_BAR;
            }
        }
        if constexpr (ALIGN_EPI) { if (wr == 0) PG8_BAR; }
        if constexpr (!Epi::AFTER_DRAIN) { E(acc, cur, wr, wc, fr, fq); S.done(cur); }
        if (!has_next) break;
#pragma unroll
        for (int a = 0; a < 2; ++a)
#pragma unroll
            for (int b = 0; b < 2; ++b)
#pragma unroll
                for (int m = 0; m < 4; ++m)
#pragma unroll
                    for (int n = 0; n < 2; ++n) acc[a][b][m][n] = (f32x4){0.f, 0.f, 0.f, 0.f};
        cur = nxt; cA = nA; cB = nB; ++ui;
        if constexpr (ALIGN_EPI) { if (wr == 1) PG8_BAR; }
    }
    PG8_WAIT_V(0);
    if constexpr (!ALIGN_EPI) { if (wr == 0) PG8_BAR; }
    PG8_BAR;
    if constexpr (Epi::AFTER_DRAIN) { E.fused(acc, cur, wr, wc, fr, fq, lds, wid, lane); S.done(cur); }
#undef PG8_SA
#undef PG8_SB
#undef PG8_STAGE
#undef PG8_LDA
#undef PG8_LDB
#undef PG8_MMA
#undef PG8_WAIT_V
#undef PG8_WAIT_L
#undef PG8_BAR
#undef PG8_SCHED
}
}
namespace att {
typedef unsigned short bf16_t;
typedef short bf16x8 __attribute__((ext_vector_type(8)));
typedef short s16x4 __attribute__((ext_vector_type(4)));
typedef float f32x16 __attribute__((ext_vector_type(16)));
typedef float f32x4 __attribute__((ext_vector_type(4)));
typedef unsigned u32x4 __attribute__((ext_vector_type(4)));
typedef unsigned u32x2 __attribute__((ext_vector_type(2)));
#define ATT_LAS __attribute__((address_space(3)))
typedef ATT_LAS const char* lds_cptr;
typedef ATT_LAS char* lds_ptr;
constexpr float kLog2e = 1.4426950408889634f;
__device__ __forceinline__ int crow(int r, int hi) { return (r & 3) + 8 * (r >> 2) + 4 * hi; }
__device__ __forceinline__ unsigned cvtpk(float lo, float hi) { unsigned r; asm volatile("v_cvt_pk_bf16_f32 %0, %1, %2" : "=v"(r) : "v"(lo), "v"(hi)); return r; }
__device__ __forceinline__ s16x4 vtr(lds_cptr p) { return __builtin_bit_cast(s16x4, __builtin_amdgcn_ds_read_tr16_b64_v4i16((ATT_LAS s16x4*)p)); }
__device__ __forceinline__ bf16x8 cat8(s16x4 lo, s16x4 hi) { return (bf16x8){lo[0], lo[1], lo[2], lo[3], hi[0], hi[1], hi[2], hi[3]}; }
__device__ __forceinline__ bf16x8 packp(const f32x16& p, int b) {
    u32x4 w; w.x = cvtpk(p[b], p[b + 1]); w.y = cvtpk(p[b + 2], p[b + 3]); w.z = cvtpk(p[b + 4], p[b + 5]); w.w = cvtpk(p[b + 6], p[b + 7]);
    return __builtin_bit_cast(bf16x8, w);
}
__device__ __forceinline__ float max16(const f32x16& p) {
    float a = fmaxf(fmaxf(p[0], p[1]), fmaxf(p[2], p[3])), b = fmaxf(fmaxf(p[4], p[5]), fmaxf(p[6], p[7]));
    float c = fmaxf(fmaxf(p[8], p[9]), fmaxf(p[10], p[11])), d = fmaxf(fmaxf(p[12], p[13]), fmaxf(p[14], p[15]));
    return fmaxf(fmaxf(a, b), fmaxf(c, d));
}
__device__ __forceinline__ float sum16(const f32x16& p) {
    return ((p[0] + p[1]) + (p[2] + p[3])) + ((p[4] + p[5]) + (p[6] + p[7])) + (((p[8] + p[9]) + (p[10] + p[11])) + ((p[12] + p[13]) + (p[14] + p[15])));
}
__device__ __forceinline__ float xmax32(float x) { const auto rr = __builtin_amdgcn_permlane32_swap(__float_as_uint(x), __float_as_uint(x), false, false); return fmaxf(__uint_as_float(rr[0]), __uint_as_float(rr[1])); }
__device__ __forceinline__ float xsum32(float x) { const auto rr = __builtin_amdgcn_permlane32_swap(__float_as_uint(x), __float_as_uint(x), false, false); return __uint_as_float(rr[0]) + __uint_as_float(rr[1]); }
__device__ __forceinline__ float xother32(float x, int hi) { const auto rr = __builtin_amdgcn_permlane32_swap(__float_as_uint(x), __float_as_uint(x), false, false); return hi ? __uint_as_float(rr[0]) : __uint_as_float(rr[1]); }
template <int KEYS> __device__ __forceinline__ void pv_tile(f32x16 (&o)[2], lds_cptr vbase, const bf16x8 (&pf)[KEYS / 16], int lane) {
    const int hi = lane >> 5, li = lane & 15;
    lds_cptr vp = vbase + (4 * hi + (li >> 2)) * 64 + ((lane >> 4) & 1) * 32 + (lane & 3) * 8;
#pragma unroll
    for (int d0 = 0; d0 < 2; ++d0)
#pragma unroll
        for (int ks = 0; ks < KEYS / 16; ++ks) {
            const s16x4 lo = vtr(vp + d0 * (KEYS * 64) + ks * 1024), hh = vtr(vp + d0 * (KEYS * 64) + ks * 1024 + 512);
            o[d0] = __builtin_amdgcn_mfma_f32_32x32x16_bf16(cat8(lo, hh), pf[ks], o[d0], 0, 0, 0);
        }
}
__device__ __forceinline__ void store_o(const f32x16 (&o)[2], float sc, bf16_t* orow, int hi) {
#pragma unroll
    for (int d0 = 0; d0 < 2; ++d0)
#pragma unroll
        for (int g = 0; g < 4; ++g) {
            u32x2 w; w.x = cvtpk(o[d0][4 * g] * sc, o[d0][4 * g + 1] * sc); w.y = cvtpk(o[d0][4 * g + 2] * sc, o[d0][4 * g + 3] * sc);
            *(u32x2*)(orow + d0 * 32 + g * 8 + hi * 4) = w;
        }
}

template <int DK> struct AttL { static constexpr int KS = DK * 2 + 16, KB = 64 * KS, VB = 8192, BUF = KB + VB, TOTAL = 2 * BUF; };
template <int DK, int MODE>
__device__ __forceinline__ void attn_unit(const bf16_t* Q, int ldq, const bf16_t* K, int ldk, const bf16_t* V, int ldv, bf16_t* O, int ldo, int qb, char* shm, float sc) {
    typedef AttL<DK> L;
    constexpr int NS = DK / 16, CPR = DK / 8;
    const int tid = opaque_tid(), lane = tid & 63, r32 = lane & 31, hi = lane >> 5; const int wid = __builtin_amdgcn_readfirstlane(tid >> 6);
    const int qpos = qb * 256 + wid * 32 + r32;
    bf16x8 qf[NS];
#pragma unroll
    for (int s = 0; s < NS; ++s) qf[s] = *(const bf16x8*)(Q + (size_t)qpos * ldq + s * 16 + hi * 8);
    const int kc0 = tid, kkey0 = kc0 / CPR, kch0 = kc0 % CPR;
    const int kc1 = 512 + tid, kkey1 = kc1 / CPR, kch1 = kc1 % CPR; const bool k2 = (DK == 96) && (tid < 256);
    const int vkey = tid >> 3, vch = tid & 7;
    const int voff = (vch >> 2) * 4096 + vkey * 64 + (vch & 3) * 16;
    const int nt = 4 * (qb + 1);
    f32x16 o[2]; o[0] = f32x16{}; o[1] = f32x16{};
    constexpr float SB_SAT = 160.0f; float wminR = 0.f;
    float mrun = -1e30f, lrun = (MODE == 1) ? 1.f : 0.f;
    u32x4 kr0A, kr1A = u32x4{}, vrA, kr0B, kr1B = u32x4{}, vrB;
#define ATT_FETCH(KR0, KR1, VR, tt) do { const size_t kb_ = (size_t)(tt) * 64; \
        KR0 = *(const u32x4*)(K + (kb_ + kkey0) * ldk + kch0 * 8); \
        if (k2) KR1 = *(const u32x4*)(K + (kb_ + kkey1) * ldk + kch1 * 8); \
        VR = *(const u32x4*)(V + (kb_ + vkey) * ldv + vch * 8); } while (0)
#define ATT_TILE(i_) ((MODE == 0) ? (i_) : nt - 1 - (i_))
    ATT_FETCH(kr0A, kr1A, vrA, ATT_TILE(0)); ATT_FETCH(kr0B, kr1B, vrB, ATT_TILE(1));
    bool done = false;
#define ATT_STEP(it, KR0, KR1, VR) { \
        const int tt = ATT_TILE(it); \
        char* buf = shm + ((it) & 1) * L::BUF; \
        *(u32x4*)(buf + kkey0 * L::KS + kch0 * 16) = KR0; \
        if (k2) *(u32x4*)(buf + kkey1 * L::KS + kch1 * 16) = KR1; \
        *(u32x4*)(buf + L::KB + voff) = VR; \
        __syncthreads(); \
        if (MODE == 1 && (it) > 0) { \
            const float* fl = (const float*)(shm + L::TOTAL) + (((it) - 1) & 1) * 8; \
            const float mnr = fminf(fminf(fminf(fl[0], fl[1]), fminf(fl[2], fl[3])), fminf(fminf(fl[4], fl[5]), fminf(fl[6], fl[7]))); \
            if (mnr >= SB_SAT) done = true; \
        } \
        if (!done) { \
        ATT_FETCH(KR0, KR1, VR, ATT_TILE(((it) + 2 < nt) ? (it) + 2 : nt - 1)); \
        att_compute(it, tt, buf); } }
    auto att_compute = [&](int it, int tt, char* buf) __attribute__((always_inline)) {
        const int kbase = tt * 64;
        bool active = !(kbase > qb * 256 + wid * 32 + 31);
        if (MODE == 1) active = active && (wminR < SB_SAT);
        if (active) {
        f32x16 p0 = f32x16{}, p1 = f32x16{};
        const char* kp = buf + r32 * L::KS + hi * 16;
#pragma unroll
        for (int s = 0; s < NS; ++s) {
            const bf16x8 a0 = *(const bf16x8*)(kp + s * 32), a1 = *(const bf16x8*)(kp + 32 * L::KS + s * 32);
            p0 = __builtin_amdgcn_mfma_f32_32x32x16_bf16(a0, qf[s], p0, 0, 0, 0);
            p1 = __builtin_amdgcn_mfma_f32_32x32x16_bf16(a1, qf[s], p1, 0, 0, 0);
        }
        const bool diag = (kbase + 63 >= qb * 256 + wid * 32);
        bf16x8 pf[4];
        if (MODE == 0) {
#pragma unroll
            for (int r = 0; r < 16; ++r) { p0[r] *= sc; p1[r] *= sc; }
            if (diag) {
#pragma unroll
                for (int r = 0; r < 16; ++r) { const int key = kbase + crow(r, hi); if (key > qpos) p0[r] = -INFINITY; if (key + 32 > qpos) p1[r] = -INFINITY; }
            }
            float rm = fmaxf(max16(p0), max16(p1)); rm = xmax32(rm);
            const float mn = fmaxf(mrun, rm), f = __builtin_amdgcn_exp2f(mrun - mn); mrun = mn;
#pragma unroll
            for (int r = 0; r < 16; ++r) { p0[r] = __builtin_amdgcn_exp2f(p0[r] - mn); p1[r] = __builtin_amdgcn_exp2f(p1[r] - mn); }
            lrun = lrun * f + (sum16(p0) + sum16(p1));
#pragma unroll
            for (int r = 0; r < 16; ++r) { o[0][r] *= f; o[1][r] *= f; }
        } else {
            f32x16 om0, om1;
#pragma unroll
            for (int r = 0; r < 16; ++r) {
                const float e0 = __builtin_amdgcn_exp2f(-fmaxf(p0[r] * sc, -100.f)), e1 = __builtin_amdgcn_exp2f(-fmaxf(p1[r] * sc, -100.f));
                const float s0 = __builtin_amdgcn_rcpf(1.0f + e0), s1 = __builtin_amdgcn_rcpf(1.0f + e1);
                om0[r] = e0 * s0; om1[r] = e1 * s1; p0[r] = s0; p1[r] = s1;
            }
            if (diag) {
#pragma unroll
                for (int r = 0; r < 16; ++r) { const int key = kbase + crow(r, hi);
                    if (key >= qpos) { om0[r] = 1.f; p0[r] = 0.f; } if (key + 32 >= qpos) { om1[r] = 1.f; p1[r] = 0.f; } }
            }
            float gs[8], og[8];
#pragma unroll
            for (int g = 0; g < 4; ++g) { gs[g] = (om0[4 * g] * om0[4 * g + 1]) * (om0[4 * g + 2] * om0[4 * g + 3]); gs[4 + g] = (om1[4 * g] * om1[4 * g + 1]) * (om1[4 * g + 2] * om1[4 * g + 3]); }
#pragma unroll
            for (int g = 0; g < 8; ++g) og[g] = xother32(gs[g], hi);
            float suf = lrun;
#pragma unroll
            for (int g = 7; g >= 0; --g) {
                const float T = suf * (hi == 0 ? og[g] : 1.f);
                f32x16& om = (g < 4) ? om0 : om1; f32x16& pp = (g < 4) ? p0 : p1; const int b = 4 * (g & 3);
                const float l3 = T, l2 = l3 * om[b + 3], l1 = l2 * om[b + 2], l0 = l1 * om[b + 1];
                pp[b + 3] *= l3; pp[b + 2] *= l2; pp[b + 1] *= l1; pp[b] *= l0;
                suf *= gs[g] * og[g];
            }
            lrun = suf;
        }
        pf[0] = packp(p0, 0); pf[1] = packp(p0, 8); pf[2] = packp(p1, 0); pf[3] = packp(p1, 8);
        pv_tile<64>(o, (lds_cptr)(buf + L::KB), pf, lane);
        }
        if (MODE == 1) {
            float w = lrun;
#pragma unroll
            for (int sh = 1; sh < 32; sh <<= 1) w = fmaxf(w, __shfl_xor(w, sh));
            w = (w > 0.f) ? 0.f : 1000.f;
            wminR = __builtin_bit_cast(float, __builtin_amdgcn_readfirstlane(__builtin_bit_cast(int, w)));
            if (lane == 0) ((float*)(shm + L::TOTAL))[(it & 1) * 8 + wid] = wminR;
        }
    };
    for (int it = 0; it < nt && !done; it += 2) {
        ATT_STEP(it, kr0A, kr1A, vrA)
        if (done) break;
        ATT_STEP(it + 1, kr0B, kr1B, vrB)
    }
#undef ATT_STEP
#undef ATT_TILE
#undef ATT_FETCH
    float scl = 1.0f;
    if (MODE == 0) { const float lt = xsum32(lrun); scl = 1.0f / lt; }
    store_o(o, scl, O + (size_t)qpos * ldo, hi);
}

__device__ __forceinline__ void sb_unit_big(const bf16_t* Q, const bf16_t* K, const bf16_t* V, int ld, bf16_t* O, int ldo, int qb, char* shm, int maxch) {
    constexpr int KS = 144, KSUB = 64 * KS, KB = 4 * KSUB, VSUB = 8192, BUF = KB + 4 * VSUB, TOTAL = 2 * BUF;
    const int tid = opaque_tid(), lane = tid & 63, r32 = lane & 31, hi = lane >> 5; const int wid = __builtin_amdgcn_readfirstlane(tid >> 6);
    const float sc = 0.125f * kLog2e;
    const int qpos = qb * 256 + wid * 32 + r32;
    bf16x8 qf[4];
#pragma unroll
    for (int s = 0; s < 4; ++s) qf[s] = *(const bf16x8*)(Q + (size_t)qpos * ld + s * 16 + hi * 8);
    const int lkey = tid >> 3, lch = tid & 7;
    const int koff = lkey * KS + lch * 16, voff = KB + (lch >> 2) * 4096 + lkey * 64 + (lch & 3) * 16;
    f32x16 o[2]; o[0] = f32x16{}; o[1] = f32x16{};
    float carry = 1.f; bool wsat = false;
    u32x4 kr[4], vr[4];
#define SBB_FETCH(c) do { const size_t cb_ = (size_t)(c) * 256 + lkey; \
        _Pragma("unroll") for (int i = 0; i < 4; ++i) { kr[i] = *(const u32x4*)(K + (cb_ + 64 * i) * ld + lch * 8); vr[i] = *(const u32x4*)(V + (cb_ + 64 * i) * ld + lch * 8); } } while (0)
    auto sub_compute = [&](int kbase, const char* kt, const char* vt) __attribute__((always_inline)) {
        f32x16 p0 = f32x16{}, p1 = f32x16{};
        const char* kp = kt + r32 * KS + hi * 16;
#pragma unroll
        for (int s = 0; s < 4; ++s) {
            const bf16x8 a0 = *(const bf16x8*)(kp + s * 32), a1 = *(const bf16x8*)(kp + 32 * KS + s * 32);
            p0 = __builtin_amdgcn_mfma_f32_32x32x16_bf16(a0, qf[s], p0, 0, 0, 0);
            p1 = __builtin_amdgcn_mfma_f32_32x32x16_bf16(a1, qf[s], p1, 0, 0, 0);
        }
        f32x16 om0, om1;
#pragma unroll
        for (int r = 0; r < 16; ++r) {
            const float e0 = __builtin_amdgcn_exp2f(-fmaxf(p0[r] * sc, -100.f)), e1 = __builtin_amdgcn_exp2f(-fmaxf(p1[r] * sc, -100.f));
            const float s0 = __builtin_amdgcn_rcpf(1.0f + e0), s1 = __builtin_amdgcn_rcpf(1.0f + e1);
            om0[r] = e0 * s0; om1[r] = e1 * s1; p0[r] = s0; p1[r] = s1;
        }
        if (kbase + 63 >= qb * 256 + wid * 32) {
#pragma unroll
            for (int r = 0; r < 16; ++r) { const int key = kbase + crow(r, hi);
                if (key >= qpos) { om0[r] = 1.f; p0[r] = 0.f; } if (key + 32 >= qpos) { om1[r] = 1.f; p1[r] = 0.f; } }
        }
        float gs[8], og[8];
#pragma unroll
        for (int g = 0; g < 4; ++g) { gs[g] = (om0[4 * g] * om0[4 * g + 1]) * (om0[4 * g + 2] * om0[4 * g + 3]); gs[4 + g] = (om1[4 * g] * om1[4 * g + 1]) * (om1[4 * g + 2] * om1[4 * g + 3]); }
#pragma unroll
        for (int g = 0; g < 8; ++g) og[g] = xother32(gs[g], hi);
        float suf = carry;
#pragma unroll
        for (int g = 7; g >= 0; --g) {
            const float T = suf * (hi == 0 ? og[g] : 1.f);
            f32x16& om = (g < 4) ? om0 : om1; f32x16& pp = (g < 4) ? p0 : p1; const int b = 4 * (g & 3);
            const float l3 = T, l2 = l3 * om[b + 3], l1 = l2 * om[b + 2], l0 = l1 * om[b + 1];
            pp[b + 3] *= l3; pp[b + 2] *= l2; pp[b + 1] *= l1; pp[b] *= l0;
            suf *= gs[g] * og[g];
        }
        carry = suf;
        bf16x8 pf[4]; pf[0] = packp(p0, 0); pf[1] = packp(p0, 8); pf[2] = packp(p1, 0); pf[3] = packp(p1, 8);
        pv_tile<64>(o, (lds_cptr)vt, pf, lane);
        wsat = !__any(carry > 0.f);
    };
    const int nch = (qb + 1 < maxch) ? qb + 1 : maxch;
    SBB_FETCH(qb);
    for (int it = 0; it < nch; ++it) {
        char* buf = shm + (it & 1) * BUF;
#pragma unroll
        for (int i = 0; i < 4; ++i) { *(u32x4*)(buf + i * KSUB + koff) = kr[i]; *(u32x4*)(buf + i * VSUB + voff) = vr[i]; }
        __syncthreads();
        if (it > 0) {
            const float* fl = (const float*)(shm + TOTAL) + ((it - 1) & 1) * 8;
            const float mnr = fminf(fminf(fminf(fl[0], fl[1]), fminf(fl[2], fl[3])), fminf(fminf(fl[4], fl[5]), fminf(fl[6], fl[7])));
            if (mnr > 0.5f) break;
        }
        if (it + 1 < nch) SBB_FETCH(qb - it - 1);
        const int cbase = (qb - it) * 256;
#pragma unroll 1
        for (int sub = 3; sub >= 0; --sub) {
            const int kbase = cbase + 64 * sub;
            if (!(kbase > qb * 256 + wid * 32 + 31) && !wsat) sub_compute(kbase, buf + sub * KSUB, buf + KB + sub * VSUB);
        }
        if (lane == 0) ((float*)(shm + TOTAL))[(it & 1) * 8 + wid] = wsat ? 1.f : 0.f;
    }
#undef SBB_FETCH
    store_o(o, 1.0f, O + (size_t)qpos * ldo, hi);
    __syncthreads();
}

__device__ __forceinline__ void sb_wave_unit(const bf16_t* Q, const bf16_t* K, const bf16_t* V, int ld, bf16_t* O, int ldo, int q0, char* wl, int lane) {
    const int r32 = lane & 31, hi = lane >> 5;
    const float sc = 0.125f * kLog2e;
    const int qpos = q0 + r32;
    bf16x8 qf[4];
#pragma unroll
    for (int s = 0; s < 4; ++s) qf[s] = *(const bf16x8*)(Q + (size_t)qpos * ld + s * 16 + hi * 8);
    f32x16 o[2]; o[0] = f32x16{}; o[1] = f32x16{};
    float carry = 1.f;
#define SBW_LOAD(j, KF, VR) do { const size_t kb_ = (size_t)(j) * 32; \
        _Pragma("unroll") for (int s = 0; s < 4; ++s) KF[s] = *(const bf16x8*)(K + (kb_ + r32) * ld + s * 16 + hi * 8); \
        _Pragma("unroll") for (int c4 = 0; c4 < 4; ++c4) VR[c4] = *(const u32x4*)(V + (kb_ + (lane >> 3) + 8 * c4) * ld + (lane & 7) * 8); } while (0)
#define SBW_TILE(j, KF, VR) do { const int kbase = (j) * 32; \
        asm volatile("s_waitcnt lgkmcnt(0)" ::: "memory"); \
        _Pragma("unroll") for (int c4 = 0; c4 < 4; ++c4) { const int key = (lane >> 3) + 8 * c4, ch = lane & 7; \
            *(u32x4*)(wl + (ch >> 2) * 2048 + key * 64 + (ch & 3) * 16) = VR[c4]; } \
        f32x16 p = f32x16{}; \
        _Pragma("unroll") for (int s = 0; s < 4; ++s) p = __builtin_amdgcn_mfma_f32_32x32x16_bf16(KF[s], qf[s], p, 0, 0, 0); \
        f32x16 om; \
        _Pragma("unroll") for (int r = 0; r < 16; ++r) { \
            const float e = __builtin_amdgcn_exp2f(-fmaxf(p[r] * sc, -100.f)); const float sg = __builtin_amdgcn_rcpf(1.0f + e); \
            om[r] = e * sg; p[r] = sg; } \
        if (kbase + 31 >= q0) { \
            _Pragma("unroll") for (int r = 0; r < 16; ++r) { if (kbase + crow(r, hi) >= qpos) { om[r] = 1.f; p[r] = 0.f; } } } \
        float gs[4], og[4]; \
        _Pragma("unroll") for (int g = 0; g < 4; ++g) gs[g] = (om[4 * g] * om[4 * g + 1]) * (om[4 * g + 2] * om[4 * g + 3]); \
        _Pragma("unroll") for (int g = 0; g < 4; ++g) og[g] = xother32(gs[g], hi); \
        float suf = carry; \
        _Pragma("unroll") for (int g = 3; g >= 0; --g) { \
            const float T = suf * (hi == 0 ? og[g] : 1.f); const int b = 4 * g; \
            const float l3 = T, l2 = l3 * om[b + 3], l1 = l2 * om[b + 2], l0 = l1 * om[b + 1]; \
            p[b + 3] *= l3; p[b + 2] *= l2; p[b + 1] *= l1; p[b] *= l0; \
            suf *= gs[g] * og[g]; } \
        carry = suf; \
        bf16x8 pf[2]; pf[0] = packp(p, 0); pf[1] = packp(p, 8); \
        asm volatile("s_waitcnt lgkmcnt(0)" ::: "memory"); \
        pv_tile<32>(o, (lds_cptr)wl, pf, lane); } while (0)
    bf16x8 kfA[4], kfB[4], kfC[4]; u32x4 vrA[4], vrB[4], vrC[4];
    int j = (q0 + 30) >> 5;
#define SBW_CL(x) ((x) < 0 ? 0 : (x))
    SBW_LOAD(j, kfA, vrA);
    SBW_LOAD(SBW_CL(j - 1), kfB, vrB);
    for (;;) {
        SBW_LOAD(SBW_CL(j - 2), kfC, vrC);
        SBW_TILE(j, kfA, vrA);
        if (j < 1 || !__any(carry > 0.f)) break;
        SBW_LOAD(SBW_CL(j - 3), kfA, vrA);
        SBW_TILE(j - 1, kfB, vrB);
        if (j < 2 || !__any(carry > 0.f)) break;
        SBW_LOAD(SBW_CL(j - 4), kfB, vrB);
        SBW_TILE(j - 2, kfC, vrC);
        if (j < 3 || !__any(carry > 0.f)) break;
        j -= 3;
    }
#undef SBW_CL
#undef SBW_LOAD
#undef SBW_TILE
    asm volatile("s_waitcnt lgkmcnt(0)" ::: "memory");
    store_o(o, 1.0f, O + (size_t)qpos * ldo, hi);
}

__device__ __forceinline__ void dil_unit(const bf16_t* QKV, float* scr, bf16_t* O, int b, int h, int blk, char* shm) {
    const int tid = opaque_tid(), lane = tid & 63, r32 = lane & 31, hi = lane >> 5; const int wid = __builtin_amdgcn_readfirstlane(tid >> 6);
    const int T0 = blk * 512; const size_t rb = (size_t)b * 2048;
    const bf16_t* Qh = QKV + h * 64; const bf16_t* Kh = QKV + 512 + h * 64; const bf16_t* Vh = QKV + 1024 + h * 64;
    const float sc = 0.125f * kLog2e, slope2 = __builtin_amdgcn_exp2f(-(float)(h + 1)) * kLog2e;
    char* wl = shm + wid * 4096;
    float* sO = scr; float* sM = scr + 512 * 64; float* sL = sM + 512;
#pragma unroll 1
    for (int br = 0; br < 3; ++br) {
        const int lg = 2 * br, d = 1 << lg;
        const float sl = slope2 * (float)d;
#pragma unroll 1
        for (int rep = 0; rep < 2; ++rep) {
            const int k = wid + 8 * rep, res = k & (d - 1), c = k >> lg, tq0 = T0 + res + d * 32 * c;
            const int tq = tq0 + d * r32;
            bf16x8 qf[4];
#pragma unroll
            for (int s = 0; s < 4; ++s) qf[s] = *(const bf16x8*)(Qh + (rb + tq) * 1536 + s * 16 + hi * 8);
            f32x16 o[2]; o[0] = f32x16{}; o[1] = f32x16{};
            float mrun = -1e30f, lrun = 0.f;
#define DIL_LOAD(kt, KF, VR) do { int ktv_ = (kt); asm volatile("" : "+s"(ktv_)); const int ik0_ = -128 + 32 * ktv_; \
                int tk_ = tq0 + d * (ik0_ + r32); tk_ = tk_ < 0 ? 0 : tk_; \
                _Pragma("unroll") for (int s = 0; s < 4; ++s) KF[s] = *(const bf16x8*)(Kh + (rb + tk_) * 1536 + s * 16 + hi * 8); \
                _Pragma("unroll") for (int c4 = 0; c4 < 4; ++c4) { const int key_ = (lane >> 3) + 8 * c4; int tv_ = tq0 + d * (ik0_ + key_); tv_ = tv_ < 0 ? 0 : tv_; \
                    VR[c4] = *(const u32x4*)(Vh + (rb + tv_) * 1536 + (lane & 7) * 8); } } while (0)
#define DIL_TILE(kt, KF, VR) do { int ktw_ = (kt); asm volatile("" : "+s"(ktw_)); const int ik0 = -128 + 32 * ktw_; \
                asm volatile("s_waitcnt lgkmcnt(0)" ::: "memory"); \
                _Pragma("unroll") for (int c4 = 0; c4 < 4; ++c4) { const int key = (lane >> 3) + 8 * c4, ch = lane & 7; \
                    *(u32x4*)(wl + (ch >> 2) * 2048 + key * 64 + (ch & 3) * 16) = VR[c4]; } \
                f32x16 p = f32x16{}; \
                _Pragma("unroll") for (int s = 0; s < 4; ++s) p = __builtin_amdgcn_mfma_f32_32x32x16_bf16(KF[s], qf[s], p, 0, 0, 0); \
                _Pragma("unroll") for (int r = 0; r < 16; ++r) { \
                    const int key = crow(r, hi), rel = r32 - (ik0 + key); \
                    const bool valid = (rel >= 0) && (rel <= 128) && (tq0 + d * (ik0 + key) >= 0); \
                    const float s2 = p[r] * sc - sl * (float)rel; \
                    p[r] = valid ? s2 : -INFINITY; } \
                float rm = max16(p); rm = xmax32(rm); \
                const float mn = fmaxf(mrun, rm), f = __builtin_amdgcn_exp2f(mrun - mn); mrun = mn; \
                _Pragma("unroll") for (int r = 0; r < 16; ++r) p[r] = __builtin_amdgcn_exp2f(p[r] - mn); \
                lrun = lrun * f + sum16(p); \
                _Pragma("unroll") for (int r = 0; r < 16; ++r) { o[0][r] *= f; o[1][r] *= f; } \
                bf16x8 pf[2]; pf[0] = packp(p, 0); pf[1] = packp(p, 8); \
                asm volatile("s_waitcnt lgkmcnt(0)" ::: "memory"); \
                pv_tile<32>(o, (lds_cptr)wl, pf, lane); } while (0)
#define DIL_LIVE(kt) (tq0 + d * (-128 + 32 * (kt) + 31) >= 0)
            bf16x8 kfA[4], kfB[4], kfC[4]; u32x4 vrA[4], vrB[4], vrC[4];
            DIL_LOAD(4, kfA, vrA);
            DIL_LOAD(3, kfB, vrB);
            DIL_LOAD(2, kfC, vrC);
            DIL_TILE(4, kfA, vrA);
            if (DIL_LIVE(3)) {
                DIL_LOAD(1, kfA, vrA);
                DIL_TILE(3, kfB, vrB);
                if (DIL_LIVE(2)) {
                    DIL_LOAD(0, kfB, vrB);
                    DIL_TILE(2, kfC, vrC);
                    if (DIL_LIVE(1)) {
                        DIL_TILE(1, kfA, vrA);
                        if (DIL_LIVE(0)) DIL_TILE(0, kfB, vrB);
                    }
                }
            }
#undef DIL_LIVE
#undef DIL_LOAD
#undef DIL_TILE
            float lt = xsum32(lrun);
            const int ti = tq - T0;
            float* so = sO + (size_t)ti * 64;
            if (br > 0) {
                const float ms = sM[ti], ls = sL[ti];
                const float mn = fmaxf(ms, mrun), fs = __builtin_amdgcn_exp2f(ms - mn), fb = __builtin_amdgcn_exp2f(mrun - mn);
                lt = lt * fb + ls * fs; mrun = mn;
#pragma unroll
                for (int d0 = 0; d0 < 2; ++d0)
#pragma unroll
                    for (int g = 0; g < 4; ++g) { const f32x4 st = *(const f32x4*)(so + d0 * 32 + g * 8 + hi * 4);
#pragma unroll
                        for (int j = 0; j < 4; ++j) o[d0][4 * g + j] = o[d0][4 * g + j] * fb + st[j] * fs; }
            }
            if (br < 2) {
#pragma unroll
                for (int d0 = 0; d0 < 2; ++d0)
#pragma unroll
                    for (int g = 0; g < 4; ++g) *(f32x4*)(so + d0 * 32 + g * 8 + hi * 4) = (f32x4){o[d0][4 * g], o[d0][4 * g + 1], o[d0][4 * g + 2], o[d0][4 * g + 3]};
                if (hi == 0) { sM[ti] = mrun; sL[ti] = lt; }
            } else {
                store_o(o, 1.0f / lt, O + (rb + tq) * 1024 + h * 64, hi);
            }
        }
        __threadfence_block();
        __syncthreads();
    }
}
#undef ATT_LAS
}

typedef unsigned short bf16_t;
typedef float f32x4 __attribute__((ext_vector_type(4)));
typedef unsigned u32x4 __attribute__((ext_vector_type(4)));
typedef unsigned u32x2 __attribute__((ext_vector_type(2)));
constexpr int M_TOK = 32768, DM = 1024, DFF = 2816, SEQ = 2048;
constexpr int NTHR = 512;
constexpr size_t MiB = 1u << 20;
constexpr size_t WS_ROPE = 0;
constexpr size_t WS_SS   = 1 * MiB;
constexpr size_t WS_SSQ  = 3 * MiB;
constexpr size_t WS_SSKV = 4 * MiB;
constexpr size_t WS_BAR  = 5 * MiB;
constexpr size_t WS_W    = 8 * MiB;
constexpr size_t SZ_WGU = (size_t)5632 * 1024 * 2, SZ_WD = (size_t)1024 * 2816 * 2;
constexpr size_t WS_WGU0 = WS_W;
constexpr size_t WS_WIN0 = WS_W + 4 * (SZ_WGU + SZ_WD);
constexpr size_t WS_WUQ  = WS_WIN0 + (size_t)2048 * 1024 * 2;
constexpr size_t WS_WUKV = WS_WUQ + (size_t)768 * 256 * 2;
constexpr size_t WS_WOUT0 = WS_WUKV + (size_t)1024 * 128 * 2;
constexpr size_t WS_WIN1 = WS_WOUT0 + (size_t)1024 * 1024 * 2;
constexpr size_t WS_WOUT1 = WS_WIN1 + (size_t)3072 * 1024 * 2;
constexpr size_t WS_WEND = WS_WOUT1 + (size_t)1024 * 1024 * 2;
constexpr size_t WS_XB   = 96 * MiB;
constexpr size_t WS_DIL  = 472 * MiB;
constexpr size_t WS_BIG  = 160 * MiB;
constexpr size_t WS_H    = WS_BIG;
constexpr size_t WS_AQKV = WS_BIG;
constexpr size_t WS_CQ   = WS_AQKV + 96 * MiB;
constexpr size_t WS_CKV  = WS_CQ + 16 * MiB;
constexpr size_t WS_QM   = WS_CKV + 8 * MiB;
constexpr size_t WS_KM   = WS_QM + 48 * MiB;
constexpr size_t WS_VM   = WS_KM + 48 * MiB;
constexpr size_t WS_O0   = WS_VM + 32 * MiB;
constexpr size_t WS_END0 = WS_O0 + 64 * MiB;
constexpr size_t WS_QKV1 = WS_BIG;
constexpr size_t WS_O1   = WS_QKV1 + 192 * MiB;
constexpr size_t WS_END1 = WS_O1 + 64 * MiB;
constexpr size_t WS_NEED = 512 * MiB;
static_assert(WS_WEND <= WS_XB && WS_END0 <= WS_NEED && WS_END1 <= WS_NEED && WS_H + (size_t)M_TOK * DFF * 2 <= WS_NEED, "d_ws map");
constexpr size_t DIL_SCR_BYTES = (512 * 64 + 1024) * 4;
static_assert(WS_DIL >= WS_END0 && WS_DIL + 256 * DIL_SCR_BYTES <= WS_NEED, "dilated state after the layer-0 mixer buffers");
constexpr int LDS_BYTES = 131072 + 18432 + 64;

struct Args {
    const float* x; const float* ffn_norm_g; const float* mix_norm_g; const float* w_gate; const float* w_up; const float* w_down;
    const float* ab_w_in; const float* q_norm_g; const float* w_uq; const float* kv_norm_g; const float* w_ukv; const float* ab_w_out;
    const float* sb_w_in; const float* sb_w_out; const float* final_g; float* out; unsigned char* ws; int ph_lo, ph_hi;
};

__device__ __forceinline__ unsigned f2bf(float f) { unsigned u = __builtin_bit_cast(unsigned, f); return (u + 0x7fffu + ((u >> 16) & 1u)) >> 16; }
__device__ __forceinline__ unsigned pk2(float lo, float hi) { return f2bf(lo) | (f2bf(hi) << 16); }
__device__ __forceinline__ float wave_sum(float v) {
#pragma unroll
    for (int o = 1; o < 64; o <<= 1) v += __shfl_xor(v, o);
    return v;
}
template <int MAP> __device__ __forceinline__ int wrow(int n) {
    if (MAP == 0) return n;
    return (n >> 7) * 256 + (n & 127) + (MAP == 2 ? 128 : 0);
}
__device__ __forceinline__ unsigned pkh2(float lo, float hi) { typedef _Float16 h2_ __attribute__((ext_vector_type(2))); if (!RES_FP16) return pk2(lo, hi); h2_ v = {(_Float16)lo, (_Float16)hi}; return __builtin_bit_cast(unsigned, v); }
template <int MAP, bool F16> __device__ __forceinline__ void tr_item(const float* W, int K, int N, bf16_t* WT, const float* gain, float* scr, int item, int lane) {
    const int nblk = N / 32, kb = item / nblk, nb = item % nblk, k0 = 64 * kb, n0 = 32 * nb;
    float wv[32];
    const float gl = gain ? gain[k0 + lane] : 1.0f;
#pragma unroll
    for (int i = 0; i < 32; ++i) { const int kk = 2 * i + (lane >> 5); wv[i] = W[(size_t)(k0 + kk) * N + n0 + (lane & 31)]; }
#pragma unroll
    for (int i = 0; i < 32; ++i) { const int kk = 2 * i + (lane >> 5);
        const float g0 = __builtin_bit_cast(float, __builtin_amdgcn_readlane(__builtin_bit_cast(int, gl), 2 * i)), g1 = __builtin_bit_cast(float, __builtin_amdgcn_readlane(__builtin_bit_cast(int, gl), 2 * i + 1));
        scr[kk * 33 + (lane & 31)] = wv[i] * ((lane >> 5) ? g1 : g0); }
    asm volatile("s_waitcnt lgkmcnt(0)" ::: "memory");
    const int c = lane & 7;
#pragma unroll
    for (int j = 0; j < 4; ++j) { const int n = (lane >> 3) + 8 * j; const float* s = scr + (8 * c) * 33 + n;
        u32x4 o; if (F16) { o.x = pkh2(s[0 * 33], s[1 * 33]); o.y = pkh2(s[2 * 33], s[3 * 33]); o.z = pkh2(s[4 * 33], s[5 * 33]); o.w = pkh2(s[6 * 33], s[7 * 33]); }
        else { o.x = pk2(s[0 * 33], s[1 * 33]); o.y = pk2(s[2 * 33], s[3 * 33]); o.z = pk2(s[4 * 33], s[5 * 33]); o.w = pk2(s[6 * 33], s[7 * 33]); }
        *(u32x4*)(WT + (size_t)wrow<MAP>(n0 + n) * K + k0 + 8 * c) = o; }
    asm volatile("s_waitcnt lgkmcnt(0)" ::: "memory");
}

struct TrP { const float* W; const float* gain; bf16_t* WT; int K, N, map, item; };
__device__ __forceinline__ void tr_load(const TrP& p, int lane, float (&wv)[32], float& gl) {
    const int nblk = p.N / 32, kb = p.item / nblk, nb = p.item % nblk, k0 = 64 * kb, n0 = 32 * nb;
    gl = p.gain ? p.gain[k0 + lane] : 1.0f;
#pragma unroll
    for (int i = 0; i < 32; ++i) { const int kk = 2 * i + (lane >> 5); wv[i] = p.W[(size_t)(k0 + kk) * p.N + n0 + (lane & 31)]; }
}
__device__ __forceinline__ void tr_store(const TrP& p, int lane, const float (&wv)[32], float gl, float* scr) {
    const int nblk = p.N / 32, kb = p.item / nblk, nb = p.item % nblk, k0 = 64 * kb, n0 = 32 * nb;
#pragma unroll
    for (int i = 0; i < 32; ++i) { const int kk = 2 * i + (lane >> 5);
        const float g0 = __builtin_bit_cast(float, __builtin_amdgcn_readlane(__builtin_bit_cast(int, gl), 2 * i)), g1 = __builtin_bit_cast(float, __builtin_amdgcn_readlane(__builtin_bit_cast(int, gl), 2 * i + 1));
        scr[kk * 33 + (lane & 31)] = wv[i] * ((lane >> 5) ? g1 : g0); }
    asm volatile("s_waitcnt lgkmcnt(0)" ::: "memory");
    const int c = lane & 7;
#pragma unroll
    for (int j = 0; j < 4; ++j) { const int n = (lane >> 3) + 8 * j; const float* s = scr + (8 * c) * 33 + n;
        u32x4 o; o.x = pkh2(s[0 * 33], s[1 * 33]); o.y = pkh2(s[2 * 33], s[3 * 33]); o.z = pkh2(s[4 * 33], s[5 * 33]); o.w = pkh2(s[6 * 33], s[7 * 33]);
        const int nn = n0 + n; const int rowd = (p.map == 0) ? nn : (nn >> 7) * 256 + (nn & 127) + (p.map == 2 ? 128 : 0);
        *(u32x4*)(p.WT + (size_t)rowd * p.K + k0 + 8 * c) = o; }
    asm volatile("s_waitcnt lgkmcnt(0)" ::: "memory");
}

#define LAS __attribute__((address_space(3)))
#define XB_TMO      128
#define XB_XCNT(j)  (256  + 64 * (j))
#define XB_XSUB(j)  (1280 + 64 * (j))
#define XB_XGEN(j)  (2304 + 64 * (j))
#define XB_TOP      3328
#define XB_TOPGEN   3392
#define XCD_BAR_WORDS 3456
#define XB_SPIN_CAP (1u << 18)

__device__ __forceinline__ unsigned xb_ld(unsigned* p)              { return __hip_atomic_load(p, __ATOMIC_RELAXED, __HIP_MEMORY_SCOPE_AGENT); }
__device__ __forceinline__ unsigned xb_add(unsigned* p, unsigned v) { return __hip_atomic_fetch_add(p, v, __ATOMIC_RELAXED, __HIP_MEMORY_SCOPE_AGENT); }
__device__ __forceinline__ unsigned xb_xcc_id() { return (unsigned)__builtin_amdgcn_s_getreg((3 << 11) | 20) & 0xFu; }
#define XB_SPIN(cond, bar) do { unsigned _sp = 0; while (cond) { __builtin_amdgcn_s_sleep(1); \
    if ((++_sp & 255u) == 0u) { if (xb_ld(&(bar)[XB_TMO])) break; if (_sp > XB_SPIN_CAP) { atomicAdd(&(bar)[XB_TMO], 1u); break; } } } } while (0)

struct XcdBarrier {
    unsigned* bar; unsigned x;
    volatile LAS unsigned* st;
};

__device__ __forceinline__ XcdBarrier xcd_barrier_post(unsigned* bar, volatile LAS unsigned* st) {
    XcdBarrier b; b.bar = bar; b.x = xb_xcc_id(); b.st = st;
    if (threadIdx.x == 0) (void)xb_add(&bar[XB_XCNT(b.x)], 1u);
    return b;
}
__device__ __forceinline__ void xcd_barrier_complete(unsigned* bar, unsigned x, unsigned& nloc, unsigned& nx) {
    const unsigned G = gridDim.x * gridDim.y * gridDim.z;
    unsigned sum, cnt, mine, sp = 0u;
    for (;;) {
        sum = 0u; cnt = 0u; mine = 0u;
#pragma unroll
        for (unsigned j = 0; j < 16; ++j) { const unsigned c = xb_ld(&bar[XB_XCNT(j)]); sum += c; cnt += (c > 0u) ? 1u : 0u; mine = (j == x) ? c : mine; }
        if (sum == G) break;
        __builtin_amdgcn_s_sleep(1);
        if ((++sp & 255u) == 0u) { if (xb_ld(&bar[XB_TMO])) break; if (sp > XB_SPIN_CAP) { atomicAdd(&bar[XB_TMO], 1u); break; } }
    }
    nloc = mine > 0u ? mine : 1u; nx = cnt > 0u ? cnt : 1u;
}

__device__ __forceinline__ void xcd_barrier(const XcdBarrier& b) {
    asm volatile("s_waitcnt vmcnt(0)" ::: "memory");
    __syncthreads();
    if (threadIdx.x == 0) {
        unsigned* bar = b.bar;
        __builtin_amdgcn_s_waitcnt(0);
        unsigned nloc = b.st[0], nx = b.st[1];
        if (nloc == 0u) { xcd_barrier_complete(bar, b.x, nloc, nx); b.st[0] = nloc; b.st[1] = nx; }
        const unsigned old = xb_add(&bar[XB_XSUB(b.x)], 1u);
        const unsigned gen = old / nloc;
        if (old + 1u == (gen + 1u) * nloc) {
            __builtin_amdgcn_fence(__ATOMIC_RELEASE, "agent");
            asm volatile("s_waitcnt vmcnt(0)" ::: "memory");
            const unsigned og = xb_add(&bar[XB_TOP], 1u);
            const unsigned tg = og / nx;
            if (og + 1u == (tg + 1u) * nx) xb_add(&bar[XB_TOPGEN], 1u);
            else XB_SPIN(xb_ld(&bar[XB_TOPGEN]) == tg, bar);
            __builtin_amdgcn_fence(__ATOMIC_ACQUIRE, "agent");
            xb_add(&bar[XB_XGEN(b.x)], 1u);
            asm volatile("s_waitcnt vmcnt(0)" ::: "memory");
        } else {
            XB_SPIN(xb_ld(&bar[XB_XGEN(b.x)]) == gen, bar);
            __builtin_amdgcn_fence(__ATOMIC_ACQUIRE, "agent");
            asm volatile("s_waitcnt vmcnt(0)" ::: "memory");
        }
    }
    __syncthreads();
}

#define LB_SUB(j) (4096 + 64 * (j))
#define LB_GEN(j) (5120 + 64 * (j))
#define LB_MISMATCH 6144
__device__ __forceinline__ void xcd_local_barrier(const XcdBarrier& b) {
    asm volatile("s_waitcnt vmcnt(0)" ::: "memory");
    __syncthreads();
    if (threadIdx.x == 0) {
        unsigned* bar = b.bar;
        const unsigned old = xb_add(&bar[LB_SUB(b.x)], 1u), gen = old / 32u;
        if (old + 1u == (gen + 1u) * 32u) xb_add(&bar[LB_GEN(b.x)], 1u);
        else XB_SPIN(xb_ld(&bar[LB_GEN(b.x)]) == gen, bar);
        __builtin_amdgcn_fence(__ATOMIC_ACQUIRE, "agent");
        asm volatile("s_waitcnt vmcnt(0)" ::: "memory");
    }
    __syncthreads();
}

__device__ __forceinline__ void grid_bar(unsigned* bar, unsigned nblk, unsigned& gen) {
    asm volatile("s_waitcnt vmcnt(0)" ::: "memory");
    __syncthreads();
    gen += 1u;
    if (threadIdx.x == 0) {
        __builtin_amdgcn_fence(__ATOMIC_RELEASE, "agent");
        asm volatile("s_waitcnt vmcnt(0)" ::: "memory");
        const unsigned target = gen * nblk;
        const unsigned old = __hip_atomic_fetch_add(bar, 1u, __ATOMIC_RELAXED, __HIP_MEMORY_SCOPE_AGENT);
        unsigned* flag = bar + 64;
        if (old + 1u == target) __hip_atomic_store(flag, gen, __ATOMIC_RELAXED, __HIP_MEMORY_SCOPE_AGENT);
        else { unsigned spins = 0; while (__hip_atomic_load(flag, __ATOMIC_RELAXED, __HIP_MEMORY_SCOPE_AGENT) < gen) { __builtin_amdgcn_s_sleep(2); if (++spins > (1u << 24)) break; } }
        __builtin_amdgcn_fence(__ATOMIC_ACQUIRE, "agent");
        asm volatile("s_waitcnt vmcnt(0)" ::: "memory");
    }
    __syncthreads();
}

__global__ void __launch_bounds__(NTHR, 2) mk_fwd(Args a) {
    extern __shared__ __attribute__((aligned(16))) unsigned char lds[];
    cg::grid_group grid = cg::this_grid();
    const int G = gridDim.x, bid = blockIdx.x;
    unsigned char* ws = a.ws;
    float* rope = (float*)(ws + WS_ROPE); float* ss = (float*)(ws + WS_SS); float* ssq = (float*)(ws + WS_SSQ); float* sskv = (float*)(ws + WS_SSKV);
    bf16_t* XB = (bf16_t*)(ws + WS_XB); bf16_t* H = (bf16_t*)(ws + WS_H);
    PG8_LAS unsigned char* glds = (PG8_LAS unsigned char*)lds;
    int ph = 0;
    unsigned* gbar = (unsigned*)(ws + WS_BAR); unsigned gen = 0u; (void)gen;
    volatile LAS unsigned* xst = (volatile LAS unsigned*)((LAS unsigned char*)lds + 131072 + 18432);
    if (threadIdx.x < 2) xst[threadIdx.x] = 0u;
    __syncthreads();
    const XcdBarrier xbar = xcd_barrier_post(gbar, xst);
    if (threadIdx.x == 0 && xbar.x != (blockIdx.x & 7u)) (void)xb_add(&gbar[LB_MISMATCH], 1u);
    bool localmode = false;
#ifndef PROBE_REPEAT
#define PROBE_REPEAT -1
#endif
#define PHASE_BEGIN if (ph >= a.ph_lo && ph < a.ph_hi) { for (int rep_ = (ph == PROBE_REPEAT ? 2 : 1); rep_ > 0; --rep_) {
#define SEAM_LOCAL(p_) ((0x5BBAu >> (p_)) & 1u)
#define PHASE_END(dosync_) } if ((dosync_) && ph + 1 < a.ph_hi) { if (a.ph_lo > 1000000) grid.sync(); \
        if (localmode && ph < 16 && SEAM_LOCAL(ph)) xcd_local_barrier(xbar); else xcd_barrier(xbar); \
        if (ph == 0) { unsigned okc = 0u; for (int j = 0; j < 8; ++j) okc += (xb_ld(&gbar[XB_XCNT(j)]) == 32u) ? 1u : 0u; \
            localmode = (G == 256) && (okc == 8u) && (xb_ld(&gbar[LB_MISMATCH]) == 0u) && (a.ph_lo == 0); } } } ++ph;

    PHASE_BEGIN
    {
        const int tid = opaque_tid(), lane = tid & 63, wave = __builtin_amdgcn_readfirstlane(tid >> 6);
        float* scr = (float*)(lds + wave * 16384);
        const int gw = bid * 8 + wave, NGW = G * 8;
        constexpr int I_GU = 16 * 88, I_D = 44 * 32, I_IN0 = 16 * 61, I_UQ = 4 * 24, I_UKV = 2 * 32, I_O = 16 * 32, I_IN1 = 16 * 96;
        constexpr int NITEMS = 4 * (2 * I_GU + I_D) + I_IN0 + I_UQ + I_UKV + I_O + I_IN1 + I_O;
        auto get_item = [&](int it) __attribute__((always_inline)) -> TrP {
            TrP p; int r = it;
            if (r < 4 * (2 * I_GU + I_D)) {
                const int f = r / (2 * I_GU + I_D); r -= f * (2 * I_GU + I_D);
                bf16_t* wgu = (bf16_t*)(ws + WS_WGU0 + f * (SZ_WGU + SZ_WD)); bf16_t* wd = (bf16_t*)(ws + WS_WGU0 + f * (SZ_WGU + SZ_WD) + SZ_WGU);
                const float* g = a.ffn_norm_g + f * 1024;
                if (r < I_GU) p = TrP{a.w_gate + (size_t)f * 1024 * 2816, g, wgu, 1024, 2816, 1, r};
                else if (r < 2 * I_GU) p = TrP{a.w_up + (size_t)f * 1024 * 2816, g, wgu, 1024, 2816, 2, r - I_GU};
                else p = TrP{a.w_down + (size_t)f * 2816 * 1024, nullptr, wd, 2816, 1024, 0, r - 2 * I_GU};
                return p;
            }
            r -= 4 * (2 * I_GU + I_D);
            if (r < I_IN0) return TrP{a.ab_w_in, a.mix_norm_g, (bf16_t*)(ws + WS_WIN0), 1024, 1952, 0, r}; r -= I_IN0;
            if (r < I_UQ) return TrP{a.w_uq, a.q_norm_g, (bf16_t*)(ws + WS_WUQ), 256, 768, 0, r}; r -= I_UQ;
            if (r < I_UKV) return TrP{a.w_ukv, a.kv_norm_g, (bf16_t*)(ws + WS_WUKV), 128, 1024, 0, r}; r -= I_UKV;
            if (r < I_O) return TrP{a.ab_w_out, nullptr, (bf16_t*)(ws + WS_WOUT0), 1024, 1024, 0, r}; r -= I_O;
            if (r < I_IN1) return TrP{a.sb_w_in, a.mix_norm_g + 1024, (bf16_t*)(ws + WS_WIN1), 1024, 3072, 0, r}; r -= I_IN1;
            return TrP{a.sb_w_out, nullptr, (bf16_t*)(ws + WS_WOUT1), 1024, 1024, 0, r};
        };
        if (gw < NITEMS) {
            TrP cur = get_item(gw); float wv[32], gl; tr_load(cur, lane, wv, gl);
            for (int it = gw; it < NITEMS; it += NGW) {
                const int itn = (it + NGW < NITEMS) ? it + NGW : it;
                const TrP nxt = get_item(itn); float wn[32], gn; tr_load(nxt, lane, wn, gn);
                tr_store(cur, lane, wv, gl, scr);
                cur = nxt; gl = gn;
#pragma unroll
                for (int i = 0; i < 32; ++i) wv[i] = wn[i];
            }
        }
        { u32x4* z = (u32x4*)(ws + WS_WIN0 + (size_t)1952 * 1024 * 2); const int nz = 96 * 1024 * 2 / 16;
          for (int i = bid * NTHR + tid; i < nz; i += G * NTHR) z[i] = u32x4{0u, 0u, 0u, 0u}; }
        for (int i = bid * NTHR + tid; i < 2048 * 16; i += G * NTHR) {
            const int pos = i >> 4, fi = i & 15; double inv = 1.0;
            for (int q = 0; q < fi; ++q) inv *= 0.5623413251903491;
            const double rev = (double)pos * inv * 0.15915494309189535; const double fr = rev - (double)(long long)rev;
            const float ang = (float)(fr * 6.283185307179586);
            float sv, cv; sincosf(ang, &sv, &cv);
            rope[pos * 32 + fi] = cv; rope[pos * 32 + 16 + fi] = sv;
        }
        for (int m0 = gw; m0 < M_TOK; m0 += 4 * NGW) {
            f32x4 v[4][4];
#pragma unroll
            for (int q = 0; q < 4; ++q)
#pragma unroll
                for (int j = 0; j < 4; ++j) v[q][j] = ((const f32x4*)(a.x + (size_t)(m0 + q * NGW) * 1024) + lane)[64 * j];
#pragma unroll
            for (int q = 0; q < 4; ++q) { const int m = m0 + q * NGW; float s = 0.f;
                unsigned long long* o8 = (unsigned long long*)(XB + (size_t)m * 1024) + lane;
#pragma unroll
                for (int j = 0; j < 4; ++j) { const f32x4 w = v[q][j]; s += (w[0] * w[0] + w[1] * w[1]) + (w[2] * w[2] + w[3] * w[3]);
                    o8[64 * j] = (unsigned long long)pkh2(w[0], w[1]) | ((unsigned long long)pkh2(w[2], w[3]) << 32); }
                s = wave_sum(s);
                if (lane < 16) ss[(size_t)m * 16 + lane] = (lane == 0) ? s : 0.f; }
        }
        __syncthreads();
    }
    PHASE_END(true)

#define GEMM_PHASE(EPI, E, Aptr, Bptr, Nn, Kk) do { int kk_ = (Kk), nn_ = (Nn); asm volatile("" : "+s"(kk_), "+s"(nn_)); pg8::Gemm g_{(const bf16_t*)(Aptr), (const bf16_t*)(Bptr), M_TOK, nn_, kk_}; pg8::StaticOrder S_; S_.init(M_TOK, nn_, G, bid); \
        pg8::gemm_phase<EPI, pg8::StaticOrder, true, true>(glds, g_, S_, E); } while (0)

#pragma unroll 1
    for (int layer = 0; layer < 2; ++layer) {
#pragma unroll 1
        for (int half = 0; half < 2; ++half) {
            const int f = layer * 2 + half;
            const bf16_t* wgu = (const bf16_t*)(ws + WS_WGU0 + f * (SZ_WGU + SZ_WD)); const bf16_t* wd = (const bf16_t*)(ws + WS_WGU0 + f * (SZ_WGU + SZ_WD) + SZ_WGU);
            PHASE_BEGIN
            { pg8::EpiGU E{ss, H}; GEMM_PHASE(pg8::EpiGU, E, XB, wgu, 5632, 1024); }
            PHASE_END(true)
            PHASE_BEGIN
                        { if (f == 0) { pg8::EpiResidT<true> E{a.x, XB, ss, (rep_ == 2) ? 0.f : 0.5f, (float*)(lds + 131072)}; GEMM_PHASE(pg8::EpiResidT<true>, E, H, wd, 1024, 2816); }
              else { pg8::EpiResidT<false> E{a.x, XB, ss, (rep_ == 2) ? 0.f : 0.5f, (float*)(lds + 131072)}; GEMM_PHASE(pg8::EpiResidT<false>, E, H, wd, 1024, 2816); } }
            PHASE_END(true)
            if (half == 1) continue;
            if (layer == 0) {
                bf16_t* AQKV = (bf16_t*)(ws + WS_AQKV); bf16_t* CQ = (bf16_t*)(ws + WS_CQ); bf16_t* CKV = (bf16_t*)(ws + WS_CKV);
                bf16_t* QM = (bf16_t*)(ws + WS_QM); bf16_t* KM = (bf16_t*)(ws + WS_KM); bf16_t* VM = (bf16_t*)(ws + WS_VM); bf16_t* O0 = (bf16_t*)(ws + WS_O0);
                PHASE_BEGIN
                { pg8::EpiInAB E{ss, AQKV, CQ, CKV, KM, ssq, sskv, rope}; GEMM_PHASE(pg8::EpiInAB, E, XB, ws + WS_WIN0, 2048, 1024); }
                PHASE_END(true)
                PHASE_BEGIN
                { pg8::EpiUQ E{ssq, QM, rope}; GEMM_PHASE(pg8::EpiUQ, E, CQ, ws + WS_WUQ, 768, 256); }
                { pg8::EpiUKV E{sskv, KM, VM}; GEMM_PHASE(pg8::EpiUKV, E, CKV, ws + WS_WUKV, 1024, 128); }
                __syncthreads();
                {
                    const int xg = bid & 7, li = bid >> 3, h = li >> 2, blk = li & 3;
                    for (int r = 0; r < 2; ++r) att::dil_unit(AQKV, (float*)(ws + WS_DIL + (size_t)bid * DIL_SCR_BYTES), O0, 2 * xg + r, h, blk, (char*)lds);
                }
                PHASE_END(true)
                PHASE_BEGIN
                for (int i = 0; i < 4; ++i) {
                    const int xg = bid & 7, li = bid >> 3, h = li >> 2, p = li & 3;
                    const int b = 2 * xg + (i >> 1); const int qb = (i & 1) ? p : 7 - p;
                    const size_t rb = (size_t)b * 2048;
                    att::attn_unit<96, 0>(QM + rb * 768 + h * 96, 768, KM + rb * 768 + h * 96, 768, VM + rb * 512 + h * 64, 512, O0 + rb * 1024 + 512 + h * 64, 1024, qb, (char*)lds,
                                          0.10206207261596575f * att::kLog2e);
                }
                __syncthreads();
                PHASE_END(true)
                PHASE_BEGIN
                { pg8::EpiResidT<false> E{a.x, XB, ss, (rep_ == 2) ? 0.f : 1.0f, (float*)(lds + 131072)}; GEMM_PHASE(pg8::EpiResidT<false>, E, O0, ws + WS_WOUT0, 1024, 1024); }
                PHASE_END(true)
            } else {
                bf16_t* QKV = (bf16_t*)(ws + WS_QKV1); bf16_t* O1 = (bf16_t*)(ws + WS_O1);
                PHASE_BEGIN
                { pg8::EpiScale E{ss, QKV, 3072}; GEMM_PHASE(pg8::EpiScale, E, XB, ws + WS_WIN1, 3072, 1024); }
                PHASE_END(true)
                PHASE_BEGIN
                {
                    const int tid = opaque_tid(), lane = tid & 63, wave = __builtin_amdgcn_readfirstlane(tid >> 6);
                    {
                        const int xg = bid & 7, li = bid >> 3, p = li & 3;
                        for (int rr = 0; rr < 4; ++rr) {
                            const int bhl = rr * 8 + (li >> 2), b = 2 * xg + (bhl >> 4), h = bhl & 15; const size_t rb = (size_t)b * 2048;
                            for (int k = 1; k >= 0; --k)
                                att::sb_wave_unit(QKV + rb * 3072 + h * 64, QKV + rb * 3072 + 1024 + h * 64, QKV + rb * 3072 + 2048 + h * 64, 3072, O1 + rb * 1024 + h * 64, 1024, (p * 16 + k * 8 + wave) * 32, (char*)lds + wave * 4096, lane);
                        }
                    }
                }
                __syncthreads();
                PHASE_END(true)
                PHASE_BEGIN
                { pg8::EpiResidT<false> E{a.x, XB, ss, (rep_ == 2) ? 0.f : 1.0f, (float*)(lds + 131072)}; GEMM_PHASE(pg8::EpiResidT<false>, E, O1, ws + WS_WOUT1, 1024, 1024); }
                PHASE_END(true)
            }
        }
    }
    PHASE_BEGIN
    {
        const int tid = opaque_tid(), lane = tid & 63, wave = __builtin_amdgcn_readfirstlane(tid >> 6);
        const int gw = bid * 8 + wave, NGW = G * 8;
        f32x4 gv[4];
#pragma unroll
        for (int j = 0; j < 4; ++j) gv[j] = ((const f32x4*)a.final_g + lane)[64 * j];
        for (int m0 = gw; m0 < M_TOK; m0 += 4 * NGW) {
            u32x2 v[4][4]; float sq[4];
#pragma unroll
            for (int q = 0; q < 4; ++q) { const int m = m0 + q * NGW; sq[q] = (lane < 16) ? ss[(size_t)m * 16 + lane] : 0.f;
#pragma unroll
                for (int j = 0; j < 4; ++j) v[q][j] = ((const u32x2*)(XB + (size_t)m * 1024) + lane)[64 * j]; }
#pragma unroll
            for (int q = 0; q < 4; ++q) { const int m = m0 + q * NGW; const float rs = __builtin_amdgcn_rsqf(wave_sum(sq[q]) * (1.0f / 1024.0f) + 1e-6f);
                f32x4* xr = (f32x4*)(a.out + (size_t)m * 1024) + lane;
#pragma unroll
                for (int j = 0; j < 4; ++j) xr[64 * j] = pg8::unpk4h(v[q][j]) * rs * gv[j]; }
        }
    }
    PHASE_END(false)
#undef PHASE_BEGIN
#undef PHASE_END
#undef GEMM_PHASE
}

extern "C" void kernel_launch(void* const* d_in, const int* in_sizes, int n_in, void* d_out, int out_size, void* d_ws, size_t ws_size, hipStream_t stream) {
    static int grid = 0;
    if (grid == 0) {
        if (n_in != 15 || in_sizes[0] != M_TOK * DM || out_size != M_TOK * DM || ws_size < WS_NEED) {
            fprintf(stderr, "kernel_launch: unexpected shapes (n_in %d in0 %d out %d ws %zu)\n", n_in, n_in > 0 ? in_sizes[0] : -1, out_size, ws_size); grid = -1; return; }
        int dev = 0, cus = 0, per_cu = 0;
        (void)hipGetDevice(&dev); (void)hipDeviceGetAttribute(&cus, hipDeviceAttributeMultiprocessorCount, dev);
        if (hipFuncSetAttribute((const void*)mk_fwd, hipFuncAttributeMaxDynamicSharedMemorySize, LDS_BYTES) != hipSuccess) { fprintf(stderr, "kernel_launch: hipFuncSetAttribute failed\n"); grid = -1; return; }
        if (hipOccupancyMaxActiveBlocksPerMultiprocessor(&per_cu, (const void*)mk_fwd, NTHR, LDS_BYTES) != hipSuccess || per_cu < 1) { fprintf(stderr, "kernel_launch: occupancy query failed (%d)\n", per_cu); per_cu = 1; }
        (void)hipGetLastError();
        grid = cus * 1;
        if (grid != 256) { fprintf(stderr, "kernel_launch: built for a 256-CU device (the phase programs assume 256 workgroups); found %d CUs, nothing launched\n", cus); grid = -1; return; }
    }
    if (grid < 0) return;
    Args a{};
    a.x = (const float*)d_in[0]; a.ffn_norm_g = (const float*)d_in[1]; a.mix_norm_g = (const float*)d_in[2]; a.w_gate = (const float*)d_in[3]; a.w_up = (const float*)d_in[4]; a.w_down = (const float*)d_in[5];
    a.ab_w_in = (const float*)d_in[6]; a.q_norm_g = (const float*)d_in[7]; a.w_uq = (const float*)d_in[8]; a.kv_norm_g = (const float*)d_in[9]; a.w_ukv = (const float*)d_in[10]; a.ab_w_out = (const float*)d_in[11];
    a.sb_w_in = (const float*)d_in[12]; a.sb_w_out = (const float*)d_in[13]; a.final_g = (const float*)d_in[14]; a.out = (float*)d_out; a.ws = (unsigned char*)d_ws;
    a.ph_lo = 0; a.ph_hi = 1000;
    if (hipMemsetAsync((char*)d_ws + WS_BAR, 0, 32768, stream) != hipSuccess) { fprintf(stderr, "kernel_launch: memset of the barrier words failed\n"); return; }
    void* args[] = {&a};
    hipError_t e = hipLaunchCooperativeKernel((const void*)mk_fwd, dim3(grid), dim3(NTHR), args, LDS_BYTES, stream);
    if (e != hipSuccess) fprintf(stderr, "kernel_launch: cooperative launch failed: %s (grid %d)\n", hipGetErrorString(e), grid);
}
```
